# Optimizing an MI355X kernel written in HIP

```python
import jax
import jax.numpy as jnp
from jax import lax
import numpy as np

D_MODEL = 1024
BATCH = 4
SEQ = 8192
DEPTH = 2

GRID_W = 64
CTX_LEN = 256
MIX_WIDTH = D_MODEL
M_HEADS = 4
M_DV = MIX_WIDTH // (2 * M_HEADS)
M_DK = M_DV // 2
M_CHUNK = 128
A_HEADS = 8
A_KV_HEADS = 2
A_GROUP = A_HEADS // A_KV_HEADS
A_DH = (MIX_WIDTH - M_HEADS * M_DV) // A_HEADS
Q_BLOCK = 128
ROPE_THETA = 10000.0
D_FF = ((8 * D_MODEL // 3 + 127) // 128) * 128
N_EXPERTS = 8
TOP_K = 2
D_FF_EXPERT = 7 * D_MODEL // 2
EPS = 1e-6
SPLIT_SIZES = (M_HEADS * M_DK, M_HEADS * M_DK, M_HEADS * M_DV, M_HEADS * M_DV, 4 * M_HEADS,
               A_HEADS * A_DH, A_KV_HEADS * A_DH, A_KV_HEADS * A_DH)
D_IN = sum(SPLIT_SIZES)

kernel_name = 'hybrid_mlstm_gqa_moe_dit_prefix'


def _rms(x, w):
    xf = x.astype(jnp.float32)
    y = xf * lax.rsqrt(jnp.mean(xf * xf, axis=-1, keepdims=True) + EPS)
    return (y * w.astype(jnp.float32)).astype(x.dtype)


def _modulate(h, shift, scale):
    return h * (1.0 + scale) + shift


def _split(p):
    out, o = [], 0
    for s in SPLIT_SIZES:
        out.append(p[..., o:o + s])
        o += s
    return out


def _rope_tables(n_tok):
    rows = n_tok // GRID_W
    row = jnp.broadcast_to(jnp.arange(rows, dtype=jnp.float32)[:, None], (rows, GRID_W)).reshape(n_tok)
    col = jnp.broadcast_to(jnp.arange(GRID_W, dtype=jnp.float32)[None, :], (rows, GRID_W)).reshape(n_tok)
    n_freq = A_DH // 4
    inv_freq = ROPE_THETA ** (-jnp.arange(n_freq, dtype=jnp.float32) / n_freq)
    ang = jnp.concatenate([row[:, None] * inv_freq, col[:, None] * inv_freq], axis=-1)
    return jnp.cos(ang), jnp.sin(ang)


def _rope(x, cos, sin):
    xf = x.astype(jnp.float32).reshape(x.shape[:-1] + (A_DH // 2, 2))
    xe, xo = xf[..., 0], xf[..., 1]
    c, s = cos[None, :, None, :], sin[None, :, None, :]
    out = jnp.stack([xe * c - xo * s, xe * s + xo * c], axis=-1)
    return out.reshape(x.shape).astype(x.dtype)


def _mlstm_prep(mq, mk, mv, mg, gate_b):
    B, T, _ = mq.shape
    heads = lambda t: t.astype(jnp.float32).reshape(B, T, M_HEADS, -1).transpose(0, 2, 1, 3)
    q = heads(mq) * (M_DK ** -0.5)
    g = (mg.astype(jnp.float32) + gate_b.astype(jnp.float32)).reshape(B, T, 4, M_HEADS).transpose(2, 0, 3, 1)
    return (q, heads(mk), heads(mv), g[0], jax.nn.log_sigmoid(g[1]), g[2], jax.nn.log_sigmoid(g[3]))


def _mlstm_states(k, v, ig, lf, state0):
    B, H, T, dk = k.shape
    dv = v.shape[-1]
    nc = T // M_CHUNK
    kc = k.reshape(B, H, nc, M_CHUNK, dk)
    vc = v.reshape(B, H, nc, M_CHUNK, dv)
    igc = ig.reshape(B, H, nc, M_CHUNK)
    b = jnp.cumsum(lf.reshape(B, H, nc, M_CHUNK), axis=-1)
    b_end = b[..., -1]
    w_log = b_end[..., None] - b + igc
    m_loc = jnp.max(w_log, axis=-1)
    w = jnp.exp(w_log - m_loc[..., None])
    c_loc = jnp.einsum('bhcsd,bhcsk->bhcdk', vc * w[..., None], kc)
    n_loc = jnp.einsum('bhcs,bhcsk->bhck', w, kc)

    def step(carry, inp):
        c_prev, n_prev, m_prev = carry
        c_l, n_l, m_l, g = inp
        m_new = jnp.maximum(g + m_prev, m_l)
        a = jnp.exp(g + m_prev - m_new)
        s = jnp.exp(m_l - m_new)
        c_new = a[..., None, None] * c_prev + s[..., None, None] * c_l
        n_new = a[..., None] * n_prev + s[..., None] * n_l
        return (c_new, n_new, m_new), (c_prev, n_prev, m_prev)

    xs = (jnp.moveaxis(c_loc, 2, 0), jnp.moveaxis(n_loc, 2, 0), jnp.moveaxis(m_loc, 2, 0), jnp.moveaxis(b_end, 2, 0))
    final, enter = lax.scan(step, state0, xs)
    enter = (jnp.moveaxis(enter[0], 0, 2), jnp.moveaxis(enter[1], 0, 2), jnp.moveaxis(enter[2], 0, 2))
    return enter, final


def _mlstm_outputs(q, k, v, ig, lf, enter):
    c_e, n_e, m_e = enter
    B, H, T, dk = q.shape
    dv = v.shape[-1]
    nc = T // M_CHUNK
    qc = q.reshape(B, H, nc, M_CHUNK, dk)
    kc = k.reshape(B, H, nc, M_CHUNK, dk)
    vc = v.reshape(B, H, nc, M_CHUNK, dv)
    igc = ig.reshape(B, H, nc, M_CHUNK)
    b = jnp.cumsum(lf.reshape(B, H, nc, M_CHUNK), axis=-1)
    lower = jnp.tril(jnp.ones((M_CHUNK, M_CHUNK), dtype=bool))
    d_log = jnp.where(lower, b[..., :, None] - b[..., None, :] + igc[..., None, :], -jnp.inf)
    inter = b + m_e[..., None]
    m_t = jnp.maximum(inter, jnp.max(d_log, axis=-1))
    a = jnp.exp(inter - m_t)
    s = jnp.einsum('bhctk,bhcsk->bhcts', qc, kc) * jnp.exp(d_log - m_t[..., None])
    num = jnp.einsum('bhcts,bhcsd->bhctd', s, vc) + a[..., None] * jnp.einsum('bhcdk,bhctk->bhctd', c_e, qc)
    den = jnp.sum(s, axis=-1) + a * jnp.einsum('bhck,bhctk->bhct', n_e, qc)
    h = num / jnp.maximum(jnp.abs(den), jnp.exp(-m_t))[..., None]
    return h.reshape(B, H, T, dv)


def _mlstm_direction(ctx_feats, lat_feats, need_ctx):
    q_c, k_c, v_c, i_c, f_c = ctx_feats
    q_l, k_l, v_l, i_l, f_l = lat_feats
    B, H, _, dk = k_c.shape
    dv = v_c.shape[-1]
    zero = (jnp.zeros((B, H, dv, dk), jnp.float32), jnp.zeros((B, H, dk), jnp.float32), jnp.zeros((B, H), jnp.float32))
    ctx_enter, ctx_final = _mlstm_states(k_c, v_c, i_c, f_c, zero)
    lat_enter, _ = _mlstm_states(k_l, v_l, i_l, f_l, ctx_final)
    h_l = _mlstm_outputs(q_l, k_l, v_l, i_l, f_l, lat_enter)
    h_c = _mlstm_outputs(q_c, k_c, v_c, i_c, f_c, ctx_enter) if need_ctx else None
    return h_l, h_c


def _mlstm_merge(h, mo, m_norm_w):
    B, H, T, dv = h.shape
    hn = _rms(h, m_norm_w.reshape(H, 1, dv))
    return hn.transpose(0, 2, 1, 3).reshape(B, T, H * dv) * jax.nn.sigmoid(mo.astype(jnp.float32))


def _fwd(f):
    return (f[0], f[1], f[2], f[3], f[4])


def _bwd(f):
    return tuple(jnp.flip(t, axis=2) for t in (f[0], f[1], f[2], f[5], f[6]))


def _attn_q(aq, q_norm_w, rope):
    B, T, _ = aq.shape
    q = _rms(aq.reshape(B, T, A_HEADS, A_DH), q_norm_w)
    if rope is not None:
        q = _rope(q, *rope)
    q = q * (A_DH ** -0.5)
    return q.reshape(B, T, A_KV_HEADS, A_GROUP, A_DH).transpose(0, 2, 3, 1, 4)


def _attn_kv(ak, av, k_norm_w, rope):
    B, T, _ = ak.shape
    k = _rms(ak.reshape(B, T, A_KV_HEADS, A_DH), k_norm_w)
    if rope is not None:
        k = _rope(k, *rope)
    v = av.reshape(B, T, A_KV_HEADS, A_DH)
    return k.transpose(0, 2, 1, 3), v.transpose(0, 2, 1, 3)


def _attend(q, k, v):
    s = jnp.einsum('bkgqd,bksd->bkgqs', q, k, preferred_element_type=jnp.float32)
    p = jax.nn.softmax(s, axis=-1)
    return jnp.einsum('bkgqs,bksd->bkgqd', p.astype(v.dtype), v)


def _merge_heads(o):
    B, K, G, T, d = o.shape
    return o.transpose(0, 3, 1, 2, 4).reshape(B, T, K * G * d)


def _latent_attention(q, k_all, v_all):
    B, K, G, T, d = q.shape
    nb = T // Q_BLOCK
    qb = jnp.moveaxis(q.reshape(B, K, G, nb, Q_BLOCK, d), 3, 0)
    ob = lax.map(lambda blk: _attend(blk, k_all, v_all), qb)
    return _merge_heads(jnp.moveaxis(ob, 0, 3).reshape(B, K, G, T, d))


def _mixer(px, pc, rope, gate_b, m_norm_w, q_norm_w, k_norm_w, need_ctx):
    mq_x, mk_x, mv_x, mo_x, mg_x, aq_x, ak_x, av_x = _split(px)
    mq_c, mk_c, mv_c, mo_c, mg_c, aq_c, ak_c, av_c = _split(pc)
    lat = _mlstm_prep(mq_x, mk_x, mv_x, mg_x, gate_b)
    ctf = _mlstm_prep(mq_c, mk_c, mv_c, mg_c, gate_b)
    hf_x, hf_c = _mlstm_direction(_fwd(ctf), _fwd(lat), need_ctx)
    hb_x, hb_c = _mlstm_direction(_bwd(ctf), _bwd(lat), need_ctx)
    m_x = _mlstm_merge(hf_x + jnp.flip(hb_x, axis=2), mo_x, m_norm_w)
    k_x, v_x = _attn_kv(ak_x, av_x, k_norm_w, rope)
    k_c, v_c = _attn_kv(ak_c, av_c, k_norm_w, None)
    k_all = jnp.concatenate([k_c, k_x], axis=2)
    v_all = jnp.concatenate([v_c, v_x], axis=2)
    a_x = _latent_attention(_attn_q(aq_x, q_norm_w, rope), k_all, v_all)
    y_x = jnp.concatenate([m_x.astype(px.dtype), a_x.astype(px.dtype)], axis=-1)
    if not need_ctx:
        return y_x, None
    m_c = _mlstm_merge(hf_c + jnp.flip(hb_c, axis=2), mo_c, m_norm_w)
    a_c = _merge_heads(_attend(_attn_q(aq_c, q_norm_w, None), k_c, v_c))
    y_c = jnp.concatenate([m_c.astype(pc.dtype), a_c.astype(pc.dtype)], axis=-1)
    return y_x, y_c


def _swiglu(h, wg, wu, wd):
    return (jax.nn.silu(h @ wg) * (h @ wu)) @ wd


def _moe(h, router, wg, wu, wd):
    logits = (h @ router).astype(jnp.float32)
    top_v, top_i = lax.top_k(logits, TOP_K)
    gates = jax.nn.softmax(top_v, axis=-1)
    y = jnp.zeros_like(h)
    for e in range(N_EXPERTS):
        w_e = jnp.sum(jnp.where(top_i == e, gates, 0.0), axis=-1).astype(h.dtype)
        y = y + w_e[..., None] * _swiglu(h, wg[e], wu[e], wd[e])
    return y


def setup_inputs(seed: int = 0) -> dict:
    key = jax.random.key(seed)
    ks = jax.random.split(key, 26)
    D = D_MODEL
    n_dense = (DEPTH + 1) // 2
    n_moe = DEPTH // 2

    def nrm(k, shape, scale):
        return jax.random.normal(k, shape, jnp.float32) * scale

    f_bias = jnp.linspace(3.0, 6.0, M_HEADS, dtype=jnp.float32)
    mlstm_gate_b = jnp.concatenate([
        nrm(ks[8], (DEPTH, M_HEADS), 0.1),
        f_bias + nrm(ks[9], (DEPTH, M_HEADS), 0.1),
        nrm(ks[10], (DEPTH, M_HEADS), 0.1),
        f_bias + nrm(ks[11], (DEPTH, M_HEADS), 0.1)], axis=-1)
    return {
        'x': nrm(ks[0], (BATCH, SEQ, D), 1.0),
        'c': nrm(ks[1], (BATCH, D), 1.0),
        'ctx': nrm(ks[2], (BATCH, CTX_LEN, D), 1.0),
        'c_ctx': nrm(ks[3], (D,), 1.0),
        'ada_w': nrm(ks[4], (DEPTH, D, 6 * D), 0.5 * D ** -0.5),
        'ada_b': nrm(ks[5], (DEPTH, 6 * D), 0.02),
        'norm1_w': 1.0 + nrm(ks[6], (DEPTH, D), 0.02),
        'norm2_w': 1.0 + nrm(ks[7], (DEPTH, D), 0.02),
        'w_in': nrm(ks[12], (DEPTH, D, D_IN), D ** -0.5),
        'mlstm_gate_b': mlstm_gate_b,
        'mlstm_norm_w': 1.0 + nrm(ks[13], (DEPTH, M_HEADS * M_DV), 0.02),
        'q_norm_w': 1.0 + nrm(ks[14], (DEPTH, A_DH), 0.02),
        'k_norm_w': 1.0 + nrm(ks[15], (DEPTH, A_DH), 0.02),
        'w_out': nrm(ks[16], (DEPTH, MIX_WIDTH, D), MIX_WIDTH ** -0.5),
        'ffn_w_gate': nrm(ks[17], (n_dense, D, D_FF), D ** -0.5),
        'ffn_w_up': nrm(ks[18], (n_dense, D, D_FF), D ** -0.5),
        'ffn_w_down': nrm(ks[19], (n_dense, D_FF, D), D_FF ** -0.5),
        'moe_router': nrm(ks[20], (n_moe, D, N_EXPERTS), D ** -0.5),
        'moe_w_gate': nrm(ks[21], (n_moe, N_EXPERTS, D, D_FF_EXPERT), D ** -0.5),
        'moe_w_up': nrm(ks[22], (n_moe, N_EXPERTS, D, D_FF_EXPERT), D ** -0.5),
        'moe_w_down': nrm(ks[23], (n_moe, N_EXPERTS, D_FF_EXPERT, D), D_FF_EXPERT ** -0.5),
        'final_norm_w': 1.0 + nrm(ks[24], (D,), 0.02),
    }


def reference(x, c, ctx, c_ctx, ada_w, ada_b, norm1_w, norm2_w, w_in, mlstm_gate_b, mlstm_norm_w,
              q_norm_w, k_norm_w, w_out, ffn_w_gate, ffn_w_up, ffn_w_down, moe_router, moe_w_gate,
              moe_w_up, moe_w_down, final_norm_w):
    rope = _rope_tables(x.shape[1])
    silu_c = jax.nn.silu(c)
    silu_cc = jax.nn.silu(c_ctx)
    for i in range(DEPTH):
        need_ctx = i < DEPTH - 1
        mod_x = [m[:, None, :] for m in jnp.split(silu_c @ ada_w[i] + ada_b[i], 6, axis=-1)]
        mod_c = jnp.split(silu_cc @ ada_w[i] + ada_b[i], 6, axis=-1)
        hx = _modulate(_rms(x, norm1_w[i]), mod_x[0], mod_x[1])
        hc = _modulate(_rms(ctx, norm1_w[i]), mod_c[0], mod_c[1])
        y_x, y_c = _mixer(hx @ w_in[i], hc @ w_in[i], rope, mlstm_gate_b[i], mlstm_norm_w[i],
                          q_norm_w[i], k_norm_w[i], need_ctx)
        x = x + mod_x[2] * (y_x @ w_out[i])
        if i % 2 == 0:
            ffn = lambda h, j=i // 2: _swiglu(h, ffn_w_gate[j], ffn_w_up[j], ffn_w_down[j])
        else:
            ffn = lambda h, j=i // 2: _moe(h, moe_router[j], moe_w_gate[j], moe_w_up[j], moe_w_down[j])
        x = x + mod_x[5] * ffn(_modulate(_rms(x, norm2_w[i]), mod_x[3], mod_x[4]))
        if need_ctx:
            ctx = ctx + mod_c[2] * (y_c @ w_out[i])
            ctx = ctx + mod_c[5] * ffn(_modulate(_rms(ctx, norm2_w[i]), mod_c[3], mod_c[4]))
    return _rms(x, final_norm_w)
```

```cpp
#include <hip/hip_runtime.h>
#include <hip/hip_bf16.h>
#include <cstdio>
#include <cstdint>
#include <cmath>
namespace pg8 {
#define PG8_LAS __attribute__((address_space(3)))
typedef unsigned short bf16_t;
typedef short bf16x8 __attribute__((ext_vector_type(8)));
typedef float f32x4 __attribute__((ext_vector_type(4)));
typedef unsigned u32x4 __attribute__((ext_vector_type(4)));
constexpr int BM = 256, BK = 64, HALF = 128, HTB = HALF * BK * 2  , STAGE_BYTES = 8 * HTB, NXCD = 8, WGM = 8;

__host__ __device__ __forceinline__ int lds_byte(int r, int c) { const int st = (r >> 4) * 2 + (c >> 5), rr = r & 15, cc = c & 31, ob = rr * 64 + cc * 2; return st * 1024 + (ob ^ (((ob >> 9) & 1) << 5)); }
__host__ __device__ __forceinline__ void stage_rc(int b, int& R, int& C) { const int st = b / 1024, sb = b % 1024, swz = sb ^ (((sb >> 9) & 1) << 5); R = (st >> 1) * 16 + swz / 64; C = (st & 1) * 32 + (swz % 64) / 2; }
__host__ __device__ __forceinline__ int perm32(int rho) { const int n = rho >> 4, i = rho & 15; return 8 * (i >> 2) + 4 * n + (i & 3); }

struct Unit { int pm, pn; };
struct Gemm { const bf16_t* A; const bf16_t* Bt; int M, N, K; };

struct StaticOrder {
    int nM, nN, nwg, G, c;
    __host__ __device__ void init(int M, int N, int G_, int c_) { nM = M / BM; nN = N / BM; nwg = nM * nN; G = G_; c = c_; }
    __host__ __device__ bool next(int i, Unit& u) const {
        const long L = (long)i * G + c; if (L >= nwg) return false;
        int wgid = (int)L; { const int q = nwg / NXCD, r = nwg % NXCD, xcd = wgid % NXCD, off = wgid / NXCD; wgid = (xcd < r ? xcd * (q + 1) : r * (q + 1) + (xcd - r) * q) + off; }
        const int nig = WGM * nN, gid = wgid / nig, fm = gid * WGM, gsz = (nM - fm) < WGM ? (nM - fm) : WGM;
        u.pm = fm + ((wgid % nig) % gsz); u.pn = (wgid % nig) / gsz; return true;
    }
    __device__ __forceinline__ void a_ready(const Unit&) const {}
    __device__ __forceinline__ void done(const Unit&) const {}
};

__device__ __forceinline__ unsigned cvt_pk_bf16(float lo, float hi) { unsigned r; asm volatile("v_cvt_pk_bf16_f32 %0, %1, %2" : "=v"(r) : "v"(lo), "v"(hi)); return r; }
typedef float f32x2 __attribute__((ext_vector_type(2)));
__device__ __forceinline__ f32x2 gelu_pk(f32x2 v) {
    const f32x2 av = __builtin_elementwise_abs(v), d = av * 0.2316418882f + 1.0f;
    f32x2 t; t.x = __builtin_amdgcn_rcpf(d.x); t.y = __builtin_amdgcn_rcpf(d.y);
    f32x2 q = t * 0.5307027145f + (-0.7265760135f); q = q * t + 0.7107068705f; q = q * t + (-0.142248368f); q = q * t + 0.127414796f; q = q * t;
    const f32x2 s = (v * v) * (-0.72134752044f);
    f32x2 e; e.x = __builtin_amdgcn_exp2f(s.x); e.y = __builtin_amdgcn_exp2f(s.y);
    const f32x2 m = v * (q * e), r = v - m;
    f32x2 o; o.x = v.x < 0.f ? m.x : r.x; o.y = v.y < 0.f ? m.y : r.y; return o;
}

template <int ACT  > struct EpiBf16 {
    static constexpr bool PERM = true, AFTER_DRAIN = false; static_assert(ACT == 0 || ACT == 1, "EpiBf16: ACT is 0 (none) or 1 (gelu_pk)");
    bf16_t* O; int ldc; const float* bias; int split_cols; size_t split_stride; float scale0;
    __device__ __forceinline__ void operator()(const f32x4 (&acc)[2][2][4][2], const Unit& u, int wr, int wc, int fr, int fq) const {
        const int row0 = u.pm * BM + wr * 64 + fr; int colt = u.pn * BM; bf16_t* base = O;
        float sc = 1.f; if (split_cols) { const int t = colt / split_cols; base += (size_t)t * split_stride; colt -= t * split_cols; if (t == 0) sc = scale0; }
        const int col0 = colt + wc * 32 + 8 * fq, bcol0 = u.pn * BM + wc * 32 + 8 * fq;
        f32x4 bv[2][2];
#pragma unroll
        for (int bj = 0; bj < 2; ++bj)
#pragma unroll
            for (int n = 0; n < 2; ++n) bv[bj][n] = bias ? *(const f32x4*)(bias + bcol0 + bj * HALF + 4 * n) : (f32x4){0.f, 0.f, 0.f, 0.f};
#pragma unroll
        for (int ai = 0; ai < 2; ++ai)
#pragma unroll
            for (int m = 0; m < 4; ++m) { bf16_t* rowp = base + (size_t)(row0 + ai * HALF + m * 16) * ldc + col0;
#pragma unroll
                for (int bj = 0; bj < 2; ++bj) { f32x4 v0 = acc[ai][bj][m][0] + bv[bj][0], v1 = acc[ai][bj][m][1] + bv[bj][1];
                    if (ACT == 1) { f32x2 a = gelu_pk((f32x2){v0[0], v0[1]}), b = gelu_pk((f32x2){v0[2], v0[3]}), c = gelu_pk((f32x2){v1[0], v1[1]}), d = gelu_pk((f32x2){v1[2], v1[3]});
                        v0 = (f32x4){a.x, a.y, b.x, b.y}; v1 = (f32x4){c.x, c.y, d.x, d.y}; }
                    v0 = v0 * sc; v1 = v1 * sc; u32x4 w; w.x = cvt_pk_bf16(v0[0], v0[1]); w.y = cvt_pk_bf16(v0[2], v0[3]); w.z = cvt_pk_bf16(v1[0], v1[1]); w.w = cvt_pk_bf16(v1[2], v1[3]);
                    *(u32x4*)(rowp + bj * HALF) = w; } }
    }
};

struct PanelStats {
    unsigned* xbuf;
    unsigned* cnt;
    unsigned* tmo;
    int ntn; float eps;
    unsigned code;
    __device__ __forceinline__ bool run(const f32x4 (&v)[2][2][4][2], const Unit& u, int wr, int wc, int fr, int fq, PG8_LAS unsigned char* lds, int wid, int lane) const {
        typedef float f32x2v __attribute__((ext_vector_type(2)));
        PG8_LAS f32x2v* P = (PG8_LAS f32x2v*)lds;
        PG8_LAS f32x2v* S = (PG8_LAS f32x2v*)(lds + 8192);
        PG8_LAS unsigned* flag = (PG8_LAS unsigned*)(lds + 8192 + 2048);
#pragma unroll
        for (int ai = 0; ai < 2; ++ai)
#pragma unroll
            for (int m = 0; m < 4; ++m) {
                float s = 0.f;
#pragma unroll
                for (int bj = 0; bj < 2; ++bj)
#pragma unroll
                    for (int n = 0; n < 2; ++n) { const f32x4 x = v[ai][bj][m][n]; s += (x[0] + x[1]) + (x[2] + x[3]); }
                s += __shfl_xor(s, 16); s += __shfl_xor(s, 32);
                const float mw = s * (1.0f / 64.0f); float q = 0.f;
#pragma unroll
                for (int bj = 0; bj < 2; ++bj)
#pragma unroll
                    for (int n = 0; n < 2; ++n) { const f32x4 d = v[ai][bj][m][n] - mw; q += (d[0] * d[0] + d[1] * d[1]) + (d[2] * d[2] + d[3] * d[3]); }
                q += __shfl_xor(q, 16); q += __shfl_xor(q, 32);
                if (fq == 0) P[(ai * HALF + wr * 64 + m * 16 + fr) * 4 + wc] = (f32x2v){mw, q};
            }
        asm volatile("s_waitcnt lgkmcnt(0)" ::: "memory"); __builtin_amdgcn_s_barrier(); asm volatile("" ::: "memory");
#if defined(BROKEN_EXCHANGE_NO_WAIT)
#warning BROKEN CONTROL BUILD: the row-statistics exchange does not wait; results are wrong by design
        if (blockIdx.x >= 64) { const long long t0_ = clock64(); while (clock64() - t0_ < 60000) __builtin_amdgcn_s_sleep(8); }
#endif
        const int row = wid * 32 + (lane & 31);
        if (lane < 32) {
            const f32x2v a = P[row * 4 + 0], b = P[row * 4 + 1], c = P[row * 4 + 2], d = P[row * 4 + 3];
            const float mt = (a.x + b.x + c.x + d.x) * 0.25f;
            const float da = a.x - mt, db = b.x - mt, dc = c.x - mt, dd = d.x - mt;
            const float m2 = (a.y + b.y) + (c.y + d.y) + 64.0f * ((da * da + db * db) + (dc * dc + dd * dd));
            unsigned long long* slot = (unsigned long long*)xbuf + ((size_t)(u.pm * BM + row) * 4 + u.pn);
            __hip_atomic_store(slot, ((unsigned long long)__float_as_uint(m2) << 32) | __float_as_uint(mt), __ATOMIC_RELAXED, __HIP_MEMORY_SCOPE_AGENT);
        }
        asm volatile("s_waitcnt vmcnt(0)" ::: "memory");
        if (lane == 0) __hip_atomic_fetch_add(cnt + 64 * u.pm, 1u, __ATOMIC_RELAXED, __HIP_MEMORY_SCOPE_AGENT);
        if (wid == 0) {
            bool dead = false; const unsigned long long t0 = __builtin_amdgcn_s_memrealtime(); const unsigned want = 8u * (unsigned)ntn;
            for (;;) {
#if defined(BROKEN_EXCHANGE_NO_WAIT)
                break;
#endif
                if ((unsigned)__builtin_amdgcn_readfirstlane(__hip_atomic_load(cnt + 64 * u.pm, __ATOMIC_RELAXED, __HIP_MEMORY_SCOPE_AGENT)) >= want) break;
                if (__builtin_amdgcn_s_memrealtime() - t0 > 2000000ull) {
                    if (lane == 0) { unsigned expect = 0u; __hip_atomic_compare_exchange_strong(tmo + 1, &expect, code | (unsigned)(u.pm & 0xff), __ATOMIC_RELAXED, __ATOMIC_RELAXED, __HIP_MEMORY_SCOPE_AGENT);
                                     __hip_atomic_store(tmo, 1u, __ATOMIC_RELAXED, __HIP_MEMORY_SCOPE_AGENT); }
                    dead = true; break; }
                __builtin_amdgcn_s_sleep(2);
            }
            __builtin_amdgcn_fence(__ATOMIC_ACQUIRE, "agent");
            if (lane == 0) flag[0] = dead ? 1u : 0u;
        }
        asm volatile("s_waitcnt vmcnt(0) lgkmcnt(0)" ::: "memory"); __builtin_amdgcn_s_barrier(); asm volatile("" ::: "memory");
        const bool bad = flag[0] != 0u;
        if (lane < 32) {
            const unsigned long long* slot = (const unsigned long long*)xbuf + (size_t)(u.pm * BM + row) * 4; float mt[4], m2[4]; float ms = 0.f;
#pragma unroll
            for (int t = 0; t < 4; ++t) { if (t < ntn) { const unsigned long long w = __hip_atomic_load(slot + t, __ATOMIC_RELAXED, __HIP_MEMORY_SCOPE_AGENT); mt[t] = __uint_as_float((unsigned)w); m2[t] = __uint_as_float((unsigned)(w >> 32)); } else { mt[t] = 0.f; m2[t] = 0.f; } ms += mt[t]; }
            const float mean = ms / (float)ntn; float q = 0.f;
#pragma unroll
            for (int t = 0; t < 4; ++t) if (t < ntn) { const float dm = mt[t] - mean; q += m2[t] + 256.0f * dm * dm; }
            S[row] = (f32x2v){mean, 1.0f / sqrtf(q / (256.0f * (float)ntn) + eps)};
        }
        asm volatile("s_waitcnt lgkmcnt(0)" ::: "memory"); __builtin_amdgcn_s_barrier(); asm volatile("" ::: "memory");
        return bad;
    }
};
struct EpiLnRes {
    static constexpr bool PERM = false, AFTER_DRAIN = true;
    const float* base; float* out; int ldc; const float* bias; PanelStats st; unsigned poison;
    __device__ __forceinline__ void fused(f32x4 (&acc)[2][2][4][2], const Unit& u, int wr, int wc, int fr, int fq, PG8_LAS unsigned char* lds, int wid, int lane) const {
        typedef float f32x2v __attribute__((ext_vector_type(2)));
        const PG8_LAS f32x2v* S = (const PG8_LAS f32x2v*)(lds + 8192);
        const int col0 = u.pn * BM + wc * 32 + 4 * fq;
#pragma unroll
        for (int bj = 0; bj < 2; ++bj)
#pragma unroll
            for (int n = 0; n < 2; ++n) { const f32x4 bv = bias ? *(const f32x4*)(bias + col0 + bj * HALF + n * 16) : (f32x4){0.f, 0.f, 0.f, 0.f};
#pragma unroll
                for (int ai = 0; ai < 2; ++ai)
#pragma unroll
                    for (int m = 0; m < 4; ++m) acc[ai][bj][m][n] += bv; }
        f32x4 pre[4][2][2];
#pragma unroll
        for (int m = 0; m < 4; ++m) { const size_t off = (size_t)(u.pm * BM + wr * 64 + m * 16 + fr) * ldc + col0;
#pragma unroll
            for (int bj = 0; bj < 2; ++bj)
#pragma unroll
                for (int n = 0; n < 2; ++n) pre[m][bj][n] = *(const f32x4*)(base + off + bj * HALF + n * 16); }
        const bool bad = st.run(acc, u, wr, wc, fr, fq, lds, wid, lane) || poison != 0u;
        const float qnan = __builtin_nanf("");
#pragma unroll
        for (int ai = 0; ai < 2; ++ai)
#pragma unroll
            for (int m = 0; m < 4; ++m) { const int r = ai * HALF + wr * 64 + m * 16 + fr; const f32x2v sr = S[r]; const size_t off = (size_t)(u.pm * BM + r) * ldc + col0;
#pragma unroll
                for (int bj = 0; bj < 2; ++bj)
#pragma unroll
                    for (int n = 0; n < 2; ++n) { const f32x4 bs = ai == 0 ? pre[m][bj][n] : *(const f32x4*)(base + off + bj * HALF + n * 16); f32x4 o = bs + (acc[ai][bj][m][n] - sr.x) * sr.y;
                        if (bad) o = (f32x4){qnan, qnan, qnan, qnan}; *(f32x4*)(out + off + bj * HALF + n * 16) = o; }
                if (m & 1) asm volatile("" ::: "memory"); }
    }
};
struct EpiLnResLn {
    static constexpr bool PERM = false, AFTER_DRAIN = true;
    const float* base; float* out; bf16_t* xn; int ldc; const float* bias; PanelStats st1, st2; unsigned poison;
    __device__ __forceinline__ void fused(f32x4 (&acc)[2][2][4][2], const Unit& u, int wr, int wc, int fr, int fq, PG8_LAS unsigned char* lds, int wid, int lane) const {
        typedef float f32x2v __attribute__((ext_vector_type(2))); typedef unsigned u32x2v __attribute__((ext_vector_type(2)));
        const PG8_LAS f32x2v* S = (const PG8_LAS f32x2v*)(lds + 8192);
        const int col0 = u.pn * BM + wc * 32 + 4 * fq;
#pragma unroll
        for (int bj = 0; bj < 2; ++bj)
#pragma unroll
            for (int n = 0; n < 2; ++n) { const f32x4 bv = bias ? *(const f32x4*)(bias + col0 + bj * HALF + n * 16) : (f32x4){0.f, 0.f, 0.f, 0.f};
#pragma unroll
                for (int ai = 0; ai < 2; ++ai)
#pragma unroll
                    for (int m = 0; m < 4; ++m) acc[ai][bj][m][n] += bv; }
        bool bad = st1.run(acc, u, wr, wc, fr, fq, lds, wid, lane) || poison != 0u;
        const float qnan = __builtin_nanf("");
#pragma unroll
        for (int ai = 0; ai < 2; ++ai)
#pragma unroll
            for (int m = 0; m < 4; ++m) { const int r = ai * HALF + wr * 64 + m * 16 + fr; const f32x2v sr = S[r]; const size_t off = (size_t)(u.pm * BM + r) * ldc + col0;
#pragma unroll
                for (int bj = 0; bj < 2; ++bj)
#pragma unroll
                    for (int n = 0; n < 2; ++n) { const f32x4 bs = *(const f32x4*)(base + off + bj * HALF + n * 16); acc[ai][bj][m][n] = bs + (acc[ai][bj][m][n] - sr.x) * sr.y; }
                asm volatile("" : "+v"(acc[ai][0][m][0]), "+v"(acc[ai][0][m][1]), "+v"(acc[ai][1][m][0]), "+v"(acc[ai][1][m][1]));
                if (m & 1) asm volatile("" ::: "memory"); }
        const bool bad1 = bad;
        bad = st2.run(acc, u, wr, wc, fr, fq, lds, wid, lane) || bad;
#pragma unroll
        for (int ai = 0; ai < 2; ++ai)
#pragma unroll
            for (int m = 0; m < 4; ++m) { const int r = ai * HALF + wr * 64 + m * 16 + fr; const f32x2v sr = S[r]; const size_t off = (size_t)(u.pm * BM + r) * ldc + col0;
#pragma unroll
                for (int bj = 0; bj < 2; ++bj)
#pragma unroll
                    for (int n = 0; n < 2; ++n) { const f32x4 x1 = acc[ai][bj][m][n]; *(f32x4*)(out + off + bj * HALF + n * 16) = bad1 ? (f32x4){qnan, qnan, qnan, qnan} : x1;
                        const f32x4 o = (x1 - sr.x) * sr.y; u32x2v w; w.x = cvt_pk_bf16(o[0], o[1]); w.y = cvt_pk_bf16(o[2], o[3]);
                        if (bad) { w.x = 0x7fc07fc0u; w.y = 0x7fc07fc0u; } *(u32x2v*)(xn + off + bj * HALF + n * 16) = w; }
                asm volatile("" ::: "memory"); }
    }
};

template <class Epi, class Sched, bool ALIGN_EPI = false, bool SP2 = false>
__device__ __forceinline__ void gemm_phase(PG8_LAS unsigned char* lds, const Gemm g, const Sched& S, const Epi& E) {
    int tid_ = threadIdx.x; asm volatile("" : "+v"(tid_));
    const int tid = tid_, wid = __builtin_amdgcn_readfirstlane(tid >> 6), lane = tid & 63, wr = wid >> 2, wc = wid & 3, fr = lane & 15, fq = lane >> 4;
    const int K = g.K, nt = K / BK;
    unsigned voffA[2], voffB[2];
#pragma unroll
    for (int i = 0; i < 2; ++i) { int R, C; stage_rc(tid * 16 + i * 8192, R, C); const int Rb = Epi::PERM ? ((R & ~31) + perm32(R & 31)) : R;
        voffA[i] = (unsigned)(R * K + C) * 2u; voffB[i] = (unsigned)(Rb * K + C) * 2u; }
    const size_t kstep = (size_t)(BK * 2);
    const size_t hstep = (size_t)HALF * K * 2;
    const size_t tstep = 2 * hstep;
    const unsigned ldsw = (unsigned)wid * 1024u;
    const int aoff = lds_byte(wr * 64 + fr, fq * 8), boff = lds_byte(wc * 32 + fr, fq * 8);
#define PG8_SA(b, h) (((b) * 2 + (h)) * HTB)
#define PG8_SB(b, h) ((4 + (b) * 2 + (h)) * HTB)
#define PG8_STAGE(bufoff, gbase, voff) do { _Pragma("unroll") for (int _i = 0; _i < 2; ++_i) \
        __builtin_amdgcn_global_load_lds((const unsigned*)((const char*)(gbase) + (voff)[_i]), (PG8_LAS unsigned*)(lds + (bufoff) + ldsw + _i * 8192), 16, 0, 0); } while (0)
#define PG8_LDA(dst, b, h) do { _Pragma("unroll") for (int m = 0; m < 4; ++m) _Pragma("unroll") for (int k = 0; k < 2; ++k) dst[m][k] = *(const PG8_LAS bf16x8*)(lds + PG8_SA(b, h) + aoff + m * 2048 + k * 1024); } while (0)
#define PG8_LDB(dst, b, h) do { _Pragma("unroll") for (int n = 0; n < 2; ++n) _Pragma("unroll") for (int k = 0; k < 2; ++k) dst[n][k] = *(const PG8_LAS bf16x8*)(lds + PG8_SB(b, h) + boff + n * 2048 + k * 1024); } while (0)
#define PG8_MMA(ai, bj, At, Bt) do { __builtin_amdgcn_s_setprio(1); _Pragma("unroll") for (int m = 0; m < 4; ++m) _Pragma("unroll") for (int n = 0; n < 2; ++n) _Pragma("unroll") for (int k = 0; k < 2; ++k) \
        acc[ai][bj][m][n] = __builtin_amdgcn_mfma_f32_16x16x32_bf16(Bt[n][k], At[m][k], acc[ai][bj][m][n], 0, 0, 0); __builtin_amdgcn_s_setprio(0); } while (0)
#define PG8_WAIT_V(n) asm volatile("s_waitcnt vmcnt(" #n ")" ::: "memory")
#define PG8_WAIT_L(n) asm volatile("s_waitcnt lgkmcnt(" #n ")" ::: "memory")
#define PG8_BAR __builtin_amdgcn_s_barrier()
#define PG8_SCHED __builtin_amdgcn_sched_barrier(0)
    Unit cur, nxt; int ui = 0;
    if (!S.next(0, cur)) return;
    f32x4 acc[2][2][4][2];
#pragma unroll
    for (int a = 0; a < 2; ++a)
#pragma unroll
        for (int b = 0; b < 2; ++b)
#pragma unroll
            for (int m = 0; m < 4; ++m)
#pragma unroll
                for (int n = 0; n < 2; ++n) acc[a][b][m][n] = (f32x4){0.f, 0.f, 0.f, 0.f};
    bf16x8 At[4][2], B0[2][2], B1[2][2];
    const char* cA = (const char*)g.A + (size_t)cur.pm * tstep; const char* cB = (const char*)g.Bt + (size_t)cur.pn * tstep;
    S.a_ready(cur);
    if constexpr (SP2) {
        PG8_STAGE(PG8_SB(0, 0), cB, voffB); PG8_STAGE(PG8_SB(0, 1), cB + hstep, voffB); PG8_STAGE(PG8_SA(0, 0), cA, voffA); PG8_STAGE(PG8_SA(0, 1), cA + hstep, voffA);
        if (wr == 1) PG8_BAR;
        PG8_WAIT_V(2); PG8_BAR;
        PG8_STAGE(PG8_SB(1, 0), cB + kstep, voffB); PG8_STAGE(PG8_SA(1, 0), cA + kstep, voffA); PG8_STAGE(PG8_SB(1, 1), cB + hstep + kstep, voffB);
        PG8_WAIT_V(6); PG8_BAR;
    } else {
        PG8_STAGE(PG8_SB(0, 0), cB, voffB); PG8_STAGE(PG8_SA(0, 0), cA, voffA); PG8_STAGE(PG8_SB(0, 1), cB + hstep, voffB); PG8_STAGE(PG8_SA(0, 1), cA + hstep, voffA);
        if (wr == 1) PG8_BAR;
        PG8_WAIT_V(4); PG8_BAR;
        PG8_STAGE(PG8_SB(1, 0), cB + kstep, voffB); PG8_STAGE(PG8_SA(1, 0), cA + kstep, voffA); PG8_STAGE(PG8_SB(1, 1), cB + hstep + kstep, voffB);
        PG8_WAIT_V(6); PG8_BAR;
    }
    for (;;) {
        const bool has_next = S.next(ui + 1, nxt);
        const char* nA = has_next ? (const char*)g.A + (size_t)nxt.pm * tstep : cA; const char* nB = has_next ? (const char*)g.Bt + (size_t)nxt.pn * tstep : cB;
        for (int t = 0; t < nt; t += 2) {
            const bool last = (t == nt - 2);
            const char* a1 = cA + (size_t)(t + 1) * kstep;
            const char* a2 = last ? nA : cA + (size_t)(t + 2) * kstep; const char* b2 = last ? nB : cB + (size_t)(t + 2) * kstep;
            const char* a3 = a2 + kstep; const char* b3 = b2 + kstep;
            if (last && has_next) S.a_ready(nxt);
            if constexpr (SP2) {
            PG8_LDB(B0, 0, 0); PG8_LDB(B1, 0, 1); PG8_SCHED; PG8_LDA(At, 0, 0); PG8_STAGE(PG8_SA(1, 1), a1 + hstep, voffA);
            PG8_WAIT_V(8); PG8_WAIT_L(0); PG8_BAR; PG8_MMA(0, 0, At, B0); PG8_MMA(0, 1, At, B1); PG8_BAR; PG8_SCHED;
            PG8_LDA(At, 0, 1); PG8_STAGE(PG8_SB(0, 0), b2, voffB); PG8_STAGE(PG8_SB(0, 1), b2 + hstep, voffB); PG8_STAGE(PG8_SA(0, 0), a2, voffA);
            PG8_WAIT_V(8); PG8_WAIT_L(0); PG8_BAR; PG8_MMA(1, 0, At, B0); PG8_MMA(1, 1, At, B1); PG8_BAR; PG8_SCHED;
            PG8_LDB(B0, 1, 0); PG8_LDB(B1, 1, 1); PG8_SCHED; PG8_LDA(At, 1, 0); PG8_STAGE(PG8_SA(0, 1), a2 + hstep, voffA);
            PG8_WAIT_V(8); PG8_WAIT_L(0); PG8_BAR; PG8_MMA(0, 0, At, B0); PG8_MMA(0, 1, At, B1); PG8_BAR; PG8_SCHED;
            PG8_LDA(At, 1, 1); PG8_STAGE(PG8_SB(1, 0), b3, voffB); PG8_STAGE(PG8_SB(1, 1), b3 + hstep, voffB); PG8_STAGE(PG8_SA(1, 0), a3, voffA);
            PG8_WAIT_V(8); PG8_WAIT_L(0); PG8_BAR; PG8_MMA(1, 0, At, B0); PG8_MMA(1, 1, At, B1); PG8_BAR; PG8_SCHED;
            } else {
            PG8_LDB(B0, 0, 0); PG8_SCHED; PG8_LDA(At, 0, 0); PG8_STAGE(PG8_SA(1, 1), a1 + hstep, voffA);
            PG8_WAIT_L(8); PG8_BAR; PG8_WAIT_L(0); PG8_MMA(0, 0, At, B0); PG8_BAR; PG8_SCHED;
            PG8_LDB(B1, 0, 1); PG8_STAGE(PG8_SB(0, 0), b2, voffB);
            PG8_BAR; PG8_WAIT_L(0); PG8_MMA(0, 1, At, B1); PG8_BAR;
            PG8_LDA(At, 0, 1); PG8_STAGE(PG8_SA(0, 0), a2, voffA);
            PG8_BAR; PG8_WAIT_L(0); PG8_MMA(1, 0, At, B0); PG8_BAR; PG8_SCHED;
            PG8_STAGE(PG8_SB(0, 1), b2 + hstep, voffB);
            PG8_WAIT_V(6); PG8_BAR; PG8_MMA(1, 1, At, B1); PG8_BAR;
            PG8_LDB(B0, 1, 0); PG8_SCHED; PG8_LDA(At, 1, 0); PG8_STAGE(PG8_SA(0, 1), a2 + hstep, voffA);
            PG8_WAIT_L(8); PG8_BAR; PG8_WAIT_L(0); PG8_MMA(0, 0, At, B0); PG8_BAR; PG8_SCHED;
            PG8_LDB(B1, 1, 1); PG8_STAGE(PG8_SB(1, 0), b3, voffB);
            PG8_BAR; PG8_WAIT_L(0); PG8_MMA(0, 1, At, B1); PG8_BAR;
            PG8_LDA(At, 1, 1); PG8_STAGE(PG8_SA(1, 0), a3, voffA);
            PG8_BAR; PG8_WAIT_L(0); PG8_MMA(1, 0, At, B0); PG8_BAR; PG8_SCHED;
            PG8_STAGE(PG8_SB(1, 1), b3 + hstep, voffB);
            PG8_WAIT_V(6); PG8_BAR; PG8_MMA(1, 1, At, B1); PG8_BAR;
            }
        }
        if constexpr (ALIGN_EPI) { if (wr == 0) PG8_BAR; }
        if constexpr (!Epi::AFTER_DRAIN) { E(acc, cur, wr, wc, fr, fq); S.done(cur); }
        if (!has_next) break;
#pragma unroll
        for (int a = 0; a < 2; ++a)
#pragma unroll
            for (int b = 0; b < 2; ++b)
#pragma unroll
                for (int m = 0; m < 4; ++m)
#pragma unroll
                    for (int n = 0; n < 2; ++n) acc[a][b][m][n] = (f32x4){0.f, 0.f, 0.f, 0.f};
        cur = nxt; cA = nA; cB = nB; ++ui;
        if constexpr (ALIGN_EPI) { if (wr == 1) PG8_BAR; }
    }
    PG8_WAIT_V(0);
    if constexpr (!ALIGN_EPI) { if (wr == 0) PG8_BAR; }
    PG8_BAR;
    if constexpr (Epi::AFTER_DRAIN) { E.fused(acc, cur, wr, wc, fr, fq, lds, wid, lane); S.done(cur); }
#undef PG8_SA
#undef PG8_SB
#undef PG8_STAGE
#undef PG8_LDA
#undef PG8_LDB
#undef PG8_MMA
#undef PG8_WAIT_V
#undef PG8_WAIT_L
#undef PG8_BAR
#undef PG8_SCHED
}
}
namespace attn_body {
using bf16=__hip_bfloat16;
using bf16x8=__attribute__((ext_vector_type(8)))short;
using s16x4=__attribute__((ext_vector_type(4)))short;
using f32x16=__attribute__((ext_vector_type(16)))float;
using u32x4=__attribute__((ext_vector_type(4)))unsigned;
constexpr int D=64;
constexpr int NW=8,QBLK=32,QB=QBLK*NW,KVBLK=64;
constexpr int QP=512,KP=128,VP=2304,OP=1024;
constexpr int ATTN_UNIT_ROWS=QB;
__device__ __forceinline__ int crow(int r,int hi){return (r&3)+8*(r>>2)+4*hi;}
#define SBAR() __builtin_amdgcn_sched_barrier(0)
__device__ __forceinline__ void cmask(f32x16&p0,f32x16&p1,int jb,int qrel,int hi){
  const float NEG=-INFINITY; int kb=64*jb+4*hi;
  #pragma unroll
  for(int r=0;r<16;++r){int kv=kb+(r&3)+8*(r>>2); if(kv>qrel)p0[r]=NEG; if(kv+32>qrel)p1[r]=NEG;}
}

constexpr int NSLOT=3, SLOTB=8192;
constexpr int LDS_K=0, LDS_V=NSLOT*SLOTB, LDS_WS=2*NSLOT*SLOTB, LDS_OST=LDS_WS+NW*64*4, LDS_BYTES=LDS_OST+NW*4096;
constexpr float C2=0.125f*1.4426950408889634f;
__device__ __forceinline__ void glds16(const void*gsrc,unsigned lds_dst){unsigned keep;
  asm volatile("s_mov_b32 %0, m0\n\ts_mov_b32 m0, %2\n\ts_nop 0\n\tglobal_load_lds_dwordx4 %1, off\n\ts_mov_b32 m0, %0":"=&s"(keep):"v"(gsrc),"s"(lds_dst):"memory");}
__device__ __forceinline__ float max3f(float a,float b,float c){float r;asm("v_max3_f32 %0, %1, %2, %3":"=v"(r):"v"(a),"v"(b),"v"(c));return r;}
__device__ __forceinline__ float max2f(float a,float b){float r;asm("v_max_f32_e32 %0, %1, %2":"=v"(r):"v"(a),"v"(b));return r;}
__device__ __forceinline__ float fadd_s(float a,float b){float r;asm("v_add_f32_e32 %0, %1, %2":"=v"(r):"v"(a),"v"(b));return r;}
__device__ __forceinline__ float fsub_s(float a,float b){float r;asm("v_sub_f32_e32 %0, %1, %2":"=v"(r):"v"(a),"v"(b));return r;}
typedef float f32x2_t __attribute__((ext_vector_type(2))); typedef __bf16 bf16x2_t __attribute__((ext_vector_type(2)));
__device__ __forceinline__ unsigned cvtpk_s(float lo,float hi){f32x2_t v={lo,hi};bf16x2_t b=__builtin_convertvector(v,bf16x2_t);return __builtin_bit_cast(unsigned,b);}
#define WAIT_BAR(N) asm volatile("s_waitcnt vmcnt(" #N ") lgkmcnt(0)\n\ts_barrier":::"memory")

__device__ __forceinline__ void qkt(f32x16&p0,f32x16&p1,const char*Kslot,const bf16x8*qr,const f32x16&negm,int r32,int hi){
  const char*kb=Kslot+hi*1024+r32*16;
  #pragma unroll
  for(int d0=0;d0<4;++d0){
    const bf16x8 b0=*reinterpret_cast<const bf16x8*>(kb+d0*2048);
    const bf16x8 b1=*reinterpret_cast<const bf16x8*>(kb+d0*2048+512);
    if(d0==0){p0=__builtin_amdgcn_mfma_f32_32x32x16_bf16(b0,qr[0],negm,0,0,0);p1=__builtin_amdgcn_mfma_f32_32x32x16_bf16(b1,qr[0],negm,0,0,0);}
    else{p0=__builtin_amdgcn_mfma_f32_32x32x16_bf16(b0,qr[d0],p0,0,0,0);p1=__builtin_amdgcn_mfma_f32_32x32x16_bf16(b1,qr[d0],p1,0,0,0);}}
}
typedef __attribute__((address_space(3))) const char* lds_cptr;
typedef short v4i16_t __attribute__((ext_vector_type(4)));
__device__ __forceinline__ void kload8(bf16x8*kf,lds_cptr kp){
  kf[0]=*(const __attribute__((address_space(3))) bf16x8*)(kp);      kf[1]=*(const __attribute__((address_space(3))) bf16x8*)(kp+512);
  kf[2]=*(const __attribute__((address_space(3))) bf16x8*)(kp+2048); kf[3]=*(const __attribute__((address_space(3))) bf16x8*)(kp+2560);
  kf[4]=*(const __attribute__((address_space(3))) bf16x8*)(kp+4096); kf[5]=*(const __attribute__((address_space(3))) bf16x8*)(kp+4608);
  kf[6]=*(const __attribute__((address_space(3))) bf16x8*)(kp+6144); kf[7]=*(const __attribute__((address_space(3))) bf16x8*)(kp+6656);
}
__device__ __forceinline__ void kload2(bf16x8*kf,lds_cptr kp,int j){ kf[2*j]=*(const __attribute__((address_space(3))) bf16x8*)(kp+j*2048); kf[2*j+1]=*(const __attribute__((address_space(3))) bf16x8*)(kp+j*2048+512); }
__device__ __forceinline__ s16x4 vtr(lds_cptr p){ return __builtin_bit_cast(s16x4,__builtin_amdgcn_ds_read_tr16_b64_v4i16((__attribute__((address_space(3))) v4i16_t*)p)); }
__device__ __forceinline__ float rowmax(const f32x16&p0,const f32x16&p1){
  float a=max3f(p0[0],p0[1],p1[0]),b=max3f(p0[2],p0[3],p1[1]);a=max3f(a,p1[2],p1[3]);
  #pragma unroll
  for(int r=4;r<16;r+=4){a=max3f(a,p0[r],p0[r+1]);b=max3f(b,p0[r+2],p0[r+3]);a=max3f(a,p1[r],p1[r+1]);b=max3f(b,p1[r+2],p1[r+3]);}
  const float m=max2f(a,b);
  auto rr=__builtin_amdgcn_permlane32_swap(__float_as_uint(m),__float_as_uint(m),false,false);
  return max2f(__uint_as_float(rr[0]),__uint_as_float(rr[1]));
}
__device__ __forceinline__ void pv(f32x16*o,int vb,bf16x8 pa0,bf16x8 pa1,bf16x8 pa2,bf16x8 pa3){
  #pragma unroll
  for(int d0=0;d0<2;++d0){s16x4 lo[4],hi[4];
    #pragma unroll
    for(int ks=0;ks<4;++ks){
      asm volatile("ds_read_b64_tr_b16 %0,%1 offset:%c2":"=&v"(lo[ks]):"v"(vb),"i"(d0*4096+ks*1024):"memory");
      asm volatile("ds_read_b64_tr_b16 %0,%1 offset:%c2":"=&v"(hi[ks]):"v"(vb),"i"(d0*4096+ks*1024+512):"memory");}
    asm volatile("s_waitcnt lgkmcnt(0)":::"memory");SBAR();
    #define PK(k) (bf16x8){lo[k][0],lo[k][1],lo[k][2],lo[k][3],hi[k][0],hi[k][1],hi[k][2],hi[k][3]}
    o[d0]=__builtin_amdgcn_mfma_f32_32x32x16_bf16(pa0,PK(0),o[d0],0,0,0);
    o[d0]=__builtin_amdgcn_mfma_f32_32x32x16_bf16(pa1,PK(1),o[d0],0,0,0);
    o[d0]=__builtin_amdgcn_mfma_f32_32x32x16_bf16(pa2,PK(2),o[d0],0,0,0);
    o[d0]=__builtin_amdgcn_mfma_f32_32x32x16_bf16(pa3,PK(3),o[d0],0,0,0);
    #undef PK
  }
}

#ifndef ATTN_STORE16
#define ATTN_STORE16(p,v) (*(u32x4*)(p)=(v))
#endif
template<int THRL> __device__ __forceinline__ void attn_unit(const bf16*Qh,const bf16*__restrict__ Kh,const bf16*__restrict__ Vh,bf16*Oh,const int NT,char*shm){
  int tid_=threadIdx.x; asm volatile("":"+v"(tid_)); const int tid=tid_,lane=tid&63,r32=lane&31,hi=lane>>5; const int wid=__builtin_amdgcn_readfirstlane(tid>>6);
  const bf16*Qw=Qh+(long)(wid*QBLK)*QP;
  const unsigned lds0=(unsigned)(uintptr_t)shm;
  float*wsf=(float*)(shm+LDS_WS)+wid*64;
  const bf16*ksrc=Kh+(long)lane*KP+wid*8;
  const bf16*vsrc=Vh+(long)(16*(wid&3)+(lane>>2))*VP+(wid>>2)*32+(lane&3)*8;
  const unsigned kdst=lds0+LDS_K+wid*1024, vdst=lds0+LDS_V+wid*1024;
  #define DMA_K(t,slot) glds16(ksrc+(long)(t)*KVBLK*KP,(unsigned)__builtin_amdgcn_readfirstlane(kdst+(slot)))
  #define DMA_V(t,slot) glds16(vsrc+(long)(t)*KVBLK*VP,(unsigned)__builtin_amdgcn_readfirstlane(vdst+(slot)))
  const int vb0=(int)(lds0+LDS_V)+((lane>>4)&1)*32+(lane&3)*8+(4*hi+((lane&15)>>2))*64;
  const char*Kbase=shm+LDS_K; bf16x8 kf[8];
  const lds_cptr shm3=(lds_cptr)shm; const lds_cptr kp0=shm3+LDS_K+hi*1024+r32*16; const lds_cptr vp0=shm3+LDS_V+((lane>>4)&1)*32+(lane&3)*8+(4*hi+((lane&15)>>2))*64;
  DMA_K(0,0);DMA_V(0,0);DMA_K(1,SLOTB);
  bf16x8 qr[4];
  #pragma unroll
  for(int d0=0;d0<4;++d0)qr[d0]=*reinterpret_cast<const bf16x8*>(&Qw[(long)r32*QP+d0*16+hi*8]);
  float mhat=0.f,l_reg=0.f;f32x16 o[2];o[0]=f32x16{};o[1]=f32x16{};f32x16 negm=f32x16{};asm volatile("":"+v"(negm));
  #define CMASK(P0,P1,t) do{}while(0)
  bool resc=false;
  #define START(P0,P1) do{ const float rm=rowmax(P0,P1); resc=false; \
    { const float dl=rm; mhat=fadd_s(mhat,dl); \
      _Pragma("unroll") for(int r=0;r<16;++r){P0[r]=fsub_s(P0[r],dl);P1[r]=fsub_s(P1[r],dl);} \
      _Pragma("unroll") for(int r=0;r<16;++r)negm[r]=-mhat; asm volatile("":"+v"(negm)); } \
    _Pragma("unroll") for(int r=0;r<16;++r)P0[r]=__builtin_amdgcn_exp2f(P0[r]); }while(0)
  #define RESC() do{ if(resc){ asm volatile("s_waitcnt lgkmcnt(0)":::"memory"); \
      _Pragma("unroll") for(int d_=0;d_<2;++d_) _Pragma("unroll") for(int r=0;r<16;++r)o[d_][r]*=wsf[crow(r,hi)]; } }while(0)
  f32x16 pA0,pA1,pB0,pB1;
  int sl_prev=0,sl_cur=0,sl_next=SLOTB;
  #define ROT() do{sl_prev=sl_cur;sl_cur=sl_next;sl_next=(sl_next==(NSLOT-1)*SLOTB)?0:sl_next+SLOTB;}while(0)
  DMA_K(2,2*SLOTB);
  WAIT_BAR(3);
  qkt(pA0,pA1,Kbase,qr,negm,r32,hi);asm volatile("s_nop 15\n\ts_nop 7":"+v"(pA0),"+v"(pA1));CMASK(pA0,pA1,0);
  START(pA0,pA1);
  _Pragma("unroll") for(int r=0;r<16;++r)pA1[r]=__builtin_amdgcn_exp2f(pA1[r]);
  WAIT_BAR(0);
  DMA_K(3,0);DMA_V(1,SLOTB);
  ROT();
  kload8(kf,kp0+sl_cur);
  WAIT_BAR(2);
  s16x4 vlo[8],vhi[8]; u32x4 pw0,pw1,pw2,pw3;
  #define PKW(P,B) cvtpk_s(P[B],P[B+1])
  #define PAF(k) __builtin_bit_cast(bf16x8,pw##k)
  #define VFR(i) (bf16x8){vlo[i][0],vlo[i][1],vlo[i][2],vlo[i][3],vhi[i][0],vhi[i][1],vhi[i][2],vhi[i][3]}
  #define PIN(x) asm volatile("":"+v"(x))
  #define MX3(a,b,c) __builtin_fmaxf(__builtin_fmaxf((a),(b)),(c))
  #define GAPA(MF,A0,A1,A2,A3,W0,W1,PW) do{ MF; sacc+=A0; sacc+=A1; sacc+=A2; sacc+=A3; PIN(sacc); W0; W1; PIN(PW); SBAR(); }while(0)
  #define EX(v) __builtin_amdgcn_exp2f(v)
  #define GAPB(MF,X,B) do{ MF; X[B]=EX(X[B]); X[B+1]=EX(X[B+1]); X[B+2]=EX(X[B+2]); X[B+3]=EX(X[B+3]); PIN(X); SBAR(); }while(0)
  #define VRD(i) do{ vlo[i]=vtr(vp_+(((i)>>2)*4096+((i)&3)*1024)); vhi[i]=vtr(vp_+(((i)>>2)*4096+((i)&3)*1024+512)); }while(0)
  #define KRD(G,j) do{ if(G){ kload2(kf,kp0+sl_next,j); SBAR(); } }while(0)
  #define STEP(C0,C1,P0,P1,t,GK,GV,GL) do{ SBAR(); \
    const lds_cptr vp_=vp0+sl_prev; \
    VRD(0); SBAR(); float sacc=(P0[0]+P0[1]); \
    GAPA(C0=__builtin_amdgcn_mfma_f32_32x32x16_bf16(kf[0],qr[0],negm,0,0,0), P0[2],P0[3],P0[4],P0[5],     pw0[0]=PKW(P0,0), pw0[1]=PKW(P0,2), pw0); \
    VRD(4); SBAR(); GAPA(C1=__builtin_amdgcn_mfma_f32_32x32x16_bf16(kf[1],qr[0],negm,0,0,0), P0[6],P0[7],P0[8],P0[9],     pw0[2]=PKW(P0,4), pw0[3]=PKW(P0,6), pw0); \
    VRD(1); SBAR(); GAPA(C0=__builtin_amdgcn_mfma_f32_32x32x16_bf16(kf[2],qr[1],C0,0,0,0),   P0[10],P0[11],P0[12],P0[13], pw1[0]=PKW(P0,8), pw1[1]=PKW(P0,10), pw1); \
    VRD(5); SBAR(); GAPA(C1=__builtin_amdgcn_mfma_f32_32x32x16_bf16(kf[3],qr[1],C1,0,0,0),   P0[14],P0[15],P1[0],P1[1],   pw1[2]=PKW(P0,12),pw1[3]=PKW(P0,14), pw1); \
    VRD(2); SBAR(); GAPA(C0=__builtin_amdgcn_mfma_f32_32x32x16_bf16(kf[4],qr[2],C0,0,0,0),   P1[2],P1[3],P1[4],P1[5],     pw2[0]=PKW(P1,0), pw2[1]=PKW(P1,2), pw2); \
    VRD(6); SBAR(); GAPA(C1=__builtin_amdgcn_mfma_f32_32x32x16_bf16(kf[5],qr[2],C1,0,0,0),   P1[6],P1[7],P1[8],P1[9],     pw2[2]=PKW(P1,4), pw2[3]=PKW(P1,6), pw2); \
    VRD(3); SBAR(); GAPA(C0=__builtin_amdgcn_mfma_f32_32x32x16_bf16(kf[6],qr[3],C0,0,0,0),   P1[10],P1[11],P1[12],P1[13], pw3[0]=PKW(P1,8), pw3[1]=PKW(P1,10), pw3); \
    VRD(7); SBAR(); GAPA(C1=__builtin_amdgcn_mfma_f32_32x32x16_bf16(kf[7],qr[3],C1,0,0,0),   P1[14],P1[15],0.f,0.f,       pw3[2]=PKW(P1,12),pw3[3]=PKW(P1,14), pw3); \
    l_reg+=sacc; \
    if(GK){DMA_K((t)+3,sl_cur);} if(GV){DMA_V((t)+1,sl_next);} \
    CMASK(C0,C1,t); \
    { float a=MX3(C0[0],C0[1],C1[0]),b=MX3(C0[2],C0[3],C1[1]); a=MX3(a,C1[2],C1[3]); \
      _Pragma("unroll") for(int r=4;r<16;r+=4){a=MX3(a,C0[r],C0[r+1]);b=MX3(b,C0[r+2],C0[r+3]);a=MX3(a,C1[r],C1[r+1]);b=MX3(b,C1[r+2],C1[r+3]);} \
      float rm=__builtin_fmaxf(a,b); { auto rr=__builtin_amdgcn_permlane32_swap(__float_as_uint(rm),__float_as_uint(rm),false,false); rm=__builtin_fmaxf(__uint_as_float(rr[0]),__uint_as_float(rr[1])); } \
      resc=false; \
      if(__builtin_expect(__any(rm>(float)THRL),0)){ const float dl=__builtin_fmaxf(rm,0.f); mhat+=dl; \
        _Pragma("unroll") for(int r=0;r<16;++r){C0[r]-=dl;C1[r]-=dl;} \
        _Pragma("unroll") for(int r=0;r<16;++r)negm[r]=-mhat; asm volatile("":"+v"(negm)); \
        const float f=__builtin_amdgcn_exp2f(-dl); l_reg*=f; if(hi==0)wsf[r32]=f; resc=true; } } \
    SBAR(); \
    GAPB(o[0]=__builtin_amdgcn_mfma_f32_32x32x16_bf16(PAF(0),VFR(0),o[0],0,0,0), C0,0); \
    GAPB(o[1]=__builtin_amdgcn_mfma_f32_32x32x16_bf16(PAF(0),VFR(4),o[1],0,0,0), C0,4); \
    KRD(GL,0); GAPB(o[0]=__builtin_amdgcn_mfma_f32_32x32x16_bf16(PAF(1),VFR(1),o[0],0,0,0), C0,8); \
    KRD(GL,1); GAPB(o[1]=__builtin_amdgcn_mfma_f32_32x32x16_bf16(PAF(1),VFR(5),o[1],0,0,0), C0,12); \
    KRD(GL,2); GAPB(o[0]=__builtin_amdgcn_mfma_f32_32x32x16_bf16(PAF(2),VFR(2),o[0],0,0,0), C1,0); \
    KRD(GL,3); GAPB(o[1]=__builtin_amdgcn_mfma_f32_32x32x16_bf16(PAF(2),VFR(6),o[1],0,0,0), C1,4); \
    GAPB(o[0]=__builtin_amdgcn_mfma_f32_32x32x16_bf16(PAF(3),VFR(3),o[0],0,0,0), C1,8); \
    GAPB(o[1]=__builtin_amdgcn_mfma_f32_32x32x16_bf16(PAF(3),VFR(7),o[1],0,0,0), C1,12); \
    }while(0)
  int t=1;
  #undef CMASK
  #define CMASK(P0,P1,t) do{}while(0)
  for(;t+5<NT;t+=2){
    STEP(pB0,pB1,pA0,pA1,t,true,true,true);     WAIT_BAR(2); RESC(); ROT();
    STEP(pA0,pA1,pB0,pB1,t+1,true,true,true);   WAIT_BAR(2); RESC(); ROT();
  }
  #undef CMASK
  #define CMASK(P0,P1,t) do{}while(0)
  #define ENDW(tt) do{ if((tt)+3<NT){WAIT_BAR(2);} else if((tt)+2<NT){WAIT_BAR(1);} else {WAIT_BAR(0);} }while(0)
  for(;t+1<NT;t+=2){
    STEP(pB0,pB1,pA0,pA1,t,(t+3<NT),(t+1<NT),(t+1<NT));       ENDW(t);   RESC(); ROT();
    STEP(pA0,pA1,pB0,pB1,t+1,(t+4<NT),(t+2<NT),(t+2<NT));     ENDW(t+1); RESC(); ROT();
  }
  STEP(pB0,pB1,pA0,pA1,NT-1,false,false,false); RESC();
  { float sacc=pB0[0]+pB0[1]; _Pragma("unroll") for(int r=2;r<16;++r)sacc+=pB0[r]; _Pragma("unroll") for(int r=0;r<16;++r)sacc+=pB1[r]; l_reg+=sacc;
    pw0=(u32x4){PKW(pB0,0),PKW(pB0,2),PKW(pB0,4),PKW(pB0,6)};pw1=(u32x4){PKW(pB0,8),PKW(pB0,10),PKW(pB0,12),PKW(pB0,14)};pw2=(u32x4){PKW(pB1,0),PKW(pB1,2),PKW(pB1,4),PKW(pB1,6)};pw3=(u32x4){PKW(pB1,8),PKW(pB1,10),PKW(pB1,12),PKW(pB1,14)};
    SBAR(); pv(o,vb0+sl_cur,PAF(0),PAF(1),PAF(2),PAF(3)); }
  #undef PKW
  #undef PAF
  #undef VFR
  #undef PIN
  #undef MX3
  #undef GAPA
  #undef GAPB
  #undef EX
  #undef VRD
  #undef KRD
  #undef STEP
  #undef ENDW
  {auto rr=__builtin_amdgcn_permlane32_swap(__float_as_uint(l_reg),__float_as_uint(l_reg),false,false);l_reg=__uint_as_float(rr[0])+__uint_as_float(rr[1]);}
  if(hi==0)wsf[32+r32]=l_reg;asm volatile("s_waitcnt lgkmcnt(0)":::"memory");
  float rli[16];
  #pragma unroll
  for(int r=0;r<16;++r)rli[r]=__builtin_amdgcn_rcpf(wsf[32+crow(r,hi)]);
  bf16*Ow=Oh+(long)(wid*QBLK)*OP;
  { bf16*stg=(bf16*)(shm+LDS_OST)+wid*2048;
    #pragma unroll
    for(int r=0;r<16;++r){const int orow=crow(r,hi);
      #pragma unroll
      for(int d0=0;d0<2;++d0)stg[orow*64+d0*32+r32]=__float2bfloat16(o[d0][r]*rli[r]);}
    asm volatile("s_waitcnt lgkmcnt(0)":::"memory");
    #pragma unroll
    for(int i=0;i<4;++i){const int row=i*8+(lane>>3),ch=lane&7; const u32x4 v=*(const u32x4*)(stg+row*64+ch*8); ATTN_STORE16(Ow+(long)row*OP+ch*8,v);} }
  asm volatile("s_waitcnt lgkmcnt(0)\n\ts_barrier":::"memory");
  #undef DMA_K
  #undef DMA_V
  #undef CMASK
  #undef START
  #undef RESC
  #undef ROT
}
constexpr int ATTN_LDS_BYTES=LDS_BYTES;
#undef SBAR
#undef WAIT_BAR
}
#define GAS __attribute__((address_space(1)))
#define LAS __attribute__((address_space(3)))
typedef unsigned short bf16;
typedef unsigned v4u __attribute__((ext_vector_type(4)));
typedef float f32x4 __attribute__((ext_vector_type(4)));
typedef short bf16x8 __attribute__((ext_vector_type(8)));
typedef GAS unsigned gu32;
typedef GAS unsigned long long gu64;
#define RLX_AGENT __ATOMIC_RELAXED, __HIP_MEMORY_SCOPE_AGENT
#define LDS_WAIT() asm volatile("s_waitcnt lgkmcnt(0)" ::: "memory")
#define VM_WAIT() asm volatile("s_waitcnt vmcnt(0)" ::: "memory")
__device__ __forceinline__ unsigned long long rt() { return __builtin_amdgcn_s_memrealtime(); }
__device__ __forceinline__ unsigned f2bf(float f) { unsigned u = __builtin_bit_cast(unsigned, f); return (u + 0x7fffu + ((u >> 16) & 1u)) >> 16; }
__device__ __forceinline__ unsigned pk2(float lo, float hi) { return f2bf(lo) | (f2bf(hi) << 16); }

#define XB_TMO      128
#define XB_XCNT(j)  (256  + 64 * (j))
#define XB_XSUB(j)  (1280 + 64 * (j))
#define XB_XGEN(j)  (2304 + 64 * (j))
#define XB_TOP      3328
#define XB_TOPGEN   3392
#define XCD_BAR_WORDS 3456
#define XB_SPIN_CAP (1u << 18)

__device__ __forceinline__ unsigned xb_ld(unsigned* p)              { return __hip_atomic_load(p, __ATOMIC_RELAXED, __HIP_MEMORY_SCOPE_AGENT); }
__device__ __forceinline__ unsigned xb_add(unsigned* p, unsigned v) { return __hip_atomic_fetch_add(p, v, __ATOMIC_RELAXED, __HIP_MEMORY_SCOPE_AGENT); }
__device__ __forceinline__ unsigned xb_xcc_id() { return (unsigned)__builtin_amdgcn_s_getreg((3 << 11) | 20) & 0xFu; }
#define XB_SPIN(cond, bar) do { unsigned _sp = 0; while (cond) { __builtin_amdgcn_s_sleep(1); \
    if ((++_sp & 255u) == 0u) { if (xb_ld(&(bar)[XB_TMO])) break; if (_sp > XB_SPIN_CAP) { atomicAdd(&(bar)[XB_TMO], 1u); break; } } } } while (0)

struct XcdBarrier {
    unsigned* bar; unsigned x;
    volatile LAS unsigned* st;
};

__device__ __forceinline__ XcdBarrier xcd_barrier_post(unsigned* bar, volatile LAS unsigned* st) {
    XcdBarrier b; b.bar = bar; b.x = xb_xcc_id(); b.st = st;
    if (threadIdx.x == 0) (void)xb_add(&bar[XB_XCNT(b.x)], 1u);
    return b;
}
__device__ __forceinline__ void xcd_barrier_complete(unsigned* bar, unsigned x, unsigned& nloc, unsigned& nx) {
    const unsigned G = gridDim.x * gridDim.y * gridDim.z;
    unsigned sum, cnt, mine, sp = 0u;
    for (;;) {
        sum = 0u; cnt = 0u; mine = 0u;
#pragma unroll
        for (unsigned j = 0; j < 16; ++j) { const unsigned c = xb_ld(&bar[XB_XCNT(j)]); sum += c; cnt += (c > 0u) ? 1u : 0u; mine = (j == x) ? c : mine; }
        if (sum == G) break;
        __builtin_amdgcn_s_sleep(1);
        if ((++sp & 255u) == 0u) { if (xb_ld(&bar[XB_TMO])) break; if (sp > XB_SPIN_CAP) { atomicAdd(&bar[XB_TMO], 1u); break; } }
    }
    nloc = mine > 0u ? mine : 1u; nx = cnt > 0u ? cnt : 1u;
}

__device__ __forceinline__ void xcd_barrier(const XcdBarrier& b) {
    asm volatile("s_waitcnt vmcnt(0)" ::: "memory");
    __syncthreads();
    if (threadIdx.x == 0) {
        unsigned* bar = b.bar;
        __builtin_amdgcn_s_waitcnt(0);
        unsigned nloc = b.st[0], nx = b.st[1];
        if (nloc == 0u) { xcd_barrier_complete(bar, b.x, nloc, nx); b.st[0] = nloc; b.st[1] = nx; }
        const unsigned old = xb_add(&bar[XB_XSUB(b.x)], 1u);
        const unsigned gen = old / nloc;
        if (old + 1u == (gen + 1u) * nloc) {
            __builtin_amdgcn_fence(__ATOMIC_RELEASE, "agent");
            asm volatile("s_waitcnt vmcnt(0)" ::: "memory");
            const unsigned og = xb_add(&bar[XB_TOP], 1u);
            const unsigned tg = og / nx;
            if (og + 1u == (tg + 1u) * nx) xb_add(&bar[XB_TOPGEN], 1u);
            else XB_SPIN(xb_ld(&bar[XB_TOPGEN]) == tg, bar);
            __builtin_amdgcn_fence(__ATOMIC_ACQUIRE, "agent");
            xb_add(&bar[XB_XGEN(b.x)], 1u);
            asm volatile("s_waitcnt vmcnt(0)" ::: "memory");
        } else {
            XB_SPIN(xb_ld(&bar[XB_XGEN(b.x)]) == gen, bar);
            __builtin_amdgcn_fence(__ATOMIC_ACQUIRE, "agent");
            asm volatile("s_waitcnt vmcnt(0)" ::: "memory");
        }
    }
    __syncthreads();
}

constexpr int NWAVES = 8, NTHR = 512;
constexpr int DM = 1024, NB = 4, TL = 8192, TC = 256, TT = TL + TC, MROWS = NB * TT  , MLAT = NB * TL  ;
constexpr int NP = 2304, DIN = 2320;
constexpr int CQ = 0, CK = 256, CV = 512, CO = 1024, CAQ = 1536, CAK = 2048, CAV = 2176;
constexpr int DFF = 2816, DFE = 3584, NEXP = 8;
constexpr int NBLK = TT / 128;
constexpr int NSEQ = NB * 4 * 2;
constexpr float EPS = 1e-6f;
constexpr int N_PHASES = 27;
constexpr int PASS_TILES = 68;

constexpr size_t MiB = 1u << 20;
constexpr size_t WS_CTL = 0, CTL_ZERO_BYTES = 1 * MiB;
constexpr size_t WS_MODS = 1 * MiB;
constexpr size_t WS_ROUTE = 2 * MiB;
constexpr size_t RT_TOKE = 0, RT_TOKG = 128 * 1024, RT_CNT = 384 * 1024, RT_INFO = 400 * 1024, RT_TILEE = 404 * 1024, RT_ROWTOK = 512 * 1024, RT_ROWG = 800 * 1024;
constexpr size_t WS_CTXRES = 4 * MiB;
constexpr size_t WS_GATES = 8 * MiB;
constexpr size_t WS_CSTN = 11 * MiB, WS_CSTM = 11 * MiB + 768 * 1024, WS_CSTE = 11 * MiB + 896 * 1024;
constexpr size_t WS_WIN = 12 * MiB, WS_WOUT = 21 * MiB, WS_WGU = 25 * MiB, WS_WD = 36 * MiB, WS_MGU = 42 * MiB, WS_MD = 154 * MiB;
constexpr size_t WS_HY = 210 * MiB;
constexpr size_t WS_P = 276 * MiB;
constexpr size_t WS_QN = WS_P + (size_t)MROWS * NP * 2;
constexpr size_t WS_KN = WS_QN + (size_t)MROWS * 512 * 2;
constexpr size_t WS_CSTC = 466 * MiB;
constexpr size_t WS_ACT0 = 276 * MiB;
constexpr size_t WS_ASORT = 276 * MiB;
constexpr size_t WS_ACT1 = 412 * MiB;
constexpr size_t WS_END = 532 * MiB;
static_assert(WS_KN + (size_t)MROWS * 128 * 2 <= WS_CSTC && WS_CSTC + (size_t)NSEQ * NBLK * 8192 * 4 <= WS_END, "ws map");
static_assert(WS_ACT0 + (size_t)MROWS * DFF * 2 <= WS_CSTC && WS_ASORT + (size_t)272 * 256 * DM * 2 <= WS_ACT1 && WS_ACT1 + (size_t)PASS_TILES * 256 * DFE * 2 <= WS_END, "ws map 2");
static_assert(WS_MD + (size_t)NEXP * DM * DFE * 2 <= WS_HY && WS_MGU + (size_t)NEXP * 2 * DFE * DM * 2 <= WS_MD && WS_WD + (size_t)DM * DFF * 2 <= WS_MGU && WS_WGU + (size_t)2 * DFF * DM * 2 <= WS_WD, "ws map 3");
constexpr int CW_BAR = 4096;

constexpr int LDS_BYTES = 155648;
constexpr int MISC_OFF = 154624;

struct Args { const float* in[22]; float* out; unsigned char* ws; int ph_lo, ph_hi, li, pad; };
typedef const __attribute__((address_space(4))) Args* CAP;
__device__ __forceinline__ const float* ain(CAP a, int k) { return (const float*)(const GAS float*)(unsigned long long)a->in[k]; }
__device__ __forceinline__ float* aout(CAP a) { return (float*)(GAS float*)(unsigned long long)a->out; }
__device__ __forceinline__ CAP args_ptr() { unsigned long long p = (unsigned long long)__builtin_amdgcn_kernarg_segment_ptr(); asm volatile("" : "+s"(p)); return (CAP)p; }

struct Frame {
    LAS unsigned char* lds; volatile LAS unsigned* MISC; gu32* ctl; unsigned char* ws;
    int tid, lane, wave, vcu, G, gw, NGW;
};

__device__ __forceinline__ float shx(float v, int o, int lane) { return __int_as_float(__builtin_amdgcn_ds_bpermute((lane ^ o) << 2, __float_as_int(v))); }
__device__ __forceinline__ float shu(float v, int o, int lane) { return __int_as_float(__builtin_amdgcn_ds_bpermute(((lane - o) & 63) << 2, __float_as_int(v))); }
__device__ __forceinline__ float shi(float v, int src) { return __int_as_float(__builtin_amdgcn_ds_bpermute(src << 2, __float_as_int(v))); }
__device__ __forceinline__ float wave_sum(float v, int lane) {
#pragma unroll
    for (int o = 1; o < 64; o <<= 1) v += shx(v, o, lane);
    return v;
}
__device__ __forceinline__ float wave_max(float v, int lane) {
#pragma unroll
    for (int o = 1; o < 64; o <<= 1) v = fmaxf(v, shx(v, o, lane));
    return v;
}
__device__ __forceinline__ float wave_incl_scan_add(float v, int lane) {
#pragma unroll
    for (int o = 1; o < 64; o <<= 1) { const float t = shu(v, o, lane); if (lane >= o) v += t; }
    return v;
}
__device__ __forceinline__ float wave_incl_scan_max(float v, int lane) {
#pragma unroll
    for (int o = 1; o < 64; o <<= 1) { const float t = shu(v, o, lane); if (lane >= o) v = fmaxf(v, t); }
    return v;
}
__device__ __forceinline__ float bf2f(unsigned short b) { return __uint_as_float((unsigned)b << 16); }
__device__ __forceinline__ float bflo(unsigned w) { return __uint_as_float(w << 16); }
__device__ __forceinline__ float bfhi(unsigned w) { return __uint_as_float(w & 0xffff0000u); }
__device__ __forceinline__ float logsig(float x) { return fminf(x, 0.f) - __logf(1.f + __expf(-fabsf(x))); }
__device__ __forceinline__ float siluf(float x) { return x / (1.f + __expf(-x)); }
__device__ __forceinline__ float dot4(f32x4 a, f32x4 b) { return (a.x * b.x + a.y * b.y) + (a.z * b.z + a.w * b.w); }
#define MFMA16(a, b, c) __builtin_amdgcn_mfma_f32_16x16x32_bf16((a), (b), (c), 0, 0, 0)

__device__ __forceinline__ void tr_item(const float* W, int ldw, int srccol0, int k0, bf16* WT, int ldt, int dstrow0, LAS float* scr, int lane) {
#pragma unroll 8
    for (int i = 0; i < 32; ++i) { const int kk = 2 * i + (lane >> 5); scr[kk * 33 + (lane & 31)] = W[(size_t)(k0 + kk) * ldw + srccol0 + (lane & 31)]; }
    LDS_WAIT(); asm volatile("" ::: "memory");
    const int c = lane & 7;
#pragma unroll
    for (int j = 0; j < 4; ++j) { const int n = (lane >> 3) + 8 * j; const LAS float* s = scr + (8 * c) * 33 + n;
        v4u o; o.x = pk2(s[0 * 33], s[1 * 33]); o.y = pk2(s[2 * 33], s[3 * 33]); o.z = pk2(s[4 * 33], s[5 * 33]); o.w = pk2(s[6 * 33], s[7 * 33]);
        *(GAS v4u*)(WT + (size_t)(dstrow0 + n) * ldt + k0 + 8 * c) = o; }
    LDS_WAIT(); asm volatile("" ::: "memory");
}
__device__ __forceinline__ void phase_prologue(Frame& F, CAP a) {
    {
        LAS float* sc = (LAS float*)F.lds;
        LAS float* red = (LAS float*)(F.lds + 20480);
        float* mods = (float*)(F.ws + WS_MODS);
        for (int u = blockIdx.x; u < 48; u += F.G) {
            const int L = u / 24, cb = u % 24;
            for (int idx = F.tid; idx < 5 * 1024; idx += NTHR) { const int v = idx >> 10, k = idx & 1023; const float x = v < 4 ? ain(a, 1)[v * 1024 + k] : ain(a, 3)[k]; sc[idx] = siluf(x); }
            __syncthreads();
            f32x4 acc[5];
#pragma unroll
            for (int v = 0; v < 5; ++v) acc[v] = (f32x4){0.f, 0.f, 0.f, 0.f};
            const float* wp = ain(a, 4) + ((size_t)L * 1024 + 128 * F.wave) * 6144 + cb * 256 + 4 * F.lane;
#pragma unroll 4
            for (int kk = 0; kk < 128; ++kk) { const f32x4 w4 = *(const f32x4*)(wp + (size_t)kk * 6144);
#pragma unroll
                for (int v = 0; v < 5; ++v) acc[v] += w4 * sc[v * 1024 + 128 * F.wave + kk]; }
#pragma unroll
            for (int v = 0; v < 5; ++v) *(LAS f32x4*)(red + (F.wave * 5 + v) * 256 + 4 * F.lane) = acc[v];
            __syncthreads();
            for (int o = F.tid; o < 1280; o += NTHR) { const int v = o >> 8, cc = o & 255; float s = ain(a, 5)[L * 6144 + cb * 256 + cc];
#pragma unroll
                for (int w = 0; w < 8; ++w) s += red[(w * 5 + v) * 256 + cc];
                mods[(size_t)(L * 5 + v) * 6144 + cb * 256 + cc] = s; }
            __syncthreads();
        }
    }
    LAS float* scr = (LAS float*)(F.lds + F.wave * 16384);
    constexpr int I0 = 2 * 16 * 72, I1 = 2 * 16 * 32, I2 = 16 * 176, I3 = 44 * 32, I4 = 8 * 16 * 224, I5 = 8 * 56 * 32;
    constexpr int NITEMS = I0 + I1 + I2 + I3 + I4 + I5;
    for (int it = F.gw; it < NITEMS; it += F.NGW) {
        int r = it;
        if (r < I0) { const int L = r / 1152, rem = r % 1152, kb = rem / 72, nb = rem % 72, c0 = 32 * nb;
            tr_item(ain(a, 8) + (size_t)L * DM * DIN, DIN, c0 < 1536 ? c0 : c0 + 16, 64 * kb, (bf16*)(F.ws + WS_WIN) + (size_t)L * NP * DM, DM, c0, scr, F.lane); continue; }
        r -= I0;
        if (r < I1) { const int L = r / 512, rem = r % 512, kb = rem / 32, nb = rem % 32;
            tr_item(ain(a, 13) + (size_t)L * DM * DM, DM, 32 * nb, 64 * kb, (bf16*)(F.ws + WS_WOUT) + (size_t)L * DM * DM, DM, 32 * nb, scr, F.lane); continue; }
        r -= I1;
        if (r < I2) { const int kb = r / 176, nb = r % 176, r0 = 32 * nb, pn = r0 >> 8, wi = r0 & 255;
            const float* W = wi < 128 ? ain(a, 14) : ain(a, 15);
            tr_item(W, DFF, 128 * pn + (wi & 127), 64 * kb, (bf16*)(F.ws + WS_WGU), DM, r0, scr, F.lane); continue; }
        r -= I2;
        if (r < I3) { const int kb = r / 32, nb = r % 32;
            tr_item(ain(a, 16), DM, 32 * nb, 64 * kb, (bf16*)(F.ws + WS_WD), DFF, 32 * nb, scr, F.lane); continue; }
        r -= I3;
        if (r < I4) { const int e = r / 3584, rem = r % 3584, kb = rem / 224, nb = rem % 224, r0 = 32 * nb, pn = r0 >> 8, wi = r0 & 255;
            const float* W = (wi < 128 ? ain(a, 18) : ain(a, 19)) + (size_t)e * DM * DFE;
            tr_item(W, DFE, 128 * pn + (wi & 127), 64 * kb, (bf16*)(F.ws + WS_MGU) + (size_t)e * 2 * DFE * DM, DM, r0, scr, F.lane); continue; }
        r -= I4;
        { const int e = r / 1792, rem = r % 1792, kb = rem / 32, nb = rem % 32;
            tr_item(ain(a, 20) + (size_t)e * DFE * DM, DM, 32 * nb, 64 * kb, (bf16*)(F.ws + WS_MD) + (size_t)e * DM * DFE, DFE, 32 * nb, scr, F.lane); }
    }
}

struct RowVec { f32x4 h[4]; };
__device__ __forceinline__ RowVec norm_mod_row(const float* src, const float* nw, const float* shift, const float* scale, int lane) {
    const GAS f32x4* xr = (const GAS f32x4*)src + lane;
    f32x4 x[4]; float ss = 0.f;
#pragma unroll
    for (int j = 0; j < 4; ++j) { x[j] = xr[64 * j]; ss += dot4(x[j], x[j]); }
    const float rinv = rsqrtf(wave_sum(ss, lane) * (1.f / DM) + EPS);
    RowVec R;
#pragma unroll
    for (int j = 0; j < 4; ++j) { const int c = 256 * j + 4 * lane; const f32x4 w = *(const f32x4*)(nw + c), sh = *(const f32x4*)(shift + c), sc = *(const f32x4*)(scale + c);
        R.h[j] = (x[j] * rinv * w) * (sc + 1.f) + sh; }
    return R;
}
__device__ __forceinline__ void store_row_bf16(bf16* dst, const RowVec& R, int lane) {
    GAS unsigned long long* o8 = (GAS unsigned long long*)dst + lane;
#pragma unroll
    for (int j = 0; j < 4; ++j) o8[64 * j] = (unsigned long long)pk2(R.h[j].x, R.h[j].y) | ((unsigned long long)pk2(R.h[j].z, R.h[j].w) << 32);
}
__device__ __forceinline__ const float* resid_row(const Frame& F, CAP a, int L, int b, int tp) {
    if (tp < TC) return (L == 0 ? ain(a, 2) : (const float*)(F.ws + WS_CTXRES)) + (size_t)(b * TC + tp) * DM;
    return (L == 0 ? ain(a, 0) : (const float*)aout(a)) + (size_t)(b * TL + tp - TC) * DM;
}
__device__ __forceinline__ void phase_norm1(Frame& F, CAP a, int L) {
    LAS float* wgT = (LAS float*)F.lds;
    const float* win = ain(a, 8) + (size_t)L * DM * DIN;
    for (int idx = F.tid; idx < 16 * 1024; idx += NTHR) { const int k = idx >> 4, g = idx & 15; wgT[g * 1024 + k] = win[(size_t)k * DIN + 1536 + g]; }
    __syncthreads();
    const float* nw = ain(a, 6) + L * DM;
    const float* mods = (const float*)(F.ws + WS_MODS) + (size_t)L * 5 * 6144;
    bf16* H = (bf16*)(F.ws + WS_HY); float* Gt = (float*)(F.ws + WS_GATES);
    const float gbias = F.lane < 16 ? ain(a, 9)[L * 16 + F.lane] : 0.f;
    for (int r = F.gw; r < MROWS; r += F.NGW) {
        const int b = r / TT, tp = r - b * TT, v = tp < TC ? 4 : b;
        const float* mv = mods + v * 6144;
        const RowVec R = norm_mod_row(resid_row(F, a, L, b, tp), nw, mv, mv + 1024, F.lane);
        store_row_bf16(H + (size_t)r * DM, R, F.lane);
        float val = 0.f;
#pragma unroll 2
        for (int g = 0; g < 16; ++g) { float s = 0.f;
#pragma unroll
            for (int j = 0; j < 4; ++j) s += dot4(R.h[j], *(const LAS f32x4*)(wgT + g * 1024 + 256 * j + 4 * F.lane));
            s = wave_sum(s, F.lane); val = (F.lane == g) ? s : val; }
        if (F.lane < 16) { val += gbias; if ((F.lane >> 2) & 1) val = logsig(val); Gt[(size_t)r * 16 + F.lane] = val; }
    }
    __syncthreads();
}
__device__ __forceinline__ void phase_norm2(Frame& F, CAP a, int L) {
    const float* nw = ain(a, 7) + L * DM;
    const float* mods = (const float*)(F.ws + WS_MODS) + (size_t)L * 5 * 6144;
    bf16* H = (bf16*)(F.ws + WS_HY);
    for (int r = F.gw; r < MROWS; r += F.NGW) {
        const int b = r / TT, tp = r - b * TT, v = tp < TC ? 4 : b;
        const float* mv = mods + v * 6144;
        const RowVec R = norm_mod_row(resid_row(F, a, 1, b, tp), nw, mv + 3 * 1024, mv + 4 * 1024, F.lane);
        store_row_bf16(H + (size_t)r * DM, R, F.lane);
    }
}
__device__ __forceinline__ void phase_final(Frame& F, CAP a) {
    const float* nw = ain(a, 21);
    for (int r = F.gw; r < MLAT; r += F.NGW) {
        GAS f32x4* xr = (GAS f32x4*)(aout(a) + (size_t)r * DM) + F.lane;
        f32x4 x[4]; float ss = 0.f;
#pragma unroll
        for (int j = 0; j < 4; ++j) { x[j] = xr[64 * j]; ss += dot4(x[j], x[j]); }
        const float rinv = rsqrtf(wave_sum(ss, F.lane) * (1.f / DM) + EPS);
#pragma unroll
        for (int j = 0; j < 4; ++j) xr[64 * j] = x[j] * rinv * *(const f32x4*)(nw + 256 * j + 4 * F.lane);
    }
}

__device__ __forceinline__ void unpack8(v4u raw, float (&x)[8]) {
    x[0] = bflo(raw.x); x[1] = bfhi(raw.x); x[2] = bflo(raw.y); x[3] = bfhi(raw.y); x[4] = bflo(raw.z); x[5] = bfhi(raw.z); x[6] = bflo(raw.w); x[7] = bfhi(raw.w);
}
__device__ __forceinline__ v4u pack8(const float (&x)[8]) { v4u o; o.x = pk2(x[0], x[1]); o.y = pk2(x[2], x[3]); o.z = pk2(x[4], x[5]); o.w = pk2(x[6], x[7]); return o; }
__device__ __forceinline__ void phase_qknorm(Frame& F, CAP a, int L) {
    const bf16* P = (const bf16*)(F.ws + WS_P); bf16* QN = (bf16*)(F.ws + WS_QN); bf16* KN = (bf16*)(F.ws + WS_KN);
    const int l8 = F.lane & 7;
    float qwv[8], kwv[8], invf[4];
#pragma unroll
    for (int e = 0; e < 8; ++e) { qwv[e] = ain(a, 11)[L * 64 + 8 * l8 + e]; kwv[e] = ain(a, 12)[L * 64 + 8 * l8 + e]; }
#pragma unroll
    for (int p = 0; p < 4; ++p) invf[p] = __builtin_amdgcn_exp2f(-(float)((4 * l8 + p) & 15) * 0.83048202372184058f);
    const bool use_row = l8 < 4;
    constexpr float C2 = 0.125f * 1.4426950408889634f;
    for (int r = F.gw; r < MROWS; r += F.NGW) {
        const int b = r / TT, tp = r - b * TT, t = tp - TC;
        const float pos = tp >= TC ? (float)(use_row ? (t >> 6) : (t & 63)) : 0.f;
        float cs[4], sn[4];
#pragma unroll
        for (int p = 0; p < 4; ++p) { const float ang = pos * invf[p]; cs[p] = __cosf(ang); sn[p] = __sinf(ang); }
        float x[8];
        {
            unpack8(*(const GAS v4u*)(P + (size_t)r * NP + CAQ + 8 * F.lane), x);
            float ss = 0.f;
#pragma unroll
            for (int e = 0; e < 8; ++e) ss += x[e] * x[e];
            ss += shx(ss, 1, F.lane); ss += shx(ss, 2, F.lane); ss += shx(ss, 4, F.lane);
            const float rinv = rsqrtf(ss * (1.f / 64.f) + EPS);
#pragma unroll
            for (int e = 0; e < 8; ++e) x[e] = x[e] * rinv * qwv[e];
#pragma unroll
            for (int p = 0; p < 4; ++p) { const float xe = x[2 * p], xo = x[2 * p + 1]; x[2 * p] = (xe * cs[p] - xo * sn[p]) * C2; x[2 * p + 1] = (xe * sn[p] + xo * cs[p]) * C2; }
            *(GAS v4u*)(QN + (size_t)r * 512 + 8 * F.lane) = pack8(x);
        }
        {
            v4u raw = (v4u){0u, 0u, 0u, 0u};
            if (F.lane < 16) raw = *(const GAS v4u*)(P + (size_t)r * NP + CAK + 8 * F.lane);
            unpack8(raw, x);
            float ss = 0.f;
#pragma unroll
            for (int e = 0; e < 8; ++e) ss += x[e] * x[e];
            ss += shx(ss, 1, F.lane); ss += shx(ss, 2, F.lane); ss += shx(ss, 4, F.lane);
            const float rinv = rsqrtf(ss * (1.f / 64.f) + EPS);
#pragma unroll
            for (int e = 0; e < 8; ++e) x[e] = x[e] * rinv * kwv[e];
#pragma unroll
            for (int p = 0; p < 4; ++p) { const float xe = x[2 * p], xo = x[2 * p + 1]; x[2 * p] = xe * cs[p] - xo * sn[p]; x[2 * p + 1] = xe * sn[p] + xo * cs[p]; }
            if (F.lane < 16) *(GAS v4u*)(KN + (size_t)r * 128 + 8 * F.lane) = pack8(x);
        }
    }
}

__device__ __forceinline__ int scan_ci(int tb, int dir) { return dir == 0 ? tb : (tb < 2 ? 1 - tb : 67 - tb); }

__device__ __forceinline__ void phase_mlstm_local(Frame& F, CAP a, int L) {
    LAS bf16* VT = (LAS bf16*)(F.lds);
    LAS bf16* KTF = (LAS bf16*)(F.lds + 34816);
    LAS bf16* KTB = (LAS bf16*)(F.lds + 52224);
    LAS float* GL = (LAS float*)(F.lds + 69632);
    LAS float* WV = (LAS float*)(F.lds + 71680);
    const bf16* P = (const bf16*)(F.ws + WS_P); const float* Gt = (const float*)(F.ws + WS_GATES);
    float* CSTC = (float*)(F.ws + WS_CSTC); float* CSTN = (float*)(F.ws + WS_CSTN); float* CSTM = (float*)(F.ws + WS_CSTM);
    const int lane = F.lane, tid = F.tid, wave = F.wave, q4 = lane >> 4, c16 = lane & 15;
    for (int u = blockIdx.x; u < NB * 4 * NBLK; u += F.G) {
        const int tb = u % NBLK, bh = u / NBLK, b = bh >> 2, h = bh & 3;
        const int r0 = b * TT + 128 * tb;
        { const int g = tid >> 7, i = tid & 127; GL[g * 128 + i] = Gt[(size_t)(r0 + i) * 16 + g * 4 + h]; }
        __syncthreads();
        if (wave < 2) {
            const int dir = wave;
            const float lf0 = GL[(1 + 2 * dir) * 128 + 2 * lane], lf1 = GL[(1 + 2 * dir) * 128 + 2 * lane + 1];
            const float ig0 = GL[(2 * dir) * 128 + 2 * lane], ig1 = GL[(2 * dir) * 128 + 2 * lane + 1];
            const float s = lf0 + lf1, inc = wave_incl_scan_add(s, lane), tot = shi(inc, 63), exc = inc - s;
            float wl0, wl1;
            if (dir == 0) { wl0 = (tot - (exc + lf0)) + ig0; wl1 = (tot - inc) + ig1; }
            else          { wl0 = exc + ig0;                 wl1 = (exc + lf0) + ig1; }
            const float ml = wave_max(fmaxf(wl0, wl1), lane);
            WV[dir * 128 + 2 * lane] = __expf(wl0 - ml); WV[dir * 128 + 2 * lane + 1] = __expf(wl1 - ml);
            if (lane == 0) { const int sidx = (bh * 2 + dir) * NBLK + scan_ci(tb, dir); CSTM[sidx * 2] = ml; CSTM[sidx * 2 + 1] = tot; }
        }
        __syncthreads();
#pragma unroll
        for (int i = 0; i < 4; ++i) { const int q = tid + 512 * i, s = q >> 4, dc = q & 15;
            const v4u raw = *(const GAS v4u*)(P + (size_t)(r0 + s) * NP + CV + h * 128 + dc * 8);
            LAS bf16* vp = VT + (dc * 8) * 136 + s;
            vp[0 * 136] = (bf16)(raw.x & 0xffffu); vp[1 * 136] = (bf16)(raw.x >> 16); vp[2 * 136] = (bf16)(raw.y & 0xffffu); vp[3 * 136] = (bf16)(raw.y >> 16);
            vp[4 * 136] = (bf16)(raw.z & 0xffffu); vp[5 * 136] = (bf16)(raw.z >> 16); vp[6 * 136] = (bf16)(raw.w & 0xffffu); vp[7 * 136] = (bf16)(raw.w >> 16); }
#pragma unroll
        for (int i = 0; i < 2; ++i) { const int q = tid + 512 * i, s = q >> 3, kc = q & 7;
            float kv[8]; unpack8(*(const GAS v4u*)(P + (size_t)(r0 + s) * NP + CK + h * 64 + kc * 8), kv);
            const float wf = WV[s], wb = WV[128 + s];
#pragma unroll
            for (int e = 0; e < 8; ++e) { KTF[(kc * 8 + e) * 136 + s] = (bf16)f2bf(kv[e] * wf); KTB[(kc * 8 + e) * 136 + s] = (bf16)f2bf(kv[e] * wb); } }
        __syncthreads();
        {
            const int pair = tid >> 2, dir = pair >> 6, k = pair & 63, part = tid & 3;
            const LAS bf16* KT = (dir ? KTB : KTF) + k * 136 + 32 * part; float sacc = 0.f;
#pragma unroll 8
            for (int s = 0; s < 32; ++s) sacc += bf2f(KT[s]);
            sacc += shx(sacc, 1, lane); sacc += shx(sacc, 2, lane);
            if (part == 0) CSTN[(size_t)((bh * 2 + dir) * NBLK + scan_ci(tb, dir)) * 64 + k] = sacc;
        }
#pragma unroll
        for (int dir = 0; dir < 2; ++dir) {
            const LAS bf16* KT = dir ? KTB : KTF;
            float* cdst = CSTC + (size_t)((bh * 2 + dir) * NBLK + scan_ci(tb, dir)) * 8192;
#pragma unroll
            for (int kt = 0; kt < 4; ++kt) {
                f32x4 acc = (f32x4){0.f, 0.f, 0.f, 0.f};
#pragma unroll
                for (int s0 = 0; s0 < 128; s0 += 32) {
                    const bf16x8 av = *(const LAS bf16x8*)(VT + (16 * wave + c16) * 136 + s0 + 8 * q4);
                    const bf16x8 bv = *(const LAS bf16x8*)(KT + (16 * kt + c16) * 136 + s0 + 8 * q4);
                    acc = MFMA16(av, bv, acc); }
#pragma unroll
                for (int j = 0; j < 4; ++j) cdst[(16 * wave + 4 * q4 + j) * 64 + 16 * kt + c16] = acc[j];
            }
        }
        __syncthreads();
    }
}

__device__ __forceinline__ void phase_scan(Frame& F) {
    float* CSTC = (float*)(F.ws + WS_CSTC); float* CSTN = (float*)(F.ws + WS_CSTN); const float* CSTM = (const float*)(F.ws + WS_CSTM); float* CSTE = (float*)(F.ws + WS_CSTE);
    const int tid = F.tid;
    for (int u = blockIdx.x; u < NSEQ * 8; u += F.G) {
        const int seq = u >> 3, js = u & 7; const bool nown = (js == 0 && tid < 64);
        float C0 = 0.f, C1 = 0.f, n = 0.f, m = 0.f;
        float* cb = CSTC + (size_t)seq * NBLK * 8192 + js * 1024 + tid;
        for (int c0 = 0; c0 < NBLK; c0 += 6) {
            float cl0[6], cl1[6], ml[6], g[6], nl[6];
#pragma unroll
            for (int i = 0; i < 6; ++i) { const size_t si = (size_t)seq * NBLK + c0 + i; cl0[i] = cb[(size_t)(c0 + i) * 8192]; cl1[i] = cb[(size_t)(c0 + i) * 8192 + 512];
                ml[i] = CSTM[si * 2]; g[i] = CSTM[si * 2 + 1]; nl[i] = nown ? CSTN[si * 64 + tid] : 0.f; }
#pragma unroll
            for (int i = 0; i < 6; ++i) { const size_t si = (size_t)seq * NBLK + c0 + i;
                const float mnew = fmaxf(g[i] + m, ml[i]), aa = __expf(g[i] + m - mnew), sv = __expf(ml[i] - mnew);
                cb[(size_t)(c0 + i) * 8192] = C0; cb[(size_t)(c0 + i) * 8192 + 512] = C1;
                if (nown) CSTN[si * 64 + tid] = n;
                if (js == 0 && tid == 0) CSTE[si] = m;
                C0 = aa * C0 + sv * cl0[i]; C1 = aa * C1 + sv * cl1[i]; n = aa * n + sv * nl[i]; m = mnew; }
        }
    }
}

__device__ __forceinline__ void phase_mlstm_out(Frame& F, CAP a, int L) {
    LAS bf16* Qs = (LAS bf16*)(F.lds);
    LAS bf16* Ks = (LAS bf16*)(F.lds + 18432);
    LAS bf16* VT = (LAS bf16*)(F.lds + 36864);
    LAS bf16* Es = (LAS bf16*)(F.lds + 76032);
    LAS bf16* Sm = (LAS bf16*)(F.lds + 96768) + F.wave * (16 * 136);
    LAS float* GL = (LAS float*)(F.lds + 131584);
    LAS float* VG = (LAS float*)(F.lds + 133632);
    const bf16* P = (const bf16*)(F.ws + WS_P); const float* Gt = (const float*)(F.ws + WS_GATES);
    const float* CSTC = (const float*)(F.ws + WS_CSTC); const float* CSTN = (const float*)(F.ws + WS_CSTN); const float* CSTE = (const float*)(F.ws + WS_CSTE);
    bf16* Y = (bf16*)(F.ws + WS_HY);
    const float* mnw = ain(a, 10) + L * 512;
    const int lane = F.lane, tid = F.tid, wave = F.wave, q4 = lane >> 4, c16 = lane & 15, t0 = 16 * wave;
    for (int idx = tid; idx < 16 * 136; idx += NTHR) { const int row = 128 + idx / 136, c = idx % 136; VT[row * 136 + c] = (bf16)((row == 128 && c < 128) ? 0x3F80u : 0u); }
    for (int idx = tid; idx < 15 * 72; idx += NTHR) Es[(129 + idx / 72) * 72 + idx % 72] = (bf16)0u;
    const int nblk = (L == 0) ? NBLK : NBLK - 2;
    for (int u = blockIdx.x; u < NB * 4 * nblk; u += F.G) {
        const int bh = u / nblk, tb = u % nblk + (NBLK - nblk), b = bh >> 2, h = bh & 3;
        const int r0 = b * TT + 128 * tb;
#pragma unroll
        for (int i = 0; i < 2; ++i) { const int q = tid + 512 * i, s = q >> 3, c = q & 7;
            *(LAS v4u*)(Qs + s * 72 + c * 8) = *(const GAS v4u*)(P + (size_t)(r0 + s) * NP + CQ + h * 64 + c * 8);
            *(LAS v4u*)(Ks + s * 72 + c * 8) = *(const GAS v4u*)(P + (size_t)(r0 + s) * NP + CK + h * 64 + c * 8); }
#pragma unroll
        for (int i = 0; i < 4; ++i) { const int q = tid + 512 * i, s = q >> 4, dc = q & 15;
            const v4u raw = *(const GAS v4u*)(P + (size_t)(r0 + s) * NP + CV + h * 128 + dc * 8);
            LAS bf16* vp = VT + (dc * 8) * 136 + s;
            vp[0 * 136] = (bf16)(raw.x & 0xffffu); vp[1 * 136] = (bf16)(raw.x >> 16); vp[2 * 136] = (bf16)(raw.y & 0xffffu); vp[3 * 136] = (bf16)(raw.y >> 16);
            vp[4 * 136] = (bf16)(raw.z & 0xffffu); vp[5 * 136] = (bf16)(raw.z >> 16); vp[6 * 136] = (bf16)(raw.w & 0xffffu); vp[7 * 136] = (bf16)(raw.w >> 16); }
        { const int g = tid >> 7, i = tid & 127; GL[g * 128 + i] = Gt[(size_t)(r0 + i) * 16 + g * 4 + h]; }
        __syncthreads();
        f32x4 hsum[8];
#pragma unroll
        for (int ct = 0; ct < 8; ++ct) hsum[ct] = (f32x4){0.f, 0.f, 0.f, 0.f};
#pragma unroll 1
        for (int dir = 0; dir < 2; ++dir) {
            const int sidx = (bh * 2 + dir) * NBLK + scan_ci(tb, dir);
            if (wave == 0) {
                const int ta = dir ? 127 - 2 * lane : 2 * lane, tc = dir ? 126 - 2 * lane : 2 * lane + 1;
                const float lf0 = GL[(1 + 2 * dir) * 128 + ta], lf1 = GL[(1 + 2 * dir) * 128 + tc], ig0 = GL[(2 * dir) * 128 + ta], ig1 = GL[(2 * dir) * 128 + tc];
                const float s = lf0 + lf1, inc = wave_incl_scan_add(s, lane), exc = inc - s;
                const float b0 = exc + lf0, b1 = inc, g0 = ig0 - b0, g1 = ig1 - b1;
                const float mx1 = fmaxf(g0, g1), pm = wave_incl_scan_max(mx1, lane);
                float pe = shu(pm, 1, lane); if (lane == 0) pe = -INFINITY;
                const float me = CSTE[sidx];
                const float M0 = fmaxf(me, fmaxf(pe, g0)), M1 = fmaxf(me, pm);
                VG[ta] = g0; VG[tc] = g1; VG[128 + ta] = M0; VG[128 + tc] = M1;
                VG[256 + ta] = __expf(me - M0); VG[256 + tc] = __expf(me - M1);
                VG[384 + ta] = __expf(-(b0 + M0)); VG[384 + tc] = __expf(-(b1 + M1));
            } else {
                for (int idx = tid - 64; idx < 128 * 16; idx += NTHR - 64) { const int d = idx >> 4, c4 = idx & 15;
                    const f32x4 v = *(const GAS f32x4*)(CSTC + (size_t)sidx * 8192 + d * 64 + c4 * 4);
                    *(LAS unsigned long long*)(Es + d * 72 + c4 * 4) = (unsigned long long)pk2(v.x, v.y) | ((unsigned long long)pk2(v.z, v.w) << 32); }
                if (wave == 1 && lane < 16) { const f32x4 v = *(const GAS f32x4*)(CSTN + (size_t)sidx * 64 + lane * 4);
                    *(LAS unsigned long long*)(Es + 128 * 72 + lane * 4) = (unsigned long long)pk2(v.x, v.y) | ((unsigned long long)pk2(v.z, v.w) << 32); }
            }
            __syncthreads();
            float Mr[4], ar[4], er[4];
#pragma unroll
            for (int j = 0; j < 4; ++j) { const int t = t0 + 4 * q4 + j; Mr[j] = VG[128 + t]; ar[j] = VG[256 + t] * 0.125f; er[j] = VG[384 + t]; }
            bf16x8 qa[2];
#pragma unroll
            for (int k = 0; k < 2; ++k) qa[k] = *(const LAS bf16x8*)(Qs + (t0 + c16) * 72 + 32 * k + 8 * q4);
#pragma unroll
            for (int st = 0; st < 8; ++st) {
                f32x4 acc = (f32x4){0.f, 0.f, 0.f, 0.f};
#pragma unroll
                for (int k = 0; k < 2; ++k) acc = MFMA16(qa[k], *(const LAS bf16x8*)(Ks + (16 * st + c16) * 72 + 32 * k + 8 * q4), acc);
                const int s = 16 * st + c16; const float gs = VG[s];
#pragma unroll
                for (int j = 0; j < 4; ++j) { const int t = t0 + 4 * q4 + j; const bool ok = dir == 0 ? (s <= t) : (s >= t);
                    const float w = ok ? __expf(gs - Mr[j]) : 0.f;
                    Sm[(4 * q4 + j) * 136 + s] = (bf16)f2bf(acc[j] * 0.125f * w); }
            }
            f32x4 res[9];
#pragma unroll
            for (int ct = 0; ct < 9; ++ct) {
                f32x4 acc1 = (f32x4){0.f, 0.f, 0.f, 0.f}, acc2 = (f32x4){0.f, 0.f, 0.f, 0.f};
#pragma unroll
                for (int s0 = 0; s0 < 128; s0 += 32)
                    acc1 = MFMA16(*(const LAS bf16x8*)(Sm + c16 * 136 + s0 + 8 * q4), *(const LAS bf16x8*)(VT + (16 * ct + c16) * 136 + s0 + 8 * q4), acc1);
#pragma unroll
                for (int k = 0; k < 2; ++k) acc2 = MFMA16(qa[k], *(const LAS bf16x8*)(Es + (16 * ct + c16) * 72 + 32 * k + 8 * q4), acc2);
#pragma unroll
                for (int j = 0; j < 4; ++j) res[ct][j] = acc1[j] + ar[j] * acc2[j];
            }
#pragma unroll
            for (int j = 0; j < 4; ++j) { const float den = shi(res[8][j], lane & 48); const float inv = 1.f / fmaxf(fabsf(den), er[j]);
#pragma unroll
                for (int ct = 0; ct < 8; ++ct) hsum[ct][j] += res[ct][j] * inv; }
            __syncthreads();
        }
#pragma unroll
        for (int j = 0; j < 4; ++j) {
            float ss = 0.f;
#pragma unroll
            for (int ct = 0; ct < 8; ++ct) ss += hsum[ct][j] * hsum[ct][j];
            ss += shx(ss, 1, lane); ss += shx(ss, 2, lane); ss += shx(ss, 4, lane); ss += shx(ss, 8, lane);
            const float rinv = rsqrtf(ss * (1.f / 128.f) + EPS);
            const size_t r = (size_t)(r0 + t0 + 4 * q4 + j);
#pragma unroll
            for (int ct = 0; ct < 8; ++ct) { const int d = 16 * ct + c16; const float mo = bf2f(P[r * NP + CO + h * 128 + d]);
                Y[r * DM + h * 128 + d] = (bf16)f2bf(hsum[ct][j] * rinv * mnw[h * 128 + d] / (1.f + __expf(-mo))); }
        }
    }
    __syncthreads();
}

__device__ __forceinline__ void phase_attn(Frame& F, int L, char* lds_generic) {
    const attn_body::bf16* QN = (const attn_body::bf16*)(F.ws + WS_QN); const attn_body::bf16* KN = (const attn_body::bf16*)(F.ws + WS_KN);
    const attn_body::bf16* P = (const attn_body::bf16*)(F.ws + WS_P); attn_body::bf16* Y = (attn_body::bf16*)(F.ws + WS_HY);
    const int nlat = NB * 8 * 32, nun = nlat + (L == 0 ? NB * 8 : 0);
    for (int base = 4 * F.vcu; base < nun; base += 4 * F.G)
        for (int i = 0; i < 4; ++i) {
            const int u = base + i; if (u >= nun) break;
            int bh, qrow0, NT;
            if (u < nlat) { bh = u >> 5; qrow0 = (bh >> 3) * TT + TC + (u & 31) * 256; NT = TT / 64; }
            else { bh = u - nlat; qrow0 = (bh >> 3) * TT; NT = TC / 64; }
            const int b = bh >> 3, h = bh & 7; const size_t krow0 = (size_t)b * TT;
            attn_body::attn_unit<8>(QN + (size_t)qrow0 * 512 + h * 64, KN + krow0 * 128 + (h >> 2) * 64, P + krow0 * NP + CAV + (h >> 2) * 64,
                                    Y + (size_t)qrow0 * DM + 512 + h * 64, NT, lds_generic);
        }
}

__device__ __forceinline__ void phase_norm2_route(Frame& F, CAP a) {
    LAS float* rT = (LAS float*)F.lds;
    LAS unsigned* hist = (LAS unsigned*)(F.lds + 32768);
    for (int idx = F.tid; idx < 8 * 1024; idx += NTHR) { const int k = idx >> 3, e = idx & 7; rT[e * 1024 + k] = ain(a, 17)[k * 8 + e]; }
    const float* nw = ain(a, 7) + 1 * DM;
    const float* mods = (const float*)(F.ws + WS_MODS) + (size_t)1 * 5 * 6144;
    bf16* H2 = (bf16*)(F.ws + WS_HY);
    int* TOKE = (int*)(F.ws + WS_ROUTE + RT_TOKE); float* TOKG = (float*)(F.ws + WS_ROUTE + RT_TOKG); int* CNT = (int*)(F.ws + WS_ROUTE + RT_CNT);
    for (int tb = blockIdx.x; tb < 256; tb += F.G) {
        if (F.tid < 16) hist[F.tid] = 0u;
        __syncthreads();
        for (int i = 0; i < 16; ++i) {
            const int tok = tb * 128 + F.wave * 16 + i, b = tok >> 13;
            const float* mv = mods + b * 6144;
            const RowVec R = norm_mod_row(aout(a) + (size_t)tok * DM, nw, mv + 3 * 1024, mv + 4 * 1024, F.lane);
            store_row_bf16(H2 + (size_t)tok * DM, R, F.lane);
            float lg[8];
#pragma unroll
            for (int e = 0; e < 8; ++e) { float s = 0.f;
#pragma unroll
                for (int j = 0; j < 4; ++j) s += dot4(R.h[j], *(const LAS f32x4*)(rT + e * 1024 + 256 * j + 4 * F.lane));
                lg[e] = wave_sum(s, F.lane); }
            float v0 = -INFINITY, v1 = -INFINITY; int i0 = 0, i1 = 0;
#pragma unroll
            for (int e = 0; e < 8; ++e) if (lg[e] > v0) { v0 = lg[e]; i0 = e; }
#pragma unroll
            for (int e = 0; e < 8; ++e) if (e != i0 && lg[e] > v1) { v1 = lg[e]; i1 = e; }
            if (F.lane == 0) { const float ex = __expf(v1 - v0), g0 = 1.f / (1.f + ex);
                TOKE[tok] = i0 | (i1 << 8); TOKG[2 * tok] = g0; TOKG[2 * tok + 1] = ex * g0;
                __hip_atomic_fetch_add(hist + i0, 1u, __ATOMIC_RELAXED, __HIP_MEMORY_SCOPE_WORKGROUP);
                __hip_atomic_fetch_add(hist + 8 + i1, 1u, __ATOMIC_RELAXED, __HIP_MEMORY_SCOPE_WORKGROUP); }
        }
        __syncthreads();
        if (F.tid < 16) CNT[tb * 16 + F.tid] = (int)hist[F.tid];
        __syncthreads();
    }
}
__device__ __forceinline__ void phase_moe_sort(Frame& F, CAP a) {
    LAS int* gbase = (LAS int*)F.lds;  LAS int* gtot = gbase + 16;  LAS unsigned* cur = (LAS unsigned*)(gbase + 32);  LAS int* postab = gbase + 64;
    const int* TOKE = (const int*)(F.ws + WS_ROUTE + RT_TOKE); const float* TOKG = (const float*)(F.ws + WS_ROUTE + RT_TOKG); const int* CNT = (const int*)(F.ws + WS_ROUTE + RT_CNT);
    int* INFO = (int*)(F.ws + WS_ROUTE + RT_INFO); int* TILEE = (int*)(F.ws + WS_ROUTE + RT_TILEE); int* ROWTOK = (int*)(F.ws + WS_ROUTE + RT_ROWTOK); float* ROWG = (float*)(F.ws + WS_ROUTE + RT_ROWG);
    const bf16* H2 = (const bf16*)(F.ws + WS_HY); bf16* AS = (bf16*)(F.ws + WS_ASORT);
    for (int tb = blockIdx.x; tb < 256; tb += F.G) {
        if (F.tid < 16) { int t = 0, mine = 0;
            for (int w = 0; w < 256; ++w) { const int c = CNT[w * 16 + F.tid]; t += c; mine += (w < tb) ? c : 0; }
            gtot[F.tid] = t; cur[F.tid] = (unsigned)mine; }
        __syncthreads();
        if (F.tid == 0) { int acc = 0; for (int g = 0; g < 16; ++g) { gbase[g] = acc; acc += (gtot[g] + 255) & ~255; } }
        __syncthreads();
        if (F.tid < 16) cur[F.tid] += (unsigned)gbase[F.tid];
        __syncthreads();
        if (F.tid < 128) { const int tok = tb * 128 + F.tid, ee = TOKE[tok], i0 = ee & 255, i1 = ee >> 8;
            const int p0 = (int)__hip_atomic_fetch_add(cur + i0, 1u, __ATOMIC_RELAXED, __HIP_MEMORY_SCOPE_WORKGROUP);
            const int p1 = (int)__hip_atomic_fetch_add(cur + 8 + i1, 1u, __ATOMIC_RELAXED, __HIP_MEMORY_SCOPE_WORKGROUP);
            ROWTOK[p0] = tok; ROWG[p0] = TOKG[2 * tok]; ROWTOK[p1] = tok; ROWG[p1] = TOKG[2 * tok + 1];
            postab[2 * F.tid] = p0; postab[2 * F.tid + 1] = p1; }
        __syncthreads();
        for (int c = 0; c < 32; ++c) { const int idx = F.wave * 32 + c, pos = postab[idx];
            const GAS v4u* src = (const GAS v4u*)(H2 + (size_t)(tb * 128 + (idx >> 1)) * DM) + F.lane; GAS v4u* dst = (GAS v4u*)(AS + (size_t)pos * DM) + F.lane;
            const v4u x0 = src[0], x1 = src[64]; dst[0] = x0; dst[64] = x1; }
        if (tb == 0) {
            for (int g = 0; g < 16; ++g) { const int lo = gbase[g] + gtot[g], hi = gbase[g] + ((gtot[g] + 255) & ~255);
                for (int p = lo + F.tid; p < hi; p += NTHR) ROWTOK[p] = -1; }
            if (F.tid == 0) { int nt0 = 0, nt1 = 0, tile = 0;
                for (int g = 0; g < 16; ++g) { const int ntile = (gtot[g] + 255) >> 8; for (int k = 0; k < ntile; ++k) TILEE[tile++] = g & 7; if (g < 8) nt0 += ntile; else nt1 += ntile; }
                INFO[0] = nt0; INFO[1] = nt1; }
        }
        __syncthreads();
    }
}

struct RowOrder : pg8::StaticOrder {
    int latent_only;
    __device__ __forceinline__ bool next(int i, pg8::Unit& u) const { if (!pg8::StaticOrder::next(i, u)) return false; if (latent_only) u.pm = (u.pm >> 5) * 33 + 1 + (u.pm & 31); return true; }
};
struct MoeUpOrder : pg8::StaticOrder {
    int lo; const int* tile_e;
    __device__ __forceinline__ bool next(int i, pg8::Unit& u) const { if (!pg8::StaticOrder::next(i, u)) return false; const int e = tile_e[lo + u.pm]; u.pm += lo; u.pn += e * 28; return true; }
};
struct MoeDownOrder : pg8::StaticOrder {
    int lo; const int* tile_e;
    __device__ __forceinline__ bool next(int i, pg8::Unit& u) const { if (!pg8::StaticOrder::next(i, u)) return false; const int e = tile_e[lo + u.pm]; u.pn += e * 4; return true; }
};
struct EpiGateRes {
    static constexpr bool PERM = false, AFTER_DRAIN = false;
    const float* baseLat; const float* baseCtx; float* outLat; float* outCtx; const float* gate;
    __device__ __forceinline__ void operator()(const pg8::f32x4 (&acc)[2][2][4][2], const pg8::Unit& u, int wr, int wc, int fr, int fq) const {
        const int b = u.pm / 33, j = u.pm % 33;
        const char* bp; char* op; const float* gv;
        if (j == 0) { const size_t off = (size_t)(b * TC) * DM; bp = (const char*)(baseCtx + off); op = (char*)(outCtx + off); gv = gate + 4 * 6144; }
        else { const size_t off = (size_t)(b * TL + (j - 1) * 256) * DM; bp = (const char*)(baseLat + off); op = (char*)(outLat + off); gv = gate + b * 6144; }
        const int col0 = u.pn * 256 + wc * 32 + 4 * fq;
        const unsigned off0 = (unsigned)((wr * 64 + fr) * DM + col0) * 4u;
        pg8::f32x4 g4[2][2];
#pragma unroll
        for (int bj = 0; bj < 2; ++bj)
#pragma unroll
            for (int n = 0; n < 2; ++n) g4[bj][n] = *(const pg8::f32x4*)(gv + col0 + bj * 128 + n * 16);
#pragma unroll
        for (int ai = 0; ai < 2; ++ai)
#pragma unroll
            for (int m = 0; m < 4; ++m) { const unsigned ro = off0 + (unsigned)((ai * 128 + m * 16) * DM * 4);
#pragma unroll
                for (int bj = 0; bj < 2; ++bj)
#pragma unroll
                    for (int n = 0; n < 2; ++n) { const unsigned p = ro + (unsigned)((bj * 128 + n * 16) * 4); *(pg8::f32x4*)(op + p) = *(const pg8::f32x4*)(bp + p) + g4[bj][n] * acc[ai][bj][m][n]; }
                asm volatile("" ::: "memory"); }
    }
};
struct EpiSwiGLU {
    static constexpr bool PERM = true, AFTER_DRAIN = false;
    bf16* O; int ldc; int pm_sub; int pn_mod;
    __device__ __forceinline__ void operator()(const pg8::f32x4 (&acc)[2][2][4][2], const pg8::Unit& u, int wr, int wc, int fr, int fq) const {
        const int row0 = (u.pm - pm_sub) * 256 + wr * 64 + fr, col0 = (u.pn % pn_mod) * 128 + wc * 32 + 8 * fq;
#pragma unroll
        for (int ai = 0; ai < 2; ++ai)
#pragma unroll
            for (int m = 0; m < 4; ++m) {
                const pg8::f32x4 g0 = acc[ai][0][m][0], g1 = acc[ai][0][m][1], u0 = acc[ai][1][m][0], u1 = acc[ai][1][m][1];
                v4u w; w.x = pg8::cvt_pk_bf16(siluf(g0[0]) * u0[0], siluf(g0[1]) * u0[1]); w.y = pg8::cvt_pk_bf16(siluf(g0[2]) * u0[2], siluf(g0[3]) * u0[3]);
                w.z = pg8::cvt_pk_bf16(siluf(g1[0]) * u1[0], siluf(g1[1]) * u1[1]); w.w = pg8::cvt_pk_bf16(siluf(g1[2]) * u1[2], siluf(g1[3]) * u1[3]);
                *(v4u*)(O + (size_t)(row0 + ai * 128 + m * 16) * ldc + col0) = w; }
    }
};
struct EpiMoeDown {
    static constexpr bool PERM = false, AFTER_DRAIN = false;
    float* x; const int* rowtok; const float* rowg; const float* gate2; int lo;
    __device__ __forceinline__ void operator()(const pg8::f32x4 (&acc)[2][2][4][2], const pg8::Unit& u, int wr, int wc, int fr, int fq) const {
        const int gt = (lo + u.pm) * 256 + wr * 64 + fr, col0 = (u.pn & 3) * 256 + wc * 32 + 4 * fq;
#pragma unroll
        for (int ai = 0; ai < 2; ++ai)
#pragma unroll
            for (int m = 0; m < 4; ++m) { const int r = gt + ai * 128 + m * 16, tok = rowtok[r];
                if (tok >= 0) { const float wg = rowg[r]; const float* gv = gate2 + (tok >> 13) * 6144 + col0; float* xp = x + (size_t)tok * DM + col0;
#pragma unroll
                    for (int bj = 0; bj < 2; ++bj)
#pragma unroll
                        for (int n = 0; n < 2; ++n) { const int c = bj * 128 + n * 16; *(pg8::f32x4*)(xp + c) = *(const pg8::f32x4*)(xp + c) + (*(const pg8::f32x4*)(gv + c) * wg) * acc[ai][bj][m][n]; } } }
    }
};

#ifndef MK_PER_PHASE
#define MK_PER_PHASE 0
#endif
#ifndef EN_MASK
#define EN_MASK 0xFFFFFFFFu
#endif
#define EN(bit) (((EN_MASK) >> (bit)) & 1u)
__global__ void __launch_bounds__(NTHR, 2) mk_fwd(Args a_unused) {
    extern __shared__ __attribute__((aligned(16))) unsigned char lds[];
    Frame F;
    F.lds = (LAS unsigned char*)lds;
    F.MISC = (volatile LAS unsigned*)(F.lds + MISC_OFF);
    F.tid = threadIdx.x; F.lane = F.tid & 63; F.wave = __builtin_amdgcn_readfirstlane(F.tid >> 6);
    F.G = gridDim.x; { const int bx = blockIdx.x; F.vcu = (F.G % 8 == 0) ? (bx % 8) * (F.G / 8) + bx / 8 : bx; }
    F.gw = F.vcu * NWAVES + F.wave; F.NGW = F.G * NWAVES;
    { CAP a = args_ptr(); F.ws = (unsigned char*)(GAS unsigned char*)(unsigned long long)a->ws; F.ctl = (gu32*)(F.ws + WS_CTL); }
    for (int u = F.tid; u < (LDS_BYTES - MISC_OFF) / 4; u += NTHR) ((LAS unsigned*)(F.lds + MISC_OFF))[u] = 0u;
    __syncthreads();
    XcdBarrier bar; bar.bar = (unsigned*)(F.ctl + CW_BAR); bar.x = 0; bar.st = nullptr;
    if (!MK_PER_PHASE) bar = xcd_barrier_post((unsigned*)(F.ctl + CW_BAR), F.MISC + 8);
    int lo, hi; { CAP a = args_ptr(); lo = a->ph_lo; hi = a->ph_hi; }
#define IN(k) (lo <= (k) && (k) < hi)
#define a (args_ptr())
#define FRESH() do { int t_ = threadIdx.x; asm volatile("" : "+v"(t_)); F.tid = t_; F.lane = t_ & 63; F.wave = __builtin_amdgcn_readfirstlane(t_ >> 6); F.gw = F.vcu * NWAVES + F.wave; \
        unsigned long long w_ = (unsigned long long)args_ptr()->ws; asm volatile("" : "+s"(w_)); F.ws = (unsigned char*)(GAS unsigned char*)w_; F.ctl = (gu32*)(F.ws + WS_CTL); } while (0)
#define SEAM(k) do { if (IN(k) && IN((k) + 1)) { if (MK_PER_PHASE) { if (F.tid == 0) __hip_atomic_store(F.ctl + 0, 0xBADBA0u, RLX_AGENT); } else xcd_barrier(bar); } } while (0)
#define HY ((bf16*)(F.ws + WS_HY))
#define CTXRES ((float*)(F.ws + WS_CTXRES))
#define MODS ((const float*)(F.ws + WS_MODS))

    FRESH();
    if (EN(0) && IN(0)) phase_prologue(F, a);
    SEAM(0); FRESH();
#pragma unroll 1
    for (int L = 0; L < 2; ++L) {
        const int pb = 1 + 9 * L;
        FRESH();
        if (EN(1) && IN(pb + 0)) phase_norm1(F, a, L);
        SEAM(pb + 0); FRESH();
        if (EN(2) && IN(pb + 1)) {
            pg8::Gemm g{HY, (const bf16*)(F.ws + WS_WIN) + (size_t)L * NP * DM, MROWS, NP, DM}; pg8::StaticOrder S; S.init(MROWS, NP, F.G, (int)blockIdx.x);
            pg8::EpiBf16<0> E{(bf16*)(F.ws + WS_P), NP, nullptr, 0, 0, 1.f};
            pg8::gemm_phase<pg8::EpiBf16<0>, pg8::StaticOrder, true, true>(F.lds, g, S, E);
        }
        SEAM(pb + 1); FRESH();
        if (IN(pb + 2)) { if (EN(3)) phase_qknorm(F, a, L); if (EN(4)) phase_mlstm_local(F, a, L); }
        SEAM(pb + 2); FRESH();
        if (IN(pb + 3)) { if (EN(5)) phase_scan(F); __syncthreads(); if (EN(6)) phase_attn(F, L, (char*)lds); }
        SEAM(pb + 3); FRESH();
        if (EN(7) && IN(pb + 4)) phase_mlstm_out(F, a, L);
        SEAM(pb + 4); FRESH();
        if (EN(8) && IN(pb + 5)) {
            const int lat = (L == 1);
            pg8::Gemm g{HY, (const bf16*)(F.ws + WS_WOUT) + (size_t)L * DM * DM, lat ? MLAT : MROWS, DM, DM}; RowOrder S; S.init(lat ? MLAT : MROWS, DM, F.G, (int)blockIdx.x); S.latent_only = lat;
            EpiGateRes E{L == 0 ? ain(a, 0) : (const float*)aout(a), L == 0 ? ain(a, 2) : (const float*)CTXRES, aout(a), CTXRES, MODS + (size_t)L * 5 * 6144 + 2 * 1024};
            pg8::gemm_phase<EpiGateRes, RowOrder, true, true>(F.lds, g, S, E);
        }
        SEAM(pb + 5); FRESH();
        if (L == 0) {
            FRESH();
            if (EN(9) && IN(7)) phase_norm2(F, a, 0);
            SEAM(7); FRESH();
            if (EN(10) && IN(8)) {
                pg8::Gemm g{HY, (const bf16*)(F.ws + WS_WGU), MROWS, 2 * DFF, DM}; pg8::StaticOrder S; S.init(MROWS, 2 * DFF, F.G, (int)blockIdx.x);
                EpiSwiGLU E{(bf16*)(F.ws + WS_ACT0), DFF, 0, 1 << 20};
                pg8::gemm_phase<EpiSwiGLU, pg8::StaticOrder, true, true>(F.lds, g, S, E);
            }
            SEAM(8); FRESH();
            if (EN(11) && IN(9)) {
                pg8::Gemm g{(const bf16*)(F.ws + WS_ACT0), (const bf16*)(F.ws + WS_WD), MROWS, DM, DFF}; RowOrder S; S.init(MROWS, DM, F.G, (int)blockIdx.x); S.latent_only = 0;
                EpiGateRes E{aout(a), CTXRES, aout(a), CTXRES, MODS + 5 * 1024};
                pg8::gemm_phase<EpiGateRes, RowOrder, true, true>(F.lds, g, S, E);
            }
            SEAM(9); FRESH();
        } else {
            FRESH();
            if (EN(12) && IN(16)) phase_norm2_route(F, a);
            SEAM(16); FRESH();
            if (EN(13) && IN(17)) phase_moe_sort(F, a);
            SEAM(17); FRESH();
            const int* INFO = (const int*)(F.ws + WS_ROUTE + RT_INFO); const int* TILEE = (const int*)(F.ws + WS_ROUTE + RT_TILEE);
#pragma unroll 1
            for (int p = 0; p < 4; ++p) {
                FRESH();
                int tlo = 0, thi = 0;
                if (IN(18 + 2 * p) || IN(19 + 2 * p)) { const int nt0 = INFO[0], nt1 = INFO[1]; const int sb = (p >> 1) ? nt0 : 0, sn = (p >> 1) ? nt1 : nt0;
                    tlo = sb + (p & 1) * PASS_TILES; thi = sb + ((p & 1) + 1) * PASS_TILES; if (thi > sb + sn) thi = sb + sn; if (tlo > thi) tlo = thi; }
                const int ntile = thi - tlo;
                if (EN(14) && IN(18 + 2 * p)) {
                    pg8::Gemm g{(const bf16*)(F.ws + WS_ASORT), (const bf16*)(F.ws + WS_MGU), ntile * 256, 2 * DFE, DM}; MoeUpOrder S; S.init(ntile * 256, 2 * DFE, F.G, (int)blockIdx.x); S.lo = tlo; S.tile_e = TILEE;
                    EpiSwiGLU E{(bf16*)(F.ws + WS_ACT1), DFE, tlo, 28};
                    pg8::gemm_phase<EpiSwiGLU, MoeUpOrder, true, true>(F.lds, g, S, E);
                }
                SEAM(18 + 2 * p); FRESH();
                if (EN(15) && IN(19 + 2 * p)) {
                    pg8::Gemm g{(const bf16*)(F.ws + WS_ACT1), (const bf16*)(F.ws + WS_MD), ntile * 256, DM, DFE}; MoeDownOrder S; S.init(ntile * 256, DM, F.G, (int)blockIdx.x); S.lo = tlo; S.tile_e = TILEE;
                    EpiMoeDown E{aout(a), (const int*)(F.ws + WS_ROUTE + RT_ROWTOK), (const float*)(F.ws + WS_ROUTE + RT_ROWG), MODS + (size_t)5 * 6144 + 5 * 1024, tlo};
                    pg8::gemm_phase<EpiMoeDown, MoeDownOrder, true, true>(F.lds, g, S, E);
                }
                SEAM(19 + 2 * p); FRESH();
            }
        }
    }
    FRESH();
    if (EN(16) && IN(26)) phase_final(F, a);
#undef IN
#undef SEAM
#undef a
#undef FRESH
#undef HY
#undef CTXRES
#undef MODS
}

extern "C" void kernel_launch(void* const* d_in, const int* in_sizes, int n_in, void* d_out, int out_size, void* d_ws, size_t ws_size, hipStream_t stream) {
    static int grid = 0;
    if (grid == 0) {
        if (n_in != 22 || in_sizes[0] != MLAT * DM || out_size != MLAT * DM || ws_size < WS_END) { fprintf(stderr, "kernel_launch: unexpected shapes (n_in %d, in0 %d, out %d, ws %zu); nothing launched\n", n_in, n_in > 0 ? in_sizes[0] : -1, out_size, ws_size); grid = -1; return; }
        int dev = 0, cus = 0, per_cu = 0;
        if (hipGetDevice(&dev) != hipSuccess || hipDeviceGetAttribute(&cus, hipDeviceAttributeMultiprocessorCount, dev) != hipSuccess) { grid = -1; return; }
        if (hipFuncSetAttribute((const void*)mk_fwd, hipFuncAttributeMaxDynamicSharedMemorySize, LDS_BYTES) != hipSuccess) { fprintf(stderr, "kernel_launch: hipFuncSetAttribute failed\n"); grid = -1; return; }
        if (hipOccupancyMaxActiveBlocksPerMultiprocessor(&per_cu, (const void*)mk_fwd, NTHR, LDS_BYTES) != hipSuccess || per_cu < 1) { fprintf(stderr, "kernel_launch: occupancy query says %d\n", per_cu); }
        (void)hipGetLastError();
        grid = cus;
    }
    if (grid < 0) return;
    if (hipMemsetAsync((char*)d_ws + WS_CTL, 0, CTL_ZERO_BYTES, stream) != hipSuccess) return;
    Args ha{};
    for (int i = 0; i < 22; ++i) ha.in[i] = (const float*)d_in[i];
    ha.out = (float*)d_out; ha.ws = (unsigned char*)d_ws; ha.li = 0; ha.pad = 0;
#if MK_PER_PHASE
    for (int k = 0; k < N_PHASES; ++k) { ha.ph_lo = k; ha.ph_hi = k + 1; hipLaunchKernelGGL(mk_fwd, dim3(grid), dim3(NTHR), LDS_BYTES, stream, ha); }
#else
    ha.ph_lo = 0; ha.ph_hi = N_PHASES;
    hipLaunchKernelGGL(mk_fwd, dim3(grid), dim3(NTHR), LDS_BYTES, stream, ha);
#endif
    (void)hipPeekAtLastError();
}
```

```cpp
#include <hip/hip_runtime.h>
#include <hip/hip_bf16.h>
#include <cstdio>
#include <cstdint>
#include <cmath>
namespace pg8 {
#define PG8_LAS __attribute__((address_space(3)))
typedef unsigned short bf16_t;
typedef short bf16x8 __attribute__((ext_vector_type(8)));
typedef float f32x4 __attribute__((ext_vector_type(4)));
typedef unsigned u32x4 __attribute__((ext_vector_type(4)));
typedef int i32x4_t __attribute__((ext_vector_type(4)));
typedef int i32x8_t __attribute__((ext_vector_type(8)));
constexpr int BM = 256, BK = 64, HALF = 128, HTB = HALF * BK * 2  , STAGE_BYTES = 8 * HTB, NXCD = 8, WGM = 8;

__host__ __device__ __forceinline__ int lds_byte(int r, int c) { const int st = (r >> 4) * 2 + (c >> 5), rr = r & 15, cc = c & 31, ob = rr * 64 + cc * 2; return st * 1024 + (ob ^ (((ob >> 9) & 1) << 5)); }
__host__ __device__ __forceinline__ void stage_rc(int b, int& R, int& C) { const int st = b / 1024, sb = b % 1024, swz = sb ^ (((sb >> 9) & 1) << 5); R = (st >> 1) * 16 + swz / 64; C = (st & 1) * 32 + (swz % 64) / 2; }
__host__ __device__ __forceinline__ int perm32(int rho) { const int n = rho >> 4, i = rho & 15; return 8 * (i >> 2) + 4 * n + (i & 3); }

struct Unit { int pm, pn, ko; };
struct Gemm { const bf16_t* A; const bf16_t* Bt; int M, N, K, ld; };

struct StaticOrder {
    int nM, nN, nwg, G, c;
    __host__ __device__ void init(int M, int N, int G_, int c_) { nM = M / BM; nN = N / BM; nwg = nM * nN; G = G_; c = c_; }
    __host__ __device__ bool next(int i, Unit& u) const {
        const long L = (long)i * G + c; if (L >= nwg) return false;
        int wgid = (int)L; { const int q = nwg / NXCD, r = nwg % NXCD, xcd = wgid % NXCD, off = wgid / NXCD; wgid = (xcd < r ? xcd * (q + 1) : r * (q + 1) + (xcd - r) * q) + off; }
        const int nig = WGM * nN, gid = wgid / nig, fm = gid * WGM, gsz = (nM - fm) < WGM ? (nM - fm) : WGM;
        u.pm = fm + ((wgid % nig) % gsz); u.pn = (wgid % nig) / gsz; u.ko = 0; return true;
    }
    __device__ __forceinline__ void a_ready(const Unit&) const {}
    __device__ __forceinline__ void done(const Unit&) const {}
};

__device__ __forceinline__ unsigned cvt_pk_bf16(float lo, float hi) { unsigned r; asm volatile("v_cvt_pk_bf16_f32 %0, %1, %2" : "=v"(r) : "v"(lo), "v"(hi)); return r; }
typedef float f32x2 __attribute__((ext_vector_type(2)));
__device__ __forceinline__ f32x2 gelu_pk(f32x2 v) {
    const f32x2 av = __builtin_elementwise_abs(v), d = av * 0.2316418882f + 1.0f;
    f32x2 t; t.x = __builtin_amdgcn_rcpf(d.x); t.y = __builtin_amdgcn_rcpf(d.y);
    f32x2 q = t * 0.5307027145f + (-0.7265760135f); q = q * t + 0.7107068705f; q = q * t + (-0.142248368f); q = q * t + 0.127414796f; q = q * t;
    const f32x2 s = (v * v) * (-0.72134752044f);
    f32x2 e; e.x = __builtin_amdgcn_exp2f(s.x); e.y = __builtin_amdgcn_exp2f(s.y);
    const f32x2 m = v * (q * e), r = v - m;
    f32x2 o; o.x = v.x < 0.f ? m.x : r.x; o.y = v.y < 0.f ? m.y : r.y; return o;
}

template <int ACT  > struct EpiBf16 {
    static constexpr int NST = 16; static constexpr bool PERM = true, AFTER_DRAIN = false; static_assert(ACT == 0 || ACT == 1, "EpiBf16: ACT is 0 (none) or 1 (gelu_pk)");
    bf16_t* O; int ldc; const float* bias; int split_cols; size_t split_stride; float scale0;
    __device__ __forceinline__ void operator()(const f32x4 (&acc)[2][2][4][2], const Unit& u, int wr, int wc, int fr, int fq) const {
        const int row0 = u.pm * BM + wr * 64 + fr; int colt = u.pn * BM; bf16_t* base = O;
        float sc = 1.f; if (split_cols) { const int t = colt / split_cols; base += (size_t)t * split_stride; colt -= t * split_cols; if (t == 0) sc = scale0; }
        const int col0 = colt + wc * 32 + 8 * fq, bcol0 = u.pn * BM + wc * 32 + 8 * fq;
        f32x4 bv[2][2];
#pragma unroll
        for (int bj = 0; bj < 2; ++bj)
#pragma unroll
            for (int n = 0; n < 2; ++n) bv[bj][n] = bias ? *(const f32x4*)(bias + bcol0 + bj * HALF + 4 * n) : (f32x4){0.f, 0.f, 0.f, 0.f};
#pragma unroll
        for (int ai = 0; ai < 2; ++ai)
#pragma unroll
            for (int m = 0; m < 4; ++m) { bf16_t* rowp = base + (size_t)(row0 + ai * HALF + m * 16) * ldc + col0;
#pragma unroll
                for (int bj = 0; bj < 2; ++bj) { f32x4 v0 = acc[ai][bj][m][0] + bv[bj][0], v1 = acc[ai][bj][m][1] + bv[bj][1];
                    if (ACT == 1) { f32x2 a = gelu_pk((f32x2){v0[0], v0[1]}), b = gelu_pk((f32x2){v0[2], v0[3]}), c = gelu_pk((f32x2){v1[0], v1[1]}), d = gelu_pk((f32x2){v1[2], v1[3]});
                        v0 = (f32x4){a.x, a.y, b.x, b.y}; v1 = (f32x4){c.x, c.y, d.x, d.y}; }
                    v0 = v0 * sc; v1 = v1 * sc; u32x4 w; w.x = cvt_pk_bf16(v0[0], v0[1]); w.y = cvt_pk_bf16(v0[2], v0[3]); w.z = cvt_pk_bf16(v1[0], v1[1]); w.w = cvt_pk_bf16(v1[2], v1[3]);
                    *(u32x4*)(rowp + bj * HALF) = w; } }
    }
};

struct PanelStats {
    unsigned* xbuf;
    unsigned* cnt;
    unsigned* tmo;
    int ntn; float eps;
    unsigned code;
    __device__ __forceinline__ bool run(const f32x4 (&v)[2][2][4][2], const Unit& u, int wr, int wc, int fr, int fq, PG8_LAS unsigned char* lds, int wid, int lane) const {
        typedef float f32x2v __attribute__((ext_vector_type(2)));
        PG8_LAS f32x2v* P = (PG8_LAS f32x2v*)lds;
        PG8_LAS f32x2v* S = (PG8_LAS f32x2v*)(lds + 8192);
        PG8_LAS unsigned* flag = (PG8_LAS unsigned*)(lds + 8192 + 2048);
#pragma unroll
        for (int ai = 0; ai < 2; ++ai)
#pragma unroll
            for (int m = 0; m < 4; ++m) {
                float s = 0.f;
#pragma unroll
                for (int bj = 0; bj < 2; ++bj)
#pragma unroll
                    for (int n = 0; n < 2; ++n) { const f32x4 x = v[ai][bj][m][n]; s += (x[0] + x[1]) + (x[2] + x[3]); }
                s += __shfl_xor(s, 16); s += __shfl_xor(s, 32);
                const float mw = s * (1.0f / 64.0f); float q = 0.f;
#pragma unroll
                for (int bj = 0; bj < 2; ++bj)
#pragma unroll
                    for (int n = 0; n < 2; ++n) { const f32x4 d = v[ai][bj][m][n] - mw; q += (d[0] * d[0] + d[1] * d[1]) + (d[2] * d[2] + d[3] * d[3]); }
                q += __shfl_xor(q, 16); q += __shfl_xor(q, 32);
                if (fq == 0) P[(ai * HALF + wr * 64 + m * 16 + fr) * 4 + wc] = (f32x2v){mw, q};
            }
        asm volatile("s_waitcnt lgkmcnt(0)" ::: "memory"); __builtin_amdgcn_s_barrier(); asm volatile("" ::: "memory");
#if defined(BROKEN_EXCHANGE_NO_WAIT)
#warning BROKEN CONTROL BUILD: the row-statistics exchange does not wait; results are wrong by design
        if (blockIdx.x >= 64) { const long long t0_ = clock64(); while (clock64() - t0_ < 60000) __builtin_amdgcn_s_sleep(8); }
#endif
        const int row = wid * 32 + (lane & 31);
        if (lane < 32) {
            const f32x2v a = P[row * 4 + 0], b = P[row * 4 + 1], c = P[row * 4 + 2], d = P[row * 4 + 3];
            const float mt = (a.x + b.x + c.x + d.x) * 0.25f;
            const float da = a.x - mt, db = b.x - mt, dc = c.x - mt, dd = d.x - mt;
            const float m2 = (a.y + b.y) + (c.y + d.y) + 64.0f * ((da * da + db * db) + (dc * dc + dd * dd));
            unsigned long long* slot = (unsigned long long*)xbuf + ((size_t)(u.pm * BM + row) * 4 + u.pn);
            __hip_atomic_store(slot, ((unsigned long long)__float_as_uint(m2) << 32) | __float_as_uint(mt), __ATOMIC_RELAXED, __HIP_MEMORY_SCOPE_AGENT);
        }
        asm volatile("s_waitcnt vmcnt(0)" ::: "memory");
        if (lane == 0) __hip_atomic_fetch_add(cnt + 64 * u.pm, 1u, __ATOMIC_RELAXED, __HIP_MEMORY_SCOPE_AGENT);
        if (wid == 0) {
            bool dead = false; const unsigned long long t0 = __builtin_amdgcn_s_memrealtime(); const unsigned want = 8u * (unsigned)ntn;
            for (;;) {
#if defined(BROKEN_EXCHANGE_NO_WAIT)
                break;
#endif
                if ((unsigned)__builtin_amdgcn_readfirstlane(__hip_atomic_load(cnt + 64 * u.pm, __ATOMIC_RELAXED, __HIP_MEMORY_SCOPE_AGENT)) >= want) break;
                if (__builtin_amdgcn_s_memrealtime() - t0 > 2000000ull) {
                    if (lane == 0) { unsigned expect = 0u; __hip_atomic_compare_exchange_strong(tmo + 1, &expect, code | (unsigned)(u.pm & 0xff), __ATOMIC_RELAXED, __ATOMIC_RELAXED, __HIP_MEMORY_SCOPE_AGENT);
                                     __hip_atomic_store(tmo, 1u, __ATOMIC_RELAXED, __HIP_MEMORY_SCOPE_AGENT); }
                    dead = true; break; }
                __builtin_amdgcn_s_sleep(2);
            }
            __builtin_amdgcn_fence(__ATOMIC_ACQUIRE, "agent");
            if (lane == 0) flag[0] = dead ? 1u : 0u;
        }
        asm volatile("s_waitcnt vmcnt(0) lgkmcnt(0)" ::: "memory"); __builtin_amdgcn_s_barrier(); asm volatile("" ::: "memory");
        const bool bad = flag[0] != 0u;
        if (lane < 32) {
            const unsigned long long* slot = (const unsigned long long*)xbuf + (size_t)(u.pm * BM + row) * 4; float mt[4], m2[4]; float ms = 0.f;
#pragma unroll
            for (int t = 0; t < 4; ++t) { if (t < ntn) { const unsigned long long w = __hip_atomic_load(slot + t, __ATOMIC_RELAXED, __HIP_MEMORY_SCOPE_AGENT); mt[t] = __uint_as_float((unsigned)w); m2[t] = __uint_as_float((unsigned)(w >> 32)); } else { mt[t] = 0.f; m2[t] = 0.f; } ms += mt[t]; }
            const float mean = ms / (float)ntn; float q = 0.f;
#pragma unroll
            for (int t = 0; t < 4; ++t) if (t < ntn) { const float dm = mt[t] - mean; q += m2[t] + 256.0f * dm * dm; }
            S[row] = (f32x2v){mean, 1.0f / sqrtf(q / (256.0f * (float)ntn) + eps)};
        }
        asm volatile("s_waitcnt lgkmcnt(0)" ::: "memory"); __builtin_amdgcn_s_barrier(); asm volatile("" ::: "memory");
        return bad;
    }
};
struct EpiLnRes {
    static constexpr int NST = 0; static constexpr bool PERM = false, AFTER_DRAIN = true;
    const float* base; float* out; int ldc; const float* bias; PanelStats st; unsigned poison;
    __device__ __forceinline__ void fused(f32x4 (&acc)[2][2][4][2], const Unit& u, int wr, int wc, int fr, int fq, PG8_LAS unsigned char* lds, int wid, int lane) const {
        typedef float f32x2v __attribute__((ext_vector_type(2)));
        const PG8_LAS f32x2v* S = (const PG8_LAS f32x2v*)(lds + 8192);
        const int col0 = u.pn * BM + wc * 32 + 4 * fq;
#pragma unroll
        for (int bj = 0; bj < 2; ++bj)
#pragma unroll
            for (int n = 0; n < 2; ++n) { const f32x4 bv = bias ? *(const f32x4*)(bias + col0 + bj * HALF + n * 16) : (f32x4){0.f, 0.f, 0.f, 0.f};
#pragma unroll
                for (int ai = 0; ai < 2; ++ai)
#pragma unroll
                    for (int m = 0; m < 4; ++m) acc[ai][bj][m][n] += bv; }
        f32x4 pre[4][2][2];
#pragma unroll
        for (int m = 0; m < 4; ++m) { const size_t off = (size_t)(u.pm * BM + wr * 64 + m * 16 + fr) * ldc + col0;
#pragma unroll
            for (int bj = 0; bj < 2; ++bj)
#pragma unroll
                for (int n = 0; n < 2; ++n) pre[m][bj][n] = *(const f32x4*)(base + off + bj * HALF + n * 16); }
        const bool bad = st.run(acc, u, wr, wc, fr, fq, lds, wid, lane) || poison != 0u;
        const float qnan = __builtin_nanf("");
#pragma unroll
        for (int ai = 0; ai < 2; ++ai)
#pragma unroll
            for (int m = 0; m < 4; ++m) { const int r = ai * HALF + wr * 64 + m * 16 + fr; const f32x2v sr = S[r]; const size_t off = (size_t)(u.pm * BM + r) * ldc + col0;
#pragma unroll
                for (int bj = 0; bj < 2; ++bj)
#pragma unroll
                    for (int n = 0; n < 2; ++n) { const f32x4 bs = ai == 0 ? pre[m][bj][n] : *(const f32x4*)(base + off + bj * HALF + n * 16); f32x4 o = bs + (acc[ai][bj][m][n] - sr.x) * sr.y;
                        if (bad) o = (f32x4){qnan, qnan, qnan, qnan}; *(f32x4*)(out + off + bj * HALF + n * 16) = o; }
                if (m & 1) asm volatile("" ::: "memory"); }
    }
};
struct EpiLnResLn {
    static constexpr int NST = 0; static constexpr bool PERM = false, AFTER_DRAIN = true;
    const float* base; float* out; bf16_t* xn; int ldc; const float* bias; PanelStats st1, st2; unsigned poison;
    __device__ __forceinline__ void fused(f32x4 (&acc)[2][2][4][2], const Unit& u, int wr, int wc, int fr, int fq, PG8_LAS unsigned char* lds, int wid, int lane) const {
        typedef float f32x2v __attribute__((ext_vector_type(2))); typedef unsigned u32x2v __attribute__((ext_vector_type(2)));
        const PG8_LAS f32x2v* S = (const PG8_LAS f32x2v*)(lds + 8192);
        const int col0 = u.pn * BM + wc * 32 + 4 * fq;
#pragma unroll
        for (int bj = 0; bj < 2; ++bj)
#pragma unroll
            for (int n = 0; n < 2; ++n) { const f32x4 bv = bias ? *(const f32x4*)(bias + col0 + bj * HALF + n * 16) : (f32x4){0.f, 0.f, 0.f, 0.f};
#pragma unroll
                for (int ai = 0; ai < 2; ++ai)
#pragma unroll
                    for (int m = 0; m < 4; ++m) acc[ai][bj][m][n] += bv; }
        bool bad = st1.run(acc, u, wr, wc, fr, fq, lds, wid, lane) || poison != 0u;
        const float qnan = __builtin_nanf("");
#pragma unroll
        for (int ai = 0; ai < 2; ++ai)
#pragma unroll
            for (int m = 0; m < 4; ++m) { const int r = ai * HALF + wr * 64 + m * 16 + fr; const f32x2v sr = S[r]; const size_t off = (size_t)(u.pm * BM + r) * ldc + col0;
#pragma unroll
                for (int bj = 0; bj < 2; ++bj)
#pragma unroll
                    for (int n = 0; n < 2; ++n) { const f32x4 bs = *(const f32x4*)(base + off + bj * HALF + n * 16); acc[ai][bj][m][n] = bs + (acc[ai][bj][m][n] - sr.x) * sr.y; }
                asm volatile("" : "+v"(acc[ai][0][m][0]), "+v"(acc[ai][0][m][1]), "+v"(acc[ai][1][m][0]), "+v"(acc[ai][1][m][1]));
                if (m & 1) asm volatile("" ::: "memory"); }
        const bool bad1 = bad;
        bad = st2.run(acc, u, wr, wc, fr, fq, lds, wid, lane) || bad;
#pragma unroll
        for (int ai = 0; ai < 2; ++ai)
#pragma unroll
            for (int m = 0; m < 4; ++m) { const int r = ai * HALF + wr * 64 + m * 16 + fr; const f32x2v sr = S[r]; const size_t off = (size_t)(u.pm * BM + r) * ldc + col0;
#pragma unroll
                for (int bj = 0; bj < 2; ++bj)
#pragma unroll
                    for (int n = 0; n < 2; ++n) { const f32x4 x1 = acc[ai][bj][m][n]; *(f32x4*)(out + off + bj * HALF + n * 16) = bad1 ? (f32x4){qnan, qnan, qnan, qnan} : x1;
                        const f32x4 o = (x1 - sr.x) * sr.y; u32x2v w; w.x = cvt_pk_bf16(o[0], o[1]); w.y = cvt_pk_bf16(o[2], o[3]);
                        if (bad) { w.x = 0x7fc07fc0u; w.y = 0x7fc07fc0u; } *(u32x2v*)(xn + off + bj * HALF + n * 16) = w; }
                asm volatile("" ::: "memory"); }
    }
};

template <class Epi, class Sched, bool ALIGN_EPI = false, bool SP2 = false, int MODE = 0  >
__device__ __forceinline__ void gemm_phase(PG8_LAS unsigned char* lds, const Gemm g, const Sched& S, const Epi& E) {
    int tid_ = threadIdx.x; asm volatile("" : "+v"(tid_));
    const int tid = tid_, wid = __builtin_amdgcn_readfirstlane(tid >> 6), lane = tid & 63, wr = wid >> 2, wc = wid & 3, fr = lane & 15, fq = lane >> 4;
    const int K = g.ld, nt = g.K / BK;
    unsigned voffA[2], voffB[2];
#pragma unroll
    for (int i = 0; i < 2; ++i) { int R, C; stage_rc(tid * 16 + i * 8192, R, C); const int Rb = Epi::PERM ? ((R & ~31) + perm32(R & 31)) : R;
        voffA[i] = (unsigned)(R * K + C) * 2u; voffB[i] = (unsigned)(Rb * K + C) * 2u; }
    const size_t kstep = (size_t)(BK * 2);
    const size_t hstep = (size_t)HALF * K * 2;
    const size_t tstep = 2 * hstep;
    const unsigned ldsw = (unsigned)wid * 1024u;
    const int aoff = lds_byte(wr * 64 + fr, fq * 8), boff = lds_byte(wc * 32 + fr, fq * 8);
#define PG8_SA(b, h) (((b) * 2 + (h)) * HTB)
#define PG8_SB(b, h) ((4 + (b) * 2 + (h)) * HTB)
#define PG8_STAGE(bufoff, gbase, voff) do { _Pragma("unroll") for (int _i = 0; _i < 2; ++_i) \
        __builtin_amdgcn_global_load_lds((const unsigned*)((const char*)(gbase) + (voff)[_i]), (PG8_LAS unsigned*)(lds + (bufoff) + ldsw + _i * 8192), 16, 0, 0); } while (0)
#define PG8_LDA(dst, b, h) do { _Pragma("unroll") for (int m = 0; m < 4; ++m) dst[m] = PG8_CAT(*(const PG8_LAS bf16x8*)(lds + PG8_SA(b, h) + aoff + m * 2048), *(const PG8_LAS bf16x8*)(lds + PG8_SA(b, h) + aoff + m * 2048 + 1024)); } while (0)
#define PG8_LDB(dst, b, h) do { _Pragma("unroll") for (int n = 0; n < 2; ++n) dst[n] = PG8_CAT(*(const PG8_LAS bf16x8*)(lds + PG8_SB(b, h) + boff + n * 2048), *(const PG8_LAS bf16x8*)(lds + PG8_SB(b, h) + boff + n * 2048 + 1024)); } while (0)
#define PG8_CAT(lo, hi) __builtin_shufflevector(__builtin_bit_cast(i32x4_t, lo), __builtin_bit_cast(i32x4_t, hi), 0, 1, 2, 3, 4, 5, 6, 7)
#define PG8_LO(x) __builtin_bit_cast(bf16x8, __builtin_shufflevector(x, x, 0, 1, 2, 3))
#define PG8_HI(x) __builtin_bit_cast(bf16x8, __builtin_shufflevector(x, x, 4, 5, 6, 7))
#define PG8_MMA(ai, bj, At, Bt) do { __builtin_amdgcn_s_setprio(1); _Pragma("unroll") for (int m = 0; m < 4; ++m) _Pragma("unroll") for (int n = 0; n < 2; ++n) { \
        if constexpr (MODE == 1) asm volatile("v_mfma_scale_f32_16x16x128_f8f6f4 %0, %1, %2, %0, %3, %3 op_sel_hi:[0,0,0]" : "+v"(acc[ai][bj][m][n]) : "v"(Bt[n]), "v"(At[m]), "v"(sc1)); \
        else if constexpr (MODE == 2) { asm volatile("v_mfma_i32_16x16x64_i8 %0, %1, %2, %0" : "+v"(acc[ai][bj][m][n]) : "v"(PG8_LO(Bt[n])), "v"(PG8_LO(At[m]))); \
               asm volatile("v_mfma_i32_16x16x64_i8 %0, %1, %2, %0" : "+v"(acc[ai][bj][m][n]) : "v"(PG8_HI(Bt[n])), "v"(PG8_HI(At[m]))); } \
        else { acc[ai][bj][m][n] = __builtin_amdgcn_mfma_f32_16x16x32_bf16(PG8_LO(Bt[n]), PG8_LO(At[m]), acc[ai][bj][m][n], 0, 0, 0); \
               acc[ai][bj][m][n] = __builtin_amdgcn_mfma_f32_16x16x32_bf16(PG8_HI(Bt[n]), PG8_HI(At[m]), acc[ai][bj][m][n], 0, 0, 0); } } __builtin_amdgcn_s_setprio(0); } while (0)
#define PG8_WAIT_V(n) asm volatile("s_waitcnt vmcnt(" #n ")" ::: "memory")
#define PG8_W8E_ASM(NS) asm volatile("s_cmp_lg_u32 %0, 0\n\ts_cbranch_scc1 .Lw8e_%=\n\ts_waitcnt vmcnt(8)\n\ts_branch .Lw8d_%=\n.Lw8e_%=:\n\ts_waitcnt vmcnt(" #NS ")\n.Lw8d_%=:" :: "s"(fl_) : "memory", "scc")
#define PG8_WAIT_V8E do { const int fl_ = __builtin_amdgcn_readfirstlane((t == 0 && ui > 0) ? 1 : 0);   \
        if constexpr (Epi::NST == 8) PG8_W8E_ASM(16); else if constexpr (Epi::NST == 16) PG8_W8E_ASM(24); else if constexpr (Epi::NST == 32) PG8_W8E_ASM(40); else { (void)fl_; asm volatile("s_waitcnt vmcnt(8)" ::: "memory"); } } while (0)
#define PG8_WAIT_L(n) asm volatile("s_waitcnt lgkmcnt(" #n ")" ::: "memory")
#define PG8_BAR __builtin_amdgcn_s_barrier()
#define PG8_SCHED __builtin_amdgcn_sched_barrier(0)
    Unit cur, nxt; int ui = 0;
    if (!S.next(0, cur)) return;
    f32x4 acc[2][2][4][2];
#pragma unroll
    for (int a = 0; a < 2; ++a)
#pragma unroll
        for (int b = 0; b < 2; ++b)
#pragma unroll
            for (int m = 0; m < 4; ++m)
#pragma unroll
                for (int n = 0; n < 2; ++n) acc[a][b][m][n] = (f32x4){0.f, 0.f, 0.f, 0.f};
    const int sc1 = 0x7F7F7F7F;
    i32x8_t At[4], B0[2], B1[2];
    const char* cA = (const char*)g.A + (size_t)cur.pm * tstep + (size_t)cur.ko * 2; const char* cB = (const char*)g.Bt + (size_t)cur.pn * tstep + (size_t)cur.ko * 2;
    S.a_ready(cur);
    if constexpr (SP2) {
        PG8_STAGE(PG8_SB(0, 0), cB, voffB); PG8_STAGE(PG8_SB(0, 1), cB + hstep, voffB); PG8_STAGE(PG8_SA(0, 0), cA, voffA); PG8_STAGE(PG8_SA(0, 1), cA + hstep, voffA);
        if (wr == 1) PG8_BAR;
        PG8_WAIT_V(2); PG8_BAR;
        PG8_STAGE(PG8_SB(1, 0), cB + kstep, voffB); PG8_STAGE(PG8_SA(1, 0), cA + kstep, voffA); PG8_STAGE(PG8_SB(1, 1), cB + hstep + kstep, voffB);
        PG8_WAIT_V(6); PG8_BAR;
    } else {
        PG8_STAGE(PG8_SB(0, 0), cB, voffB); PG8_STAGE(PG8_SA(0, 0), cA, voffA); PG8_STAGE(PG8_SB(0, 1), cB + hstep, voffB); PG8_STAGE(PG8_SA(0, 1), cA + hstep, voffA);
        if (wr == 1) PG8_BAR;
        PG8_WAIT_V(4); PG8_BAR;
        PG8_STAGE(PG8_SB(1, 0), cB + kstep, voffB); PG8_STAGE(PG8_SA(1, 0), cA + kstep, voffA); PG8_STAGE(PG8_SB(1, 1), cB + hstep + kstep, voffB);
        PG8_WAIT_V(6); PG8_BAR;
    }
    for (;;) {
        const bool has_next = S.next(ui + 1, nxt);
        const char* nA = has_next ? (const char*)g.A + (size_t)nxt.pm * tstep + (size_t)nxt.ko * 2 : cA; const char* nB = has_next ? (const char*)g.Bt + (size_t)nxt.pn * tstep + (size_t)nxt.ko * 2 : cB;
        for (int t = 0; t < nt; t += 2) {
            const bool last = (t == nt - 2);
            const char* a1 = cA + (size_t)(t + 1) * kstep;
            const char* a2 = last ? nA : cA + (size_t)(t + 2) * kstep; const char* b2 = last ? nB : cB + (size_t)(t + 2) * kstep;
            const char* a3 = a2 + kstep; const char* b3 = b2 + kstep;
            if (last && has_next) S.a_ready(nxt);
            if constexpr (SP2) {
            PG8_LDB(B0, 0, 0); PG8_LDB(B1, 0, 1); PG8_SCHED; PG8_LDA(At, 0, 0); PG8_STAGE(PG8_SA(1, 1), a1 + hstep, voffA);
            PG8_WAIT_V8E; PG8_WAIT_L(0); PG8_BAR; PG8_MMA(0, 0, At, B0); PG8_MMA(0, 1, At, B1); PG8_BAR; PG8_SCHED;
            PG8_LDA(At, 0, 1); PG8_STAGE(PG8_SB(0, 0), b2, voffB); PG8_STAGE(PG8_SB(0, 1), b2 + hstep, voffB); PG8_STAGE(PG8_SA(0, 0), a2, voffA);
            PG8_WAIT_V8E; PG8_WAIT_L(0); PG8_BAR; PG8_MMA(1, 0, At, B0); PG8_MMA(1, 1, At, B1); PG8_BAR; PG8_SCHED;
            PG8_LDB(B0, 1, 0); PG8_LDB(B1, 1, 1); PG8_SCHED; PG8_LDA(At, 1, 0); PG8_STAGE(PG8_SA(0, 1), a2 + hstep, voffA);
            PG8_WAIT_V(8); PG8_WAIT_L(0); PG8_BAR; PG8_MMA(0, 0, At, B0); PG8_MMA(0, 1, At, B1); PG8_BAR; PG8_SCHED;
            PG8_LDA(At, 1, 1); PG8_STAGE(PG8_SB(1, 0), b3, voffB); PG8_STAGE(PG8_SB(1, 1), b3 + hstep, voffB); PG8_STAGE(PG8_SA(1, 0), a3, voffA);
            PG8_WAIT_V(8); PG8_WAIT_L(0); PG8_BAR; PG8_MMA(1, 0, At, B0); PG8_MMA(1, 1, At, B1); PG8_BAR; PG8_SCHED;
            } else {
            PG8_LDB(B0, 0, 0); PG8_SCHED; PG8_LDA(At, 0, 0); PG8_STAGE(PG8_SA(1, 1), a1 + hstep, voffA);
            PG8_WAIT_L(8); PG8_BAR; PG8_WAIT_L(0); PG8_MMA(0, 0, At, B0); PG8_BAR; PG8_SCHED;
            PG8_LDB(B1, 0, 1); PG8_STAGE(PG8_SB(0, 0), b2, voffB);
            PG8_BAR; PG8_WAIT_L(0); PG8_MMA(0, 1, At, B1); PG8_BAR;
            PG8_LDA(At, 0, 1); PG8_STAGE(PG8_SA(0, 0), a2, voffA);
            PG8_BAR; PG8_WAIT_L(0); PG8_MMA(1, 0, At, B0); PG8_BAR; PG8_SCHED;
            PG8_STAGE(PG8_SB(0, 1), b2 + hstep, voffB);
            PG8_WAIT_V(6); PG8_BAR; PG8_MMA(1, 1, At, B1); PG8_BAR;
            PG8_LDB(B0, 1, 0); PG8_SCHED; PG8_LDA(At, 1, 0); PG8_STAGE(PG8_SA(0, 1), a2 + hstep, voffA);
            PG8_WAIT_L(8); PG8_BAR; PG8_WAIT_L(0); PG8_MMA(0, 0, At, B0); PG8_BAR; PG8_SCHED;
            PG8_LDB(B1, 1, 1); PG8_STAGE(PG8_SB(1, 0), b3, voffB);
            PG8_BAR; PG8_WAIT_L(0); PG8_MMA(0, 1, At, B1); PG8_BAR;
            PG8_LDA(At, 1, 1); PG8_STAGE(PG8_SA(1, 0), a3, voffA);
            PG8_BAR; PG8_WAIT_L(0); PG8_MMA(1, 0, At, B0); PG8_BAR; PG8_SCHED;
            PG8_STAGE(PG8_SB(1, 1), b3 + hstep, voffB);
            PG8_WAIT_V(6); PG8_BAR; PG8_MMA(1, 1, At, B1); PG8_BAR;
            }
        }
        if constexpr (MODE != 0) asm volatile("s_nop 15\n\ts_nop 7" ::: "memory");
        if constexpr (ALIGN_EPI) { if (wr == 0) PG8_BAR; }
        if constexpr (!Epi::AFTER_DRAIN) { E(acc, cur, wr, wc, fr, fq); S.done(cur); }
        if (!has_next) break;
#pragma unroll
        for (int a = 0; a < 2; ++a)
#pragma unroll
            for (int b = 0; b < 2; ++b)
#pragma unroll
                for (int m = 0; m < 4; ++m)
#pragma unroll
                    for (int n = 0; n < 2; ++n) { double z0_, z1_; asm volatile("v_mov_b64 %0, 0\n\tv_mov_b64 %1, 0" : "=v"(z0_), "=v"(z1_));
                    typedef double f64x2z __attribute__((ext_vector_type(2))); acc[a][b][m][n] = __builtin_bit_cast(f32x4, (f64x2z){z0_, z1_}); }
        cur = nxt; cA = nA; cB = nB; ++ui;
        if constexpr (ALIGN_EPI) { if (wr == 1) PG8_BAR; }
    }
    PG8_WAIT_V(0);
    if constexpr (!ALIGN_EPI) { if (wr == 0) PG8_BAR; }
    PG8_BAR;
    if constexpr (Epi::AFTER_DRAIN) { E.fused(acc, cur, wr, wc, fr, fq, lds, wid, lane); S.done(cur); }
#undef PG8_SA
#undef PG8_SB
#undef PG8_STAGE
#undef PG8_LDA
#undef PG8_LDB
#undef PG8_MMA
#undef PG8_CAT
#undef PG8_LO
#undef PG8_HI
#undef PG8_WAIT_V
#undef PG8_WAIT_V8E
#undef PG8_W8E_ASM
#undef PG8_WAIT_L
#undef PG8_BAR
#undef PG8_SCHED
}
}
namespace attn_body {
using bf16=__hip_bfloat16;
using bf16x8=__attribute__((ext_vector_type(8)))short;
using s16x4=__attribute__((ext_vector_type(4)))short;
using f32x16=__attribute__((ext_vector_type(16)))float;
using u32x4=__attribute__((ext_vector_type(4)))unsigned;
constexpr int D=64;
constexpr int NW=8,QBLK=32,QB=QBLK*NW,KVBLK=64;
constexpr int QP=512,KP=128,VP=2304,OP=1024,QPR=2304;
constexpr int ATTN_UNIT_ROWS=QB;
__device__ __forceinline__ int crow(int r,int hi){return (r&3)+8*(r>>2)+4*hi;}
#define SBAR() __builtin_amdgcn_sched_barrier(0)
__device__ __forceinline__ void cmask(f32x16&p0,f32x16&p1,int jb,int qrel,int hi){
  const float NEG=-INFINITY; int kb=64*jb+4*hi;
  #pragma unroll
  for(int r=0;r<16;++r){int kv=kb+(r&3)+8*(r>>2); if(kv>qrel)p0[r]=NEG; if(kv+32>qrel)p1[r]=NEG;}
}

constexpr int NSLOT=3, SLOTB=8192;
constexpr int LDS_K=0, LDS_V=NSLOT*SLOTB, LDS_WS=2*NSLOT*SLOTB, LDS_OST=LDS_WS+NW*64*4, LDS_BYTES=LDS_OST+NW*4096;
constexpr float C2=0.125f*1.4426950408889634f;
__device__ __forceinline__ void glds16(const void*gsrc,unsigned lds_dst){unsigned keep;
  asm volatile("s_mov_b32 %0, m0\n\ts_mov_b32 m0, %2\n\ts_nop 0\n\tglobal_load_lds_dwordx4 %1, off\n\ts_mov_b32 m0, %0":"=&s"(keep):"v"(gsrc),"s"(lds_dst):"memory");}
__device__ __forceinline__ float max3f(float a,float b,float c){float r;asm("v_max3_f32 %0, %1, %2, %3":"=v"(r):"v"(a),"v"(b),"v"(c));return r;}
__device__ __forceinline__ float max2f(float a,float b){float r;asm("v_max_f32_e32 %0, %1, %2":"=v"(r):"v"(a),"v"(b));return r;}
__device__ __forceinline__ float fadd_s(float a,float b){float r;asm("v_add_f32_e32 %0, %1, %2":"=v"(r):"v"(a),"v"(b));return r;}
__device__ __forceinline__ float fsub_s(float a,float b){float r;asm("v_sub_f32_e32 %0, %1, %2":"=v"(r):"v"(a),"v"(b));return r;}
typedef float f32x2_t __attribute__((ext_vector_type(2))); typedef __bf16 bf16x2_t __attribute__((ext_vector_type(2)));
__device__ __forceinline__ unsigned cvtpk_s(float lo,float hi){f32x2_t v={lo,hi};bf16x2_t b=__builtin_convertvector(v,bf16x2_t);return __builtin_bit_cast(unsigned,b);}
#define WAIT_BAR(N) asm volatile("s_waitcnt vmcnt(" #N ") lgkmcnt(0)\n\ts_barrier":::"memory")

__device__ __forceinline__ void qkt(f32x16&p0,f32x16&p1,const char*Kslot,const bf16x8*qr,const f32x16&negm,int r32,int hi){
  const char*kb=Kslot+hi*1024+r32*16;
  #pragma unroll
  for(int d0=0;d0<4;++d0){
    const bf16x8 b0=*reinterpret_cast<const bf16x8*>(kb+d0*2048);
    const bf16x8 b1=*reinterpret_cast<const bf16x8*>(kb+d0*2048+512);
    if(d0==0){p0=__builtin_amdgcn_mfma_f32_32x32x16_bf16(b0,qr[0],negm,0,0,0);p1=__builtin_amdgcn_mfma_f32_32x32x16_bf16(b1,qr[0],negm,0,0,0);}
    else{p0=__builtin_amdgcn_mfma_f32_32x32x16_bf16(b0,qr[d0],p0,0,0,0);p1=__builtin_amdgcn_mfma_f32_32x32x16_bf16(b1,qr[d0],p1,0,0,0);}}
}
typedef __attribute__((address_space(3))) const char* lds_cptr;
typedef short v4i16_t __attribute__((ext_vector_type(4)));
__device__ __forceinline__ void kload8(bf16x8*kf,lds_cptr kp){
  kf[0]=*(const __attribute__((address_space(3))) bf16x8*)(kp);      kf[1]=*(const __attribute__((address_space(3))) bf16x8*)(kp+512);
  kf[2]=*(const __attribute__((address_space(3))) bf16x8*)(kp+2048); kf[3]=*(const __attribute__((address_space(3))) bf16x8*)(kp+2560);
  kf[4]=*(const __attribute__((address_space(3))) bf16x8*)(kp+4096); kf[5]=*(const __attribute__((address_space(3))) bf16x8*)(kp+4608);
  kf[6]=*(const __attribute__((address_space(3))) bf16x8*)(kp+6144); kf[7]=*(const __attribute__((address_space(3))) bf16x8*)(kp+6656);
}
__device__ __forceinline__ void kload2(bf16x8*kf,lds_cptr kp,int j){ kf[2*j]=*(const __attribute__((address_space(3))) bf16x8*)(kp+j*2048); kf[2*j+1]=*(const __attribute__((address_space(3))) bf16x8*)(kp+j*2048+512); }
__device__ __forceinline__ s16x4 vtr(lds_cptr p){ return __builtin_bit_cast(s16x4,__builtin_amdgcn_ds_read_tr16_b64_v4i16((__attribute__((address_space(3))) v4i16_t*)p)); }
__device__ __forceinline__ float rowmax(const f32x16&p0,const f32x16&p1){
  float a=max3f(p0[0],p0[1],p1[0]),b=max3f(p0[2],p0[3],p1[1]);a=max3f(a,p1[2],p1[3]);
  #pragma unroll
  for(int r=4;r<16;r+=4){a=max3f(a,p0[r],p0[r+1]);b=max3f(b,p0[r+2],p0[r+3]);a=max3f(a,p1[r],p1[r+1]);b=max3f(b,p1[r+2],p1[r+3]);}
  const float m=max2f(a,b);
  auto rr=__builtin_amdgcn_permlane32_swap(__float_as_uint(m),__float_as_uint(m),false,false);
  return max2f(__uint_as_float(rr[0]),__uint_as_float(rr[1]));
}
__device__ __forceinline__ void pv(f32x16*o,int vb,bf16x8 pa0,bf16x8 pa1,bf16x8 pa2,bf16x8 pa3){
  #pragma unroll
  for(int d0=0;d0<2;++d0){s16x4 lo[4],hi[4];
    #pragma unroll
    for(int ks=0;ks<4;++ks){
      asm volatile("ds_read_b64_tr_b16 %0,%1 offset:%c2":"=&v"(lo[ks]):"v"(vb),"i"(d0*4096+ks*1024):"memory");
      asm volatile("ds_read_b64_tr_b16 %0,%1 offset:%c2":"=&v"(hi[ks]):"v"(vb),"i"(d0*4096+ks*1024+512):"memory");}
    asm volatile("s_waitcnt lgkmcnt(0)":::"memory");SBAR();
    #define PK(k) (bf16x8){lo[k][0],lo[k][1],lo[k][2],lo[k][3],hi[k][0],hi[k][1],hi[k][2],hi[k][3]}
    o[d0]=__builtin_amdgcn_mfma_f32_32x32x16_bf16(pa0,PK(0),o[d0],0,0,0);
    o[d0]=__builtin_amdgcn_mfma_f32_32x32x16_bf16(pa1,PK(1),o[d0],0,0,0);
    o[d0]=__builtin_amdgcn_mfma_f32_32x32x16_bf16(pa2,PK(2),o[d0],0,0,0);
    o[d0]=__builtin_amdgcn_mfma_f32_32x32x16_bf16(pa3,PK(3),o[d0],0,0,0);
    #undef PK
  }
}

#ifndef ATTN_STORE16
#define ATTN_STORE16(p,v) (*(u32x4*)(p)=(v))
#endif
template<int THRL,bool FIXMAX,bool QPREP> __device__ __forceinline__ void attn_unit(const bf16*Qh,const bf16*__restrict__ Kh,const bf16*__restrict__ Vh,bf16*Oh,const int NT,const float negB,const float*qw,const int tok0,char*shm){
  int tid_=threadIdx.x; asm volatile("":"+v"(tid_)); const int tid=tid_,lane=tid&63,r32=lane&31,hi=lane>>5; const int wid=__builtin_amdgcn_readfirstlane(tid>>6);
  const bf16*Qw=Qh+(long)(wid*QBLK)*(QPREP?QPR:QP);
  const unsigned lds0=(unsigned)(uintptr_t)shm;
  float*wsf=(float*)(shm+LDS_WS)+wid*64;
  const bf16*ksrc=Kh+(long)lane*KP+wid*8;
  const bf16*vsrc=Vh+(long)(16*(wid&3)+(lane>>2))*VP+(wid>>2)*32+(lane&3)*8;
  const unsigned kdst=lds0+LDS_K+wid*1024, vdst=lds0+LDS_V+wid*1024;
  #define DMA_K(t,slot) glds16(ksrc+(long)(t)*KVBLK*KP,(unsigned)__builtin_amdgcn_readfirstlane(kdst+(slot)))
  #define DMA_V(t,slot) glds16(vsrc+(long)(t)*KVBLK*VP,(unsigned)__builtin_amdgcn_readfirstlane(vdst+(slot)))
  const int vb0=(int)(lds0+LDS_V)+((lane>>4)&1)*32+(lane&3)*8+(4*hi+((lane&15)>>2))*64;
  const char*Kbase=shm+LDS_K; bf16x8 kf[8];
  const lds_cptr shm3=(lds_cptr)shm; const lds_cptr kp0=shm3+LDS_K+hi*1024+r32*16; const lds_cptr vp0=shm3+LDS_V+((lane>>4)&1)*32+(lane&3)*8+(4*hi+((lane&15)>>2))*64;
  DMA_K(0,0);DMA_V(0,0);DMA_K(1,SLOTB);
  bf16x8 qr[4];
  #pragma unroll
  for(int d0=0;d0<4;++d0)qr[d0]=*reinterpret_cast<const bf16x8*>(&Qw[(long)r32*(QPREP?QPR:QP)+d0*16+hi*8]);
  if constexpr(QPREP){
    float x[4][8]; float ss=0.f;
    #pragma unroll
    for(int d0=0;d0<4;++d0){ const u32x4 w=__builtin_bit_cast(u32x4,qr[d0]);
      x[d0][0]=__uint_as_float(w.x<<16);x[d0][1]=__uint_as_float(w.x&0xffff0000u);x[d0][2]=__uint_as_float(w.y<<16);x[d0][3]=__uint_as_float(w.y&0xffff0000u);
      x[d0][4]=__uint_as_float(w.z<<16);x[d0][5]=__uint_as_float(w.z&0xffff0000u);x[d0][6]=__uint_as_float(w.w<<16);x[d0][7]=__uint_as_float(w.w&0xffff0000u);
      #pragma unroll
      for(int e=0;e<8;++e)ss+=x[d0][e]*x[d0][e]; }
    { auto rr=__builtin_amdgcn_permlane32_swap(__float_as_uint(ss),__float_as_uint(ss),false,false); ss=__uint_as_float(rr[0])+__uint_as_float(rr[1]); }
    const float rinv=__builtin_amdgcn_rsqf(ss*(1.f/64.f)+1e-6f)*C2;
    const int tok=tok0+wid*QBLK+r32; const float prow=tok0<0?0.f:(float)(tok>>6), pcol=tok0<0?0.f:(float)(tok&63);
    #pragma unroll
    for(int d0=0;d0<4;++d0){
      const float pos=d0<2?prow:pcol;
      #pragma unroll
      for(int p=0;p<4;++p){ const int f=(d0&1)*8+hi*4+p; const float ang=pos*__builtin_amdgcn_exp2f(-(float)f*0.83048202372184058f);
        const float cs=__cosf(ang),sn=__sinf(ang);
        const float xe=x[d0][2*p]*rinv*qw[d0*16+hi*8+2*p],xo=x[d0][2*p+1]*rinv*qw[d0*16+hi*8+2*p+1];
        x[d0][2*p]=xe*cs-xo*sn; x[d0][2*p+1]=xe*sn+xo*cs; }
      u32x4 w; w.x=cvtpk_s(x[d0][0],x[d0][1]);w.y=cvtpk_s(x[d0][2],x[d0][3]);w.z=cvtpk_s(x[d0][4],x[d0][5]);w.w=cvtpk_s(x[d0][6],x[d0][7]);
      qr[d0]=__builtin_bit_cast(bf16x8,w); }
  }
  float mhat=0.f,l_reg=0.f;f32x16 o[2];o[0]=f32x16{};o[1]=f32x16{};f32x16 negm=f32x16{};
  if constexpr(FIXMAX){ int nb_=__builtin_amdgcn_readfirstlane(__float_as_int(negB)); asm volatile("":"+s"(nb_));
    const float nb=__int_as_float(nb_);
    #pragma unroll
    for(int r=0;r<16;++r)negm[r]=nb;}
  asm volatile("":"+v"(negm));
  #define CMASK(P0,P1,t) do{}while(0)
  bool resc=false;
  #define START(P0,P1) do{ resc=false; \
    if constexpr(!FIXMAX){ const float rm=rowmax(P0,P1); const float dl=rm; mhat=fadd_s(mhat,dl); \
      _Pragma("unroll") for(int r=0;r<16;++r){P0[r]=fsub_s(P0[r],dl);P1[r]=fsub_s(P1[r],dl);} \
      _Pragma("unroll") for(int r=0;r<16;++r)negm[r]=-mhat; asm volatile("":"+v"(negm)); } \
    _Pragma("unroll") for(int r=0;r<16;++r)P0[r]=__builtin_amdgcn_exp2f(P0[r]); }while(0)
  #define RESC() do{ if(resc){ asm volatile("s_waitcnt lgkmcnt(0)":::"memory"); \
      _Pragma("unroll") for(int d_=0;d_<2;++d_) _Pragma("unroll") for(int r=0;r<16;++r)o[d_][r]*=wsf[crow(r,hi)]; } }while(0)
  f32x16 pA0,pA1,pB0,pB1;
  int sl_prev=0,sl_cur=0,sl_next=SLOTB;
  #define ROT() do{sl_prev=sl_cur;sl_cur=sl_next;sl_next=(sl_next==(NSLOT-1)*SLOTB)?0:sl_next+SLOTB;}while(0)
  DMA_K(2,2*SLOTB);
  WAIT_BAR(3);
  qkt(pA0,pA1,Kbase,qr,negm,r32,hi);asm volatile("s_nop 15\n\ts_nop 7":"+v"(pA0),"+v"(pA1));CMASK(pA0,pA1,0);
  START(pA0,pA1);
  _Pragma("unroll") for(int r=0;r<16;++r)pA1[r]=__builtin_amdgcn_exp2f(pA1[r]);
  WAIT_BAR(0);
  DMA_K(3,0);DMA_V(1,SLOTB);
  ROT();
  kload8(kf,kp0+sl_cur);
  WAIT_BAR(2);
  s16x4 vlo[8],vhi[8]; u32x4 pw0,pw1,pw2,pw3;
  #define PKW(P,B) cvtpk_s(P[B],P[B+1])
  #define PAF(k) __builtin_bit_cast(bf16x8,pw##k)
  #define VFR(i) (bf16x8){vlo[i][0],vlo[i][1],vlo[i][2],vlo[i][3],vhi[i][0],vhi[i][1],vhi[i][2],vhi[i][3]}
  #define PIN(x) asm volatile("":"+v"(x))
  #define MX3(a,b,c) __builtin_fmaxf(__builtin_fmaxf((a),(b)),(c))
  #define GAPA(MF,A0,A1,A2,A3,W0,W1,PW) do{ MF; sacc+=A0; sacc+=A1; sacc+=A2; sacc+=A3; PIN(sacc); W0; W1; PIN(PW); SBAR(); }while(0)
  #define EX(v) __builtin_amdgcn_exp2f(v)
  #define GAPB(MF,X,B) do{ MF; X[B]=EX(X[B]); X[B+1]=EX(X[B+1]); X[B+2]=EX(X[B+2]); X[B+3]=EX(X[B+3]); PIN(X); SBAR(); }while(0)
  #define VRD(i) do{ vlo[i]=vtr(vp_+(((i)>>2)*4096+((i)&3)*1024)); vhi[i]=vtr(vp_+(((i)>>2)*4096+((i)&3)*1024+512)); }while(0)
  #define KRD(G,j) do{ if(G){ kload2(kf,kp0+sl_next,j); SBAR(); } }while(0)
  #define STEP(C0,C1,P0,P1,t,GK,GV,GL) do{ SBAR(); \
    const lds_cptr vp_=vp0+sl_prev; \
    VRD(0); SBAR(); float sacc=(P0[0]+P0[1]); \
    GAPA(C0=__builtin_amdgcn_mfma_f32_32x32x16_bf16(kf[0],qr[0],negm,0,0,0), P0[2],P0[3],P0[4],P0[5],     pw0[0]=PKW(P0,0), pw0[1]=PKW(P0,2), pw0); \
    VRD(4); SBAR(); GAPA(C1=__builtin_amdgcn_mfma_f32_32x32x16_bf16(kf[1],qr[0],negm,0,0,0), P0[6],P0[7],P0[8],P0[9],     pw0[2]=PKW(P0,4), pw0[3]=PKW(P0,6), pw0); \
    VRD(1); SBAR(); GAPA(C0=__builtin_amdgcn_mfma_f32_32x32x16_bf16(kf[2],qr[1],C0,0,0,0),   P0[10],P0[11],P0[12],P0[13], pw1[0]=PKW(P0,8), pw1[1]=PKW(P0,10), pw1); \
    VRD(5); SBAR(); GAPA(C1=__builtin_amdgcn_mfma_f32_32x32x16_bf16(kf[3],qr[1],C1,0,0,0),   P0[14],P0[15],P1[0],P1[1],   pw1[2]=PKW(P0,12),pw1[3]=PKW(P0,14), pw1); \
    VRD(2); SBAR(); GAPA(C0=__builtin_amdgcn_mfma_f32_32x32x16_bf16(kf[4],qr[2],C0,0,0,0),   P1[2],P1[3],P1[4],P1[5],     pw2[0]=PKW(P1,0), pw2[1]=PKW(P1,2), pw2); \
    VRD(6); SBAR(); GAPA(C1=__builtin_amdgcn_mfma_f32_32x32x16_bf16(kf[5],qr[2],C1,0,0,0),   P1[6],P1[7],P1[8],P1[9],     pw2[2]=PKW(P1,4), pw2[3]=PKW(P1,6), pw2); \
    VRD(3); SBAR(); GAPA(C0=__builtin_amdgcn_mfma_f32_32x32x16_bf16(kf[6],qr[3],C0,0,0,0),   P1[10],P1[11],P1[12],P1[13], pw3[0]=PKW(P1,8), pw3[1]=PKW(P1,10), pw3); \
    VRD(7); SBAR(); GAPA(C1=__builtin_amdgcn_mfma_f32_32x32x16_bf16(kf[7],qr[3],C1,0,0,0),   P1[14],P1[15],0.f,0.f,       pw3[2]=PKW(P1,12),pw3[3]=PKW(P1,14), pw3); \
    l_reg+=sacc; \
    if(GK){DMA_K((t)+3,sl_cur);} if(GV){DMA_V((t)+1,sl_next);} \
    CMASK(C0,C1,t); \
    if constexpr(!FIXMAX){ float a=MX3(C0[0],C0[1],C1[0]),b=MX3(C0[2],C0[3],C1[1]); a=MX3(a,C1[2],C1[3]); \
      _Pragma("unroll") for(int r=4;r<16;r+=4){a=MX3(a,C0[r],C0[r+1]);b=MX3(b,C0[r+2],C0[r+3]);a=MX3(a,C1[r],C1[r+1]);b=MX3(b,C1[r+2],C1[r+3]);} \
      float rm=__builtin_fmaxf(a,b); { auto rr=__builtin_amdgcn_permlane32_swap(__float_as_uint(rm),__float_as_uint(rm),false,false); rm=__builtin_fmaxf(__uint_as_float(rr[0]),__uint_as_float(rr[1])); } \
      resc=false; \
      if(__builtin_expect(__any(rm>(float)THRL),0)){ const float dl=__builtin_fmaxf(rm,0.f); mhat+=dl; \
        _Pragma("unroll") for(int r=0;r<16;++r){C0[r]-=dl;C1[r]-=dl;} \
        _Pragma("unroll") for(int r=0;r<16;++r)negm[r]=-mhat; asm volatile("":"+v"(negm)); \
        const float f=__builtin_amdgcn_exp2f(-dl); l_reg*=f; if(hi==0)wsf[r32]=f; resc=true; } } \
    SBAR(); \
    GAPB(o[0]=__builtin_amdgcn_mfma_f32_32x32x16_bf16(PAF(0),VFR(0),o[0],0,0,0), C0,0); \
    GAPB(o[1]=__builtin_amdgcn_mfma_f32_32x32x16_bf16(PAF(0),VFR(4),o[1],0,0,0), C0,4); \
    KRD(GL,0); GAPB(o[0]=__builtin_amdgcn_mfma_f32_32x32x16_bf16(PAF(1),VFR(1),o[0],0,0,0), C0,8); \
    KRD(GL,1); GAPB(o[1]=__builtin_amdgcn_mfma_f32_32x32x16_bf16(PAF(1),VFR(5),o[1],0,0,0), C0,12); \
    KRD(GL,2); GAPB(o[0]=__builtin_amdgcn_mfma_f32_32x32x16_bf16(PAF(2),VFR(2),o[0],0,0,0), C1,0); \
    KRD(GL,3); GAPB(o[1]=__builtin_amdgcn_mfma_f32_32x32x16_bf16(PAF(2),VFR(6),o[1],0,0,0), C1,4); \
    GAPB(o[0]=__builtin_amdgcn_mfma_f32_32x32x16_bf16(PAF(3),VFR(3),o[0],0,0,0), C1,8); \
    GAPB(o[1]=__builtin_amdgcn_mfma_f32_32x32x16_bf16(PAF(3),VFR(7),o[1],0,0,0), C1,12); \
    }while(0)
  int t=1;
  #undef CMASK
  #define CMASK(P0,P1,t) do{}while(0)
  for(;t+5<NT;t+=2){
    STEP(pB0,pB1,pA0,pA1,t,true,true,true);     WAIT_BAR(2); RESC(); ROT();
    STEP(pA0,pA1,pB0,pB1,t+1,true,true,true);   WAIT_BAR(2); RESC(); ROT();
  }
  #undef CMASK
  #define CMASK(P0,P1,t) do{}while(0)
  #define ENDW(tt) do{ if((tt)+3<NT){WAIT_BAR(2);} else if((tt)+2<NT){WAIT_BAR(1);} else {WAIT_BAR(0);} }while(0)
  for(;t+1<NT;t+=2){
    STEP(pB0,pB1,pA0,pA1,t,(t+3<NT),(t+1<NT),(t+1<NT));       ENDW(t);   RESC(); ROT();
    STEP(pA0,pA1,pB0,pB1,t+1,(t+4<NT),(t+2<NT),(t+2<NT));     ENDW(t+1); RESC(); ROT();
  }
  STEP(pB0,pB1,pA0,pA1,NT-1,false,false,false); RESC();
  { float sacc=pB0[0]+pB0[1]; _Pragma("unroll") for(int r=2;r<16;++r)sacc+=pB0[r]; _Pragma("unroll") for(int r=0;r<16;++r)sacc+=pB1[r]; l_reg+=sacc;
    pw0=(u32x4){PKW(pB0,0),PKW(pB0,2),PKW(pB0,4),PKW(pB0,6)};pw1=(u32x4){PKW(pB0,8),PKW(pB0,10),PKW(pB0,12),PKW(pB0,14)};pw2=(u32x4){PKW(pB1,0),PKW(pB1,2),PKW(pB1,4),PKW(pB1,6)};pw3=(u32x4){PKW(pB1,8),PKW(pB1,10),PKW(pB1,12),PKW(pB1,14)};
    SBAR(); pv(o,vb0+sl_cur,PAF(0),PAF(1),PAF(2),PAF(3)); }
  #undef PKW
  #undef PAF
  #undef VFR
  #undef PIN
  #undef MX3
  #undef GAPA
  #undef GAPB
  #undef EX
  #undef VRD
  #undef KRD
  #undef STEP
  #undef ENDW
  {auto rr=__builtin_amdgcn_permlane32_swap(__float_as_uint(l_reg),__float_as_uint(l_reg),false,false);l_reg=__uint_as_float(rr[0])+__uint_as_float(rr[1]);}
  if(hi==0)wsf[32+r32]=l_reg;asm volatile("s_waitcnt lgkmcnt(0)":::"memory");
  float rli[16];
  #pragma unroll
  for(int r=0;r<16;++r)rli[r]=__builtin_amdgcn_rcpf(wsf[32+crow(r,hi)]);
  bf16*Ow=Oh+(long)(wid*QBLK)*OP;
  { bf16*stg=(bf16*)(shm+LDS_OST)+wid*2048;
    #pragma unroll
    for(int r=0;r<16;++r){const int orow=crow(r,hi);
      #pragma unroll
      for(int d0=0;d0<2;++d0)stg[orow*64+d0*32+r32]=__float2bfloat16(o[d0][r]*rli[r]);}
    asm volatile("s_waitcnt lgkmcnt(0)":::"memory");
    #pragma unroll
    for(int i=0;i<4;++i){const int row=i*8+(lane>>3),ch=lane&7; const u32x4 v=*(const u32x4*)(stg+row*64+ch*8); ATTN_STORE16(Ow+(long)row*OP+ch*8,v);} }
  asm volatile("s_waitcnt lgkmcnt(0)\n\ts_barrier":::"memory");
  #undef DMA_K
  #undef DMA_V
  #undef CMASK
  #undef START
  #undef RESC
  #undef ROT
}
constexpr int ATTN_LDS_BYTES=LDS_BYTES;
#undef SBAR
#undef WAIT_BAR
}
#define GAS __attribute__((address_space(1)))
#define LAS __attribute__((address_space(3)))
typedef unsigned short bf16;
typedef unsigned v4u __attribute__((ext_vector_type(4)));
typedef float f32x4 __attribute__((ext_vector_type(4)));
typedef short bf16x8 __attribute__((ext_vector_type(8)));
typedef GAS unsigned gu32;
typedef GAS unsigned long long gu64;
#define RLX_AGENT __ATOMIC_RELAXED, __HIP_MEMORY_SCOPE_AGENT
#define LDS_WAIT() asm volatile("s_waitcnt lgkmcnt(0)" ::: "memory")
#define VM_WAIT() asm volatile("s_waitcnt vmcnt(0)" ::: "memory")
__device__ __forceinline__ unsigned long long rt() { return __builtin_amdgcn_s_memrealtime(); }
__device__ __forceinline__ unsigned f2bf(float f) { unsigned u = __builtin_bit_cast(unsigned, f); return (u + 0x7fffu + ((u >> 16) & 1u)) >> 16; }
__device__ __forceinline__ unsigned pk2(float lo, float hi) { return f2bf(lo) | (f2bf(hi) << 16); }

#define XB_TMO      128
#define XB_XCNT(j)  (256  + 64 * (j))
#define XB_XSUB(j)  (1280 + 64 * (j))
#define XB_XGEN(j)  (2304 + 64 * (j))
#define XB_TOP      3328
#define XB_TOPGEN   3392
#define XCD_BAR_WORDS 3456
#define XB_SPIN_CAP (1u << 18)

__device__ __forceinline__ unsigned xb_ld(unsigned* p)              { return __hip_atomic_load(p, __ATOMIC_RELAXED, __HIP_MEMORY_SCOPE_AGENT); }
__device__ __forceinline__ unsigned xb_add(unsigned* p, unsigned v) { return __hip_atomic_fetch_add(p, v, __ATOMIC_RELAXED, __HIP_MEMORY_SCOPE_AGENT); }
__device__ __forceinline__ unsigned xb_xcc_id() { return (unsigned)__builtin_amdgcn_s_getreg((3 << 11) | 20) & 0xFu; }
#define XB_SPIN(cond, bar) do { unsigned _sp = 0; while (cond) { __builtin_amdgcn_s_sleep(1); \
    if ((++_sp & 255u) == 0u) { if (xb_ld(&(bar)[XB_TMO])) break; if (_sp > XB_SPIN_CAP) { atomicAdd(&(bar)[XB_TMO], 1u); break; } } } } while (0)

struct XcdBarrier {
    unsigned* bar; unsigned x;
    volatile LAS unsigned* st;
};

__device__ __forceinline__ XcdBarrier xcd_barrier_post(unsigned* bar, volatile LAS unsigned* st) {
    XcdBarrier b; b.bar = bar; b.x = xb_xcc_id(); b.st = st;
    if (threadIdx.x == 0) (void)xb_add(&bar[XB_XCNT(b.x)], 1u);
    return b;
}
__device__ __forceinline__ void xcd_barrier_complete(unsigned* bar, unsigned x, unsigned& nloc, unsigned& nx) {
    const unsigned G = gridDim.x * gridDim.y * gridDim.z;
    unsigned sum, cnt, mine, sp = 0u;
    for (;;) {
        sum = 0u; cnt = 0u; mine = 0u;
#pragma unroll
        for (unsigned j = 0; j < 16; ++j) { const unsigned c = xb_ld(&bar[XB_XCNT(j)]); sum += c; cnt += (c > 0u) ? 1u : 0u; mine = (j == x) ? c : mine; }
        if (sum == G) break;
        __builtin_amdgcn_s_sleep(1);
        if ((++sp & 255u) == 0u) { if (xb_ld(&bar[XB_TMO])) break; if (sp > XB_SPIN_CAP) { atomicAdd(&bar[XB_TMO], 1u); break; } }
    }
    nloc = mine > 0u ? mine : 1u; nx = cnt > 0u ? cnt : 1u;
}

__device__ __forceinline__ void xcd_barrier(const XcdBarrier& b) {
    asm volatile("s_waitcnt vmcnt(0)" ::: "memory");
    __syncthreads();
    if (threadIdx.x == 0) {
        unsigned* bar = b.bar;
        __builtin_amdgcn_s_waitcnt(0);
        unsigned nloc = b.st[0], nx = b.st[1];
        if (nloc == 0u) { xcd_barrier_complete(bar, b.x, nloc, nx); b.st[0] = nloc; b.st[1] = nx; }
        const unsigned old = xb_add(&bar[XB_XSUB(b.x)], 1u);
        const unsigned gen = old / nloc;
        if (old + 1u == (gen + 1u) * nloc) {
            __builtin_amdgcn_fence(__ATOMIC_RELEASE, "agent");
            asm volatile("s_waitcnt vmcnt(0)" ::: "memory");
            const unsigned og = xb_add(&bar[XB_TOP], 1u);
            const unsigned tg = og / nx;
            if (og + 1u == (tg + 1u) * nx) xb_add(&bar[XB_TOPGEN], 1u);
            else XB_SPIN(xb_ld(&bar[XB_TOPGEN]) == tg, bar);
            __builtin_amdgcn_fence(__ATOMIC_ACQUIRE, "agent");
            xb_add(&bar[XB_XGEN(b.x)], 1u);
            asm volatile("s_waitcnt vmcnt(0)" ::: "memory");
        } else {
            XB_SPIN(xb_ld(&bar[XB_XGEN(b.x)]) == gen, bar);
            __builtin_amdgcn_fence(__ATOMIC_ACQUIRE, "agent");
            asm volatile("s_waitcnt vmcnt(0)" ::: "memory");
        }
    }
    __syncthreads();
}

constexpr int NWAVES = 8, NTHR = 512;
constexpr int DM = 1024, NB = 4, TL = 8192, TC = 256, TT = TL + TC, MROWS = NB * TT  , MLAT = NB * TL  ;
constexpr int NP = 2304, DIN = 2320;
constexpr int CQ = 0, CK = 256, CV = 512, CO = 1024, CAQ = 1536, CAK = 2048, CAV = 2176;
constexpr int DFF = 2816, DFE = 3584, NEXP = 8;
constexpr int NBLK = TT / 128;
constexpr int NSEQ = NB * 4 * 2;
constexpr float EPS = 1e-6f;
constexpr int N_PHASES = 23;
constexpr int PASS_TILES = 128, ACT1_TILES = 136;

constexpr size_t MiB = 1u << 20;
constexpr size_t WS_CTL = 0, CTL_ZERO_BYTES = 1 * MiB;
constexpr size_t WS_MODS = 1 * MiB;
constexpr size_t WS_ROUTE = 2 * MiB;
constexpr size_t RT_TOKE = 0, RT_TOKG = 128 * 1024, RT_CNT = 384 * 1024, RT_INFO = 400 * 1024, RT_TILEE = 404 * 1024, RT_ROWTOK = 512 * 1024, RT_ROWG = 800 * 1024;
constexpr size_t WS_CTXRES = 4 * MiB;
constexpr size_t WS_GATES = 8 * MiB;
constexpr size_t WS_CSTN = 11 * MiB, WS_CSTM = 11 * MiB + 768 * 1024, WS_CSTE = 11 * MiB + 896 * 1024;
constexpr float W_UP_SCALE = 32.f, W_DN_SCALE = 64.f, ACT_SCALE = 4.f;
#ifndef P_I8
#define P_I8 1
#endif
#ifndef DENSE_I8
#define DENSE_I8 1
#endif
#ifndef DENSE_FP8
#define DENSE_FP8 0
#endif
constexpr int DB = DENSE_FP8 ? 1 : 2;
constexpr int UB = (DENSE_FP8 || DENSE_I8) ? 1 : 2;
constexpr int UMODE = DENSE_I8 ? 2 : (DENSE_FP8 ? 1 : 0);
constexpr int PB_ = P_I8 ? 1 : 2;
constexpr int CW_CMAX_IN = 8192, CW_CMAX_UP = 8192 + 2 * NP;
constexpr size_t RT_ROWSC_H = 1400 * 1024;
constexpr int CW_WMAX = 64;
constexpr size_t RT_ROWSC = 1200 * 1024;
constexpr size_t WS_MGU = 12 * MiB, WS_MD = 68 * MiB;
constexpr size_t WS_WIN = 96 * MiB, WS_WOUT = 105 * MiB, WS_WGU = 109 * MiB, WS_WD = 120 * MiB;
constexpr size_t WS_HY = 126 * MiB;
constexpr size_t WS_P = 192 * MiB;
constexpr size_t WS_QN = WS_P + (size_t)MROWS * NP * 2;
constexpr size_t WS_KN = WS_QN + (size_t)MROWS * 512 * 2;
constexpr size_t WS_GPRE = WS_QN;
constexpr size_t WS_CSTC = 382 * MiB;
constexpr size_t WS_ACT0 = 192 * MiB;
constexpr size_t WS_H2B = 382 * MiB;
constexpr size_t WS_ASORT = 126 * MiB;
constexpr size_t WS_EOUT = 192 * MiB;
constexpr size_t WS_ACT1 = 324 * MiB;
constexpr size_t WS_RESID = 508 * MiB;
constexpr size_t WS_END = 572 * MiB;
constexpr size_t RP = 2048;
constexpr size_t WS_SLAB_CW = WS_QN, WS_SLAB_CD = WS_CSTC;
constexpr int NS_CW = 4, NS_CD = DENSE_FP8 ? 0 : 11;
constexpr size_t WS_SLAB_MT = WS_MGU;
constexpr int NS_MT = 7, MT_TILES = 8;
static_assert(WS_KN + (size_t)MROWS * 128 * 2 <= WS_CSTC && WS_CSTC + (size_t)NSEQ * NBLK * 8192 * 4 <= WS_RESID, "ws map");
static_assert(WS_ACT0 + (size_t)MROWS * DFF * DB <= WS_CSTC && WS_ASORT + (size_t)264 * 256 * DM <= WS_EOUT && WS_EOUT + (size_t)264 * 256 * DM * 2 <= WS_ACT1 && WS_ACT1 + (size_t)ACT1_TILES * 256 * DFE <= WS_RESID && WS_H2B + (size_t)MLAT * DM <= WS_RESID, "ws map 2");
static_assert(WS_MGU + (size_t)NEXP * 2 * DFE * DM <= WS_MD && WS_MD + (size_t)NEXP * DM * DFE <= WS_WIN && WS_WIN + (size_t)2 * NP * DM * 2 <= WS_WOUT && WS_WOUT + (size_t)2 * DM * DM * 2 <= WS_WGU && WS_WGU + (size_t)2 * DFF * DM * UB <= WS_WD && WS_WD + (size_t)DM * DFF * DB <= WS_HY && (size_t)NS_MT * MT_TILES * 256 * 1024 * 4 <= WS_MD - WS_MGU, "ws map 3");
constexpr int CW_BAR = 4096;

constexpr int LDS_BYTES = 155648;
constexpr int MISC_OFF = 154624;

struct Args { const float* in[22]; float* out; unsigned char* ws; int ph_lo, ph_hi, li, pad; };
typedef const __attribute__((address_space(4))) Args* CAP;
__device__ __forceinline__ const float* ain(CAP a, int k) { return (const float*)(const GAS float*)(unsigned long long)a->in[k]; }
__device__ __forceinline__ float* aout(CAP a) { return (float*)(GAS float*)(unsigned long long)a->out; }
__device__ __forceinline__ CAP args_ptr() { unsigned long long p = (unsigned long long)__builtin_amdgcn_kernarg_segment_ptr(); asm volatile("" : "+s"(p)); return (CAP)p; }

struct Frame {
    LAS unsigned char* lds; volatile LAS unsigned* MISC; gu32* ctl; unsigned char* ws;
    int tid, lane, wave, vcu, G, gw, NGW;
};

__device__ __forceinline__ float shx(float v, int o, int lane) { return __int_as_float(__builtin_amdgcn_ds_bpermute((lane ^ o) << 2, __float_as_int(v))); }
__device__ __forceinline__ float shu(float v, int o, int lane) { return __int_as_float(__builtin_amdgcn_ds_bpermute(((lane - o) & 63) << 2, __float_as_int(v))); }
__device__ __forceinline__ float shi(float v, int src) { return __int_as_float(__builtin_amdgcn_ds_bpermute(src << 2, __float_as_int(v))); }
#define WAVE_DPP(v, ctrl) __int_as_float(__builtin_amdgcn_update_dpp(0, __float_as_int(v), ctrl, 0xf, 0xf, true))
__device__ __forceinline__ float wave_sum(float v, int lane) {
    (void)lane;
    v += WAVE_DPP(v, 0xB1); v += WAVE_DPP(v, 0x4E); v += WAVE_DPP(v, 0x141); v += WAVE_DPP(v, 0x140);
    { auto rr = __builtin_amdgcn_permlane16_swap(__float_as_uint(v), __float_as_uint(v), false, false); v = __uint_as_float(rr[0]) + __uint_as_float(rr[1]); }
    { auto rr = __builtin_amdgcn_permlane32_swap(__float_as_uint(v), __float_as_uint(v), false, false); v = __uint_as_float(rr[0]) + __uint_as_float(rr[1]); }
    return v;
}
__device__ __forceinline__ float wave_max(float v, int lane) {
    (void)lane;
    v = fmaxf(v, WAVE_DPP(v, 0xB1)); v = fmaxf(v, WAVE_DPP(v, 0x4E)); v = fmaxf(v, WAVE_DPP(v, 0x141)); v = fmaxf(v, WAVE_DPP(v, 0x140));
    { auto rr = __builtin_amdgcn_permlane16_swap(__float_as_uint(v), __float_as_uint(v), false, false); v = fmaxf(__uint_as_float(rr[0]), __uint_as_float(rr[1])); }
    { auto rr = __builtin_amdgcn_permlane32_swap(__float_as_uint(v), __float_as_uint(v), false, false); v = fmaxf(__uint_as_float(rr[0]), __uint_as_float(rr[1])); }
    return v;
}
#define SCAN_DPP(idv, v, ctrl, rmask) __int_as_float(__builtin_amdgcn_update_dpp(__float_as_int(idv), __float_as_int(v), ctrl, rmask, 0xf, false))
__device__ __forceinline__ float wave_incl_scan_add(float v, int lane) {
    (void)lane;
    v += SCAN_DPP(0.f, v, 0x111, 0xf); v += SCAN_DPP(0.f, v, 0x112, 0xf); v += SCAN_DPP(0.f, v, 0x114, 0xf); v += SCAN_DPP(0.f, v, 0x118, 0xf);
    v += SCAN_DPP(0.f, v, 0x142, 0xa); v += SCAN_DPP(0.f, v, 0x143, 0xc);
    return v;
}
__device__ __forceinline__ float wave_incl_scan_max(float v, int lane) {
    (void)lane; const float ninf = -INFINITY;
    v = fmaxf(v, SCAN_DPP(ninf, v, 0x111, 0xf)); v = fmaxf(v, SCAN_DPP(ninf, v, 0x112, 0xf)); v = fmaxf(v, SCAN_DPP(ninf, v, 0x114, 0xf)); v = fmaxf(v, SCAN_DPP(ninf, v, 0x118, 0xf));
    v = fmaxf(v, SCAN_DPP(ninf, v, 0x142, 0xa)); v = fmaxf(v, SCAN_DPP(ninf, v, 0x143, 0xc));
    return v;
}
__device__ __forceinline__ float bf2f(unsigned short b) { return __uint_as_float((unsigned)b << 16); }
__device__ __forceinline__ float bflo(unsigned w) { return __uint_as_float(w << 16); }
__device__ __forceinline__ float bfhi(unsigned w) { return __uint_as_float(w & 0xffff0000u); }
__device__ __forceinline__ float logsig(float x) { return fminf(x, 0.f) - __logf(1.f + __expf(-fabsf(x))); }
__device__ __forceinline__ float siluf(float x) { return x / (1.f + __expf(-x)); }
__device__ __forceinline__ float dot4(f32x4 a, f32x4 b) { return (a.x * b.x + a.y * b.y) + (a.z * b.z + a.w * b.w); }
#define MFMA16(a, b, c) __builtin_amdgcn_mfma_f32_16x16x32_bf16((a), (b), (c), 0, 0, 0)
__device__ __forceinline__ unsigned pk4_i8(float a, float b, float c, float d) {
    const int qa = (int)__builtin_amdgcn_fmed3f(__builtin_rintf(a), -127.f, 127.f), qb = (int)__builtin_amdgcn_fmed3f(__builtin_rintf(b), -127.f, 127.f), qc = (int)__builtin_amdgcn_fmed3f(__builtin_rintf(c), -127.f, 127.f), qd = (int)__builtin_amdgcn_fmed3f(__builtin_rintf(d), -127.f, 127.f);
    return (unsigned)(qa & 255) | ((unsigned)(qb & 255) << 8) | ((unsigned)(qc & 255) << 16) | ((unsigned)(qd & 255) << 24); }
__device__ __forceinline__ float c448(float x) { return __builtin_amdgcn_fmed3f(x, -448.f, 448.f); }
__device__ __forceinline__ unsigned pk4_fp8(float a, float b, float c, float d) {
    int p = 0; p = __builtin_amdgcn_cvt_pk_fp8_f32(c448(a), c448(b), p, false); p = __builtin_amdgcn_cvt_pk_fp8_f32(c448(c), c448(d), p, true); return (unsigned)p; }

struct TrDesc { const float* src; unsigned char* dst; int ldw, ldt; float sc8; int mode; const gu32* cmax; };
constexpr int I0 = 2 * 16 * 72, I1 = 2 * 16 * 32, I2 = 16 * 176, I3 = 44 * 32, I4 = 8 * 16 * 224, I5 = 8 * 56 * 32;
constexpr int I_SMALL = I0 + I1 + I2 + I3, I_MOE = I4 + I5;
__device__ __forceinline__ TrDesc tr_desc(Frame& F, CAP a, int it) {
    TrDesc d; int r = it;
    if (r < I0) { const int L = r / 1152, rem = r % 1152, kb = rem / 72, nb = rem % 72, c0 = 32 * nb;
        d.ldw = DIN; d.src = ain(a, 8) + (size_t)L * DM * DIN + (size_t)(64 * kb) * DIN + (c0 < 1536 ? c0 : c0 + 16); d.ldt = DM * PB_; d.dst = F.ws + WS_WIN + ((size_t)L * NP * DM + (size_t)c0 * DM + 64 * kb) * PB_; d.mode = P_I8 ? 2 : 0; d.sc8 = 0.f; d.cmax = F.ctl + CW_CMAX_IN + L * NP + c0; return d; }
    r -= I0;
    if (r < I1) { const int L = r / 512, rem = r % 512, kb = rem / 32, nb = rem % 32;
        d.ldw = DM; d.src = ain(a, 13) + (size_t)L * DM * DM + (size_t)(64 * kb) * DM + 32 * nb; d.ldt = DM * 2; d.dst = F.ws + WS_WOUT + ((size_t)L * DM * DM + (size_t)(32 * nb) * DM + 64 * kb) * 2; d.sc8 = 0.f; d.mode = 0; return d; }
    r -= I1;
    if (r < I2) { const int kb = r / 176, nb = r % 176, r0 = 32 * nb, pn = r0 >> 8, wi = r0 & 255;
        d.ldw = DFF; d.src = (wi < 128 ? ain(a, 14) : ain(a, 15)) + (size_t)(64 * kb) * DFF + 128 * pn + (wi & 127); d.ldt = DM * UB; d.dst = F.ws + WS_WGU + ((size_t)r0 * DM + 64 * kb) * UB; d.mode = UMODE; d.sc8 = DENSE_FP8 ? W_UP_SCALE : 0.f; d.cmax = F.ctl + CW_CMAX_UP + r0; return d; }
    r -= I2;
    if (r < I3) { const int kb = r / 32, nb = r % 32;
        d.ldw = DM; d.src = ain(a, 16) + (size_t)(64 * kb) * DM + 32 * nb; d.ldt = DFF * DB; d.dst = F.ws + WS_WD + ((size_t)(32 * nb) * DFF + 64 * kb) * DB; d.sc8 = DENSE_FP8 ? W_DN_SCALE : 0.f; d.mode = DENSE_FP8 ? 1 : 0; return d; }
    r -= I3;
    if (r < I4) { const int e = r / 3584, rem = r % 3584, kb = rem / 224, nb = rem % 224, r0 = 32 * nb, pn = r0 >> 8, wi = r0 & 255;
        d.ldw = DFE; d.src = (wi < 128 ? ain(a, 18) : ain(a, 19)) + (size_t)e * DM * DFE + (size_t)(64 * kb) * DFE + 128 * pn + (wi & 127); d.ldt = DM; d.dst = F.ws + WS_MGU + (size_t)e * 2 * DFE * DM + (size_t)r0 * DM + 64 * kb; d.sc8 = W_UP_SCALE; d.mode = 1; return d; }
    r -= I4;
    { const int e = r / 1792, rem = r % 1792, kb = rem / 32, nb = rem % 32;
        d.ldw = DM; d.src = ain(a, 20) + (size_t)e * DFE * DM + (size_t)(64 * kb) * DM + 32 * nb; d.ldt = DFE; d.dst = F.ws + WS_MD + (size_t)e * DM * DFE + (size_t)(32 * nb) * DFE + 64 * kb; d.sc8 = W_DN_SCALE; d.mode = 1; return d; }
}
struct TrRegs { f32x4 v[8]; unsigned cm[4]; };
__device__ __forceinline__ TrRegs tr_load(const TrDesc& d, int lane) {
    TrRegs R;
#pragma unroll
    for (int i = 0; i < 8; ++i) R.v[i] = __builtin_nontemporal_load((const GAS f32x4*)(d.src + (size_t)(8 * i + (lane >> 3)) * d.ldw + 4 * (lane & 7)));
#pragma unroll
    for (int j = 0; j < 4; ++j) R.cm[j] = d.mode == 2 ? d.cmax[(lane >> 3) + 8 * j] : 0u;
    return R;
}
__device__ __forceinline__ void tr_finish(const TrDesc& d, const TrRegs& R, LAS float* scr, int lane) {
#pragma unroll
    for (int i = 0; i < 8; ++i) { LAS float* p = scr + (8 * i + (lane >> 3)) * 33 + 4 * (lane & 7); p[0] = R.v[i].x; p[1] = R.v[i].y; p[2] = R.v[i].z; p[3] = R.v[i].w; }
    LDS_WAIT(); asm volatile("" ::: "memory");
    const int c = lane & 7;
#pragma unroll
    for (int j = 0; j < 4; ++j) { const int n = (lane >> 3) + 8 * j; const LAS float* s = scr + (8 * c) * 33 + n;
        if (d.mode == 0) { v4u o; o.x = pk2(s[0 * 33], s[1 * 33]); o.y = pk2(s[2 * 33], s[3 * 33]); o.z = pk2(s[4 * 33], s[5 * 33]); o.w = pk2(s[6 * 33], s[7 * 33]);
            *(GAS v4u*)(d.dst + (size_t)n * d.ldt + 16 * c) = o; }
        else if (d.mode == 2) { const float sc8 = 127.f / fmaxf(__uint_as_float(R.cm[j]), 1e-30f); const unsigned lo = pk4_i8(s[0 * 33] * sc8, s[1 * 33] * sc8, s[2 * 33] * sc8, s[3 * 33] * sc8), hi = pk4_i8(s[4 * 33] * sc8, s[5 * 33] * sc8, s[6 * 33] * sc8, s[7 * 33] * sc8);
            *(GAS unsigned long long*)(d.dst + (size_t)n * d.ldt + 8 * c) = (unsigned long long)lo | ((unsigned long long)hi << 32); }
        else { const float sc8 = d.sc8; const unsigned lo = pk4_fp8(s[0 * 33] * sc8, s[1 * 33] * sc8, s[2 * 33] * sc8, s[3 * 33] * sc8), hi = pk4_fp8(s[4 * 33] * sc8, s[5 * 33] * sc8, s[6 * 33] * sc8, s[7 * 33] * sc8);
            *(GAS unsigned long long*)(d.dst + (size_t)n * d.ldt + 8 * c) = (unsigned long long)lo | ((unsigned long long)hi << 32); } }
    LDS_WAIT(); asm volatile("" ::: "memory");
}
__device__ __forceinline__ void convert_weights(Frame& F, CAP a, int first, int count, LAS float* scr) {
    int it = first + F.gw; const int end = first + count;
    if (it >= end) return;
    TrDesc d = tr_desc(F, a, it); TrRegs R = tr_load(d, F.lane);
    for (;;) {
        const int nx = it + F.NGW; const bool more = nx < end;
        TrDesc dn = d; TrRegs Rn = R;
        if (more) { dn = tr_desc(F, a, nx); Rn = tr_load(dn, F.lane); }
        tr_finish(d, R, scr, F.lane);
        if (!more) break;
        d = dn; R = Rn; it = nx;
    }
}
__device__ __forceinline__ void phase_prologue(Frame& F, CAP a) {
    {
        LAS float* sc = (LAS float*)F.lds;
        LAS float* red = (LAS float*)(F.lds + 20480);
        float* mods = (float*)(F.ws + WS_MODS);
        for (int u = blockIdx.x; u < 192; u += F.G) {
            const int L = u / 96, cb = u % 96;
            { float xv[10];
#pragma unroll
              for (int i = 0; i < 10; ++i) { const int idx = F.tid + NTHR * i, v = idx >> 10, k = idx & 1023; xv[i] = v < 4 ? ain(a, 1)[v * 1024 + k] : ain(a, 3)[k]; }
#pragma unroll
              for (int i = 0; i < 10; ++i) sc[F.tid + NTHR * i] = siluf(xv[i]); }
            __syncthreads();
            float acc[5] = {0.f, 0.f, 0.f, 0.f, 0.f};
            const float* wp = ain(a, 4) + ((size_t)L * 1024 + 128 * F.wave) * 6144 + cb * 64 + F.lane;
#pragma unroll 1
            for (int k0 = 0; k0 < 128; k0 += 64) { float wv[64];
#pragma unroll
                for (int q = 0; q < 64; ++q) wv[q] = *(const GAS float*)(wp + (size_t)(k0 + q) * 6144);
#pragma unroll
                for (int q = 0; q < 64; ++q) {
#pragma unroll
                    for (int v = 0; v < 5; ++v) acc[v] += wv[q] * sc[v * 1024 + 128 * F.wave + k0 + q]; } }
#pragma unroll
            for (int v = 0; v < 5; ++v) red[(F.wave * 5 + v) * 64 + F.lane] = acc[v];
            __syncthreads();
            if (F.tid < 320) { const int v = F.tid >> 6, cc = F.tid & 63; float sum = ain(a, 5)[L * 6144 + cb * 64 + cc];
#pragma unroll
                for (int w = 0; w < 8; ++w) sum += red[(w * 5 + v) * 64 + cc];
                mods[(size_t)(L * 5 + v) * 6144 + cb * 64 + cc] = sum; }
            __syncthreads();
        }
    }
    {
        constexpr int NB_IN = P_I8 ? 2 * 16 * (NP / 64) : 0, NB_UP = DENSE_I8 ? 16 * (2 * DFF / 64) : 0;
        for (int blk = F.gw; blk < NB_IN + NB_UP; blk += F.NGW) {
            const float* src; int ldw; gu32* cm;
            if (blk < NB_IN) { const int L = blk / (16 * (NP / 64)), rem = blk % (16 * (NP / 64)), kb = rem / (NP / 64), c0 = 64 * (rem % (NP / 64));
                ldw = DIN; src = ain(a, 8) + (size_t)L * DM * DIN + (size_t)(64 * kb) * DIN + (c0 < 1536 ? c0 : c0 + 16); cm = F.ctl + CW_CMAX_IN + L * NP + c0; }
            else { const int r = blk - NB_IN, kb = r / (2 * DFF / 64), r0 = 64 * (r % (2 * DFF / 64)), pn = r0 >> 8, wi = r0 & 255;
                ldw = DFF; src = (wi < 128 ? ain(a, 14) : ain(a, 15)) + (size_t)(64 * kb) * DFF + 128 * pn + (wi & 127); cm = F.ctl + CW_CMAX_UP + r0; }
            unsigned mx = 0u;
#pragma unroll 1
            for (int k0 = 0; k0 < 64; k0 += 32) { unsigned wv[32];
#pragma unroll
                for (int q = 0; q < 32; ++q) wv[q] = __float_as_uint(*(const GAS float*)(src + (size_t)(k0 + q) * ldw + F.lane));
#pragma unroll
                for (int q = 0; q < 32; ++q) { const unsigned av = wv[q] & 0x7fffffffu; mx = mx > av ? mx : av; } }
            __hip_atomic_fetch_max(cm + F.lane, mx, RLX_AGENT);
        }
    }
    {
        LAS float* scr = (LAS float*)(F.lds + F.wave * 16384);
        if (!P_I8) convert_weights(F, a, 0, I0, scr);
        convert_weights(F, a, I0, I1, scr);
        if (!DENSE_I8) convert_weights(F, a, I0 + I1, I2, scr);
        convert_weights(F, a, I0 + I1 + I2, I3, scr);
    }
}

struct RowVec { f32x4 h[4]; };
__device__ __forceinline__ f32x4 bf4(unsigned long long w) { return (f32x4){bflo((unsigned)w), bfhi((unsigned)w), bflo((unsigned)(w >> 32)), bfhi((unsigned)(w >> 32))}; }
struct RowIn { f32x4 x[4]; f32x4 t[4]; };
template <bool XB> __device__ __forceinline__ RowIn load_row(const void* src, const bf16* T, int lane) {
    RowIn I;
    if constexpr (XB) { const GAS unsigned long long* xr = (const GAS unsigned long long*)src + lane;
#pragma unroll
        for (int j = 0; j < 4; ++j) I.x[j] = bf4(xr[64 * j]); }
    else { const GAS f32x4* xr = (const GAS f32x4*)src + lane;
#pragma unroll
        for (int j = 0; j < 4; ++j) I.x[j] = xr[64 * j]; }
    if (T) { const GAS unsigned long long* tr = (const GAS unsigned long long*)T + lane;
#pragma unroll
        for (int j = 0; j < 4; ++j) I.t[j] = bf4(tr[64 * j]); }
    else {
#pragma unroll
        for (int j = 0; j < 4; ++j) I.t[j] = (f32x4){0.f, 0.f, 0.f, 0.f}; }
    return I;
}
template <bool XB> __device__ __forceinline__ RowIn load_row_slabs(const void* src, const float* S, int ns, size_t sstride, int lane) {
    RowIn I = load_row<XB>(src, nullptr, lane);
#pragma unroll 1
    for (int q = 0; q < ns; ++q) { const GAS f32x4* sr = (const GAS f32x4*)(S + (size_t)q * sstride) + lane;
#pragma unroll
        for (int j = 0; j < 4; ++j) I.t[j] += sr[64 * j]; }
    return I;
}
template <bool XB> struct RowRaw { f32x4 xf[XB ? 1 : 4]; unsigned long long xb[XB ? 4 : 1]; unsigned long long t[4]; };
template <bool XB> __device__ __forceinline__ RowRaw<XB> load_raw(const void* src, const bf16* T, int lane) {
    RowRaw<XB> I;
    if constexpr (XB) { const GAS unsigned long long* xr = (const GAS unsigned long long*)src + lane;
#pragma unroll
        for (int j = 0; j < 4; ++j) I.xb[j] = xr[64 * j]; }
    else { const GAS f32x4* xr = (const GAS f32x4*)src + lane;
#pragma unroll
        for (int j = 0; j < 4; ++j) I.xf[j] = xr[64 * j]; }
    if (T) { const GAS unsigned long long* tr = (const GAS unsigned long long*)T + lane;
#pragma unroll
        for (int j = 0; j < 4; ++j) I.t[j] = tr[64 * j]; }
    else {
#pragma unroll
        for (int j = 0; j < 4; ++j) I.t[j] = 0ull; }
    return I;
}
template <bool XB> __device__ __forceinline__ RowIn cook(const RowRaw<XB>& W) {
    RowIn I;
#pragma unroll
    for (int j = 0; j < 4; ++j) { if constexpr (XB) I.x[j] = bf4(W.xb[j]); else I.x[j] = W.xf[j]; I.t[j] = bf4(W.t[j]); }
    return I;
}
struct RowPar { f32x4 g[4], w[4], sh[4]; };
__device__ __forceinline__ RowPar load_par(const float* gate, const float* nw, const float* shift, const float* scale, int lane) {
    RowPar P;
#pragma unroll
    for (int j = 0; j < 4; ++j) { const int c = 256 * j + 4 * lane;
        P.g[j] = gate ? *(const f32x4*)(gate + c) : (f32x4){0.f, 0.f, 0.f, 0.f};
        const f32x4 w = *(const f32x4*)(nw + c), sc = *(const f32x4*)(scale + c); P.w[j] = w * (sc + 1.f); P.sh[j] = *(const f32x4*)(shift + c); }
    return P;
}
__device__ __forceinline__ RowVec finish_row(const RowIn& I, bool upd, const RowPar& P, void* dst, int lane) {
    f32x4 x[4]; float ss = 0.f;
    if (upd) { GAS unsigned long long* xw = (GAS unsigned long long*)dst + lane;
#pragma unroll
        for (int j = 0; j < 4; ++j) { x[j] = I.x[j] + P.g[j] * I.t[j]; xw[64 * j] = (unsigned long long)pk2(x[j].x, x[j].y) | ((unsigned long long)pk2(x[j].z, x[j].w) << 32); } }
    else {
#pragma unroll
        for (int j = 0; j < 4; ++j) x[j] = I.x[j]; }
#pragma unroll
    for (int j = 0; j < 4; ++j) ss += dot4(x[j], x[j]);
    const float rinv = rsqrtf(wave_sum(ss, lane) * (1.f / DM) + EPS);
    RowVec R;
#pragma unroll
    for (int j = 0; j < 4; ++j) R.h[j] = (x[j] * rinv) * P.w[j] + P.sh[j];
    return R;
}
__device__ __forceinline__ void store_row_bf16(bf16* dst, const RowVec& R, int lane) {
    GAS unsigned long long* o8 = (GAS unsigned long long*)dst + lane;
#pragma unroll
    for (int j = 0; j < 4; ++j) o8[64 * j] = (unsigned long long)pk2(R.h[j].x, R.h[j].y) | ((unsigned long long)pk2(R.h[j].z, R.h[j].w) << 32);
}
__device__ __forceinline__ void store_row_fp8(unsigned char* dst, const RowVec& R, int lane) {
    GAS unsigned* o4 = (GAS unsigned*)dst + lane;
#pragma unroll
    for (int j = 0; j < 4; ++j) o4[64 * j] = pk4_fp8(R.h[j].x, R.h[j].y, R.h[j].z, R.h[j].w);
}
__device__ __forceinline__ void store_row_i8(unsigned char* dst, float* rs, const RowVec& R, int lane) {
    float m = 0.f;
#pragma unroll
    for (int j = 0; j < 4; ++j) m = fmaxf(fmaxf(m, fmaxf(fabsf(R.h[j].x), fabsf(R.h[j].y))), fmaxf(fabsf(R.h[j].z), fabsf(R.h[j].w)));
    m = fmaxf(wave_max(m, lane), 1e-30f);
    const float inv = 127.f / m;
    GAS unsigned* o4 = (GAS unsigned*)dst + lane;
#pragma unroll
    for (int j = 0; j < 4; ++j) o4[64 * j] = pk4_i8(R.h[j].x * inv, R.h[j].y * inv, R.h[j].z * inv, R.h[j].w * inv);
    if (lane == 0) *rs = m * (1.f / 127.f);
}
__device__ __forceinline__ const float* input_row(CAP a, int b, int tp) {
    if (tp < TC) return ain(a, 2) + (size_t)(b * TC + tp) * DM;
    return ain(a, 0) + (size_t)(b * TL + tp - TC) * DM;
}
__device__ __forceinline__ unsigned char* resid_ptr(const Frame& F, CAP a, int b, int tp) {
    if (tp < TC) return F.ws + WS_CTXRES + (size_t)(b * TC + tp) * RP;
    return F.ws + WS_RESID + (size_t)(b * TL + tp - TC) * RP;
}
__device__ __forceinline__ void phase_norm1(Frame& F, CAP a, int L) {
    const float* nw = ain(a, 6) + L * DM;
    const float* mods = (const float*)(F.ws + WS_MODS) + (size_t)L * 5 * 6144;
    const float* gts = (const float*)(F.ws + WS_MODS) + 5 * 1024;
    bf16* H = (bf16*)(F.ws + WS_HY);
    unsigned char* H8 = F.ws + WS_QN; float* RS = (float*)(F.ws + WS_ROUTE + RT_ROWSC_H);
    static_assert(P_I8 == 1, "phase_norm1 writes int8 rows");
    if (P_I8 && L == 0) convert_weights(F, a, 0, I0, (LAS float*)(F.lds + F.wave * 16384));
    if (DENSE_I8 && L == 0) convert_weights(F, a, I0 + I1, I2, (LAS float*)(F.lds + F.wave * 16384));
    if (2 * F.gw < NB * TC) {
        const RowPar Pc = load_par(L ? gts + 4 * 6144 : nullptr, nw, mods + 4 * 6144, mods + 4 * 6144 + 1024, F.lane);
        for (int rc = 2 * F.gw; rc < NB * TC; rc += 2 * F.NGW) {
            const int b = rc / TC, tp = rc - b * TC, r = b * TT + tp;
            RowVec R0, R1;
            if (L == 0) { const float* src = ain(a, 2) + (size_t)rc * DM;
                const RowIn I0 = load_row<false>(src, nullptr, F.lane), I1 = load_row<false>(src + DM, nullptr, F.lane);
                R0 = finish_row(I0, false, Pc, nullptr, F.lane); R1 = finish_row(I1, false, Pc, nullptr, F.lane); }
            else { unsigned char* xr = F.ws + WS_CTXRES + (size_t)rc * RP; const float* S = (const float*)(F.ws + WS_SLAB_CD) + (size_t)rc * DM;
                const RowIn I0 = load_row_slabs<true>(xr, S, NS_CD, (size_t)1024 * 1024, F.lane), I1 = load_row_slabs<true>(xr + RP, S + DM, NS_CD, (size_t)1024 * 1024, F.lane);
                R0 = finish_row(I0, true, Pc, xr, F.lane); R1 = finish_row(I1, true, Pc, xr + RP, F.lane); }
            store_row_i8(H8 + (size_t)r * DM, RS + r, R0, F.lane); store_row_i8(H8 + (size_t)(r + 1) * DM, RS + r + 1, R1, F.lane);
        }
    }
    const int b = F.gw & 3, wpb = F.NGW >> 2;
    const RowPar P = load_par(L ? gts + b * 6144 : nullptr, nw, mods + b * 6144, mods + b * 6144 + 1024, F.lane);
    const float* xin = ain(a, 0) + (size_t)b * TL * DM; unsigned char* xres = F.ws + WS_RESID + (size_t)b * TL * RP;
    const bf16* T2 = H + ((size_t)b * TT + TC) * DM;
    int t = 2 * (F.gw >> 2);
    if (L == 0) {
        RowRaw<false> N0, N1;
        if (t < TL) { N0 = load_raw<false>(xin + (size_t)t * DM, nullptr, F.lane); N1 = load_raw<false>(xin + (size_t)(t + 1) * DM, nullptr, F.lane); }
#pragma unroll 1
        for (; t < TL; t += 2 * wpb) {
            const RowRaw<false> W0 = N0, W1 = N1; const int tn = t + 2 * wpb;
            if (tn < TL) { N0 = load_raw<false>(xin + (size_t)tn * DM, nullptr, F.lane); N1 = load_raw<false>(xin + (size_t)(tn + 1) * DM, nullptr, F.lane); }
            const int r = b * TT + TC + t;
            const RowVec R0 = finish_row(cook<false>(W0), false, P, nullptr, F.lane), R1 = finish_row(cook<false>(W1), false, P, nullptr, F.lane);
            store_row_i8(H8 + (size_t)r * DM, RS + r, R0, F.lane); store_row_i8(H8 + (size_t)(r + 1) * DM, RS + r + 1, R1, F.lane);
        }
    } else {
        RowRaw<true> N0, N1;
        if (t < TL) { N0 = load_raw<true>(xres + (size_t)t * RP, nullptr, F.lane); N1 = load_raw<true>(xres + (size_t)(t + 1) * RP, nullptr, F.lane); }
#pragma unroll 1
        for (; t < TL; t += 2 * wpb) {
            const RowRaw<true> W0 = N0, W1 = N1; const int tn = t + 2 * wpb;
            if (tn < TL) { N0 = load_raw<true>(xres + (size_t)tn * RP, nullptr, F.lane); N1 = load_raw<true>(xres + (size_t)(tn + 1) * RP, nullptr, F.lane); }
            const int r = b * TT + TC + t; unsigned char* xr = xres + (size_t)t * RP;
            const RowVec R0 = finish_row(cook<true>(W0), false, P, xr, F.lane), R1 = finish_row(cook<true>(W1), false, P, xr + RP, F.lane);
            store_row_i8(H8 + (size_t)r * DM, RS + r, R0, F.lane); store_row_i8(H8 + (size_t)(r + 1) * DM, RS + r + 1, R1, F.lane);
        }
    }
}
__device__ __forceinline__ void phase_gates(Frame& F, CAP a, int L) {
    LAS bf16* WgT = (LAS bf16*)F.lds;
    const float* win = ain(a, 8) + (size_t)L * DM * DIN;
    { float wv_[32];
#pragma unroll
      for (int i = 0; i < 32; ++i) { const int idx = F.tid + NTHR * i, k = idx >> 4, g = idx & 15; wv_[i] = *(const GAS float*)(win + (size_t)k * DIN + 1536 + g); }
#pragma unroll
      for (int i = 0; i < 32; ++i) { const int idx = F.tid + NTHR * i, k = idx >> 4, g = idx & 15; WgT[g * 1032 + k] = (bf16)f2bf(wv_[i]); } }
    __syncthreads();
    const bf16* H = (const bf16*)(F.ws + WS_HY); const unsigned char* H8 = F.ws + WS_QN; const float* RS = (const float*)(F.ws + WS_ROUTE + RT_ROWSC_H); float* Gt = (float*)(F.ws + WS_GATES);
    const int c16 = F.lane & 15, q4 = F.lane >> 4;
    const float gbias = ain(a, 9)[L * 16 + c16];
    for (int grp = F.gw; grp < MROWS / 16; grp += F.NGW) {
        f32x4 acc = (f32x4){0.f, 0.f, 0.f, 0.f};
        unsigned long long rawa[32];
        float rsg[4];
        if (P_I8) {
#pragma unroll
            for (int kk = 0; kk < 32; ++kk) rawa[kk] = *(const GAS unsigned long long*)(H8 + (size_t)(grp * 16 + c16) * DM + 8 * q4 + 32 * kk);
#pragma unroll
            for (int j = 0; j < 4; ++j) rsg[j] = RS[grp * 16 + 4 * q4 + j]; }
#pragma unroll
        for (int k0 = 0; k0 < 1024; k0 += 256) {
            bf16x8 av[8];
            if (P_I8) {
#pragma unroll
                for (int kk = 0; kk < 8; ++kk) { const unsigned long long rw = rawa[(k0 >> 5) + kk]; const int lo = (int)(unsigned)rw, hi = (int)(unsigned)(rw >> 32);
                    v4u w; w.x = pk2((float)(signed char)(lo), (float)(signed char)(lo >> 8)); w.y = pk2((float)(signed char)(lo >> 16), (float)(signed char)(lo >> 24));
                    w.z = pk2((float)(signed char)(hi), (float)(signed char)(hi >> 8)); w.w = pk2((float)(signed char)(hi >> 16), (float)(signed char)(hi >> 24)); av[kk] = __builtin_bit_cast(bf16x8, w); }
            } else { const bf16* arow = H + (size_t)(grp * 16 + c16) * DM + 8 * q4;
#pragma unroll
                for (int kk = 0; kk < 8; ++kk) av[kk] = *(const GAS bf16x8*)(arow + k0 + 32 * kk); }
#pragma unroll
            for (int kk = 0; kk < 8; ++kk) acc = MFMA16(av[kk], *(const LAS bf16x8*)(WgT + c16 * 1032 + k0 + 32 * kk + 8 * q4), acc);
        }
        if (P_I8) {
#pragma unroll
            for (int j = 0; j < 4; ++j) acc[j] *= rsg[j]; }
#pragma unroll
        for (int j = 0; j < 4; ++j) { float v = acc[j] + gbias; if ((c16 >> 2) & 1) v = logsig(v); Gt[(size_t)(grp * 16 + 4 * q4 + j) * 16 + c16] = v; }
    }
    __syncthreads();
}
__device__ __forceinline__ void phase_norm2(Frame& F, CAP a, int L) {
    const float* nw = ain(a, 7) + L * DM;
    const float* mods = (const float*)(F.ws + WS_MODS) + (size_t)L * 5 * 6144;
    unsigned char* H8 = F.ws + WS_HY; const bf16* T = (const bf16*)(F.ws + WS_P);
    float* RS = (float*)(F.ws + WS_ROUTE + RT_ROWSC);
    static_assert(DENSE_I8 == 1, "phase_norm2 writes int8 rows");
    if (2 * F.gw < NB * TC) {
        const float* mv = mods + 4 * 6144;
        const RowPar Pc = load_par(mv + 2 * 1024, nw, mv + 3 * 1024, mv + 4 * 1024, F.lane);
        for (int rc = 2 * F.gw; rc < NB * TC; rc += 2 * F.NGW) {
            const int b = rc / TC, tp = rc - b * TC, r = b * TT + tp;
            const float* src = ain(a, 2) + (size_t)rc * DM; unsigned char* dst = F.ws + WS_CTXRES + (size_t)rc * RP;
            const float* S = (const float*)(F.ws + WS_SLAB_CW) + (size_t)rc * DM;
            const RowIn I0 = load_row_slabs<false>(src, S, NS_CW, (size_t)1024 * 1024, F.lane), I1 = load_row_slabs<false>(src + DM, S + DM, NS_CW, (size_t)1024 * 1024, F.lane);
            const RowVec R0 = finish_row(I0, true, Pc, dst, F.lane), R1 = finish_row(I1, true, Pc, dst + RP, F.lane);
            store_row_i8(H8 + (size_t)r * DM, RS + r, R0, F.lane); store_row_i8(H8 + (size_t)(r + 1) * DM, RS + r + 1, R1, F.lane);
        }
    }
    const int b = F.gw & 3, wpb = F.NGW >> 2;
    const float* mv = mods + b * 6144;
    const RowPar P = load_par(mv + 2 * 1024, nw, mv + 3 * 1024, mv + 4 * 1024, F.lane);
    const float* xin = ain(a, 0) + (size_t)b * TL * DM; unsigned char* xres = F.ws + WS_RESID + (size_t)b * TL * RP;
    const bf16* Tb = T + ((size_t)b * TT + TC) * DM;
    int t = 2 * (F.gw >> 2);
    RowRaw<true> N0, N1;
    if (t < TL) { N0 = load_raw<true>(xres + (size_t)t * RP, nullptr, F.lane); N1 = load_raw<true>(xres + (size_t)(t + 1) * RP, nullptr, F.lane); }
#pragma unroll 1
    for (; t < TL; t += 2 * wpb) {
        const RowRaw<true> W0 = N0, W1 = N1; const int tn = t + 2 * wpb;
        if (tn < TL) { N0 = load_raw<true>(xres + (size_t)tn * RP, nullptr, F.lane); N1 = load_raw<true>(xres + (size_t)(tn + 1) * RP, nullptr, F.lane); }
        const int r = b * TT + TC + t;
        const RowVec R0 = finish_row(cook<true>(W0), false, P, nullptr, F.lane), R1 = finish_row(cook<true>(W1), false, P, nullptr, F.lane);
        store_row_i8(H8 + (size_t)r * DM, RS + r, R0, F.lane); store_row_i8(H8 + (size_t)(r + 1) * DM, RS + r + 1, R1, F.lane);
    }
}
struct FinRaw { unsigned long long x[4], e0[4], e1[4]; };
__device__ __forceinline__ FinRaw fin_load(const unsigned char* xrow, const bf16* AS, int p0, int p1, int lane) {
    FinRaw R; const GAS unsigned long long* xr = (const GAS unsigned long long*)xrow + lane;
    const GAS unsigned long long* e0 = (const GAS unsigned long long*)(AS + (size_t)p0 * DM) + lane; const GAS unsigned long long* e1 = (const GAS unsigned long long*)(AS + (size_t)p1 * DM) + lane;
#pragma unroll
    for (int j = 0; j < 4; ++j) R.x[j] = xr[64 * j];
    if (p0 < 65536) {
#pragma unroll
        for (int j = 0; j < 4; ++j) R.e0[j] = e0[64 * j]; }
    else {
#pragma unroll
        for (int j = 0; j < 4; ++j) R.e0[j] = 0ull; }
    if (p1 < 65536) {
#pragma unroll
        for (int j = 0; j < 4; ++j) R.e1[j] = e1[64 * j]; }
    else {
#pragma unroll
        for (int j = 0; j < 4; ++j) R.e1[j] = 0ull; }
    return R;
}
__device__ __forceinline__ void fin_row(const FinRaw& W, int p0, int p1, float g0, float g1, const f32x4 (&G)[4], const f32x4 (&Wn)[4], const float* MT, float* orow, int lane) {
    f32x4 v0[4], v1[4], x[4]; float ss = 0.f;
#pragma unroll
    for (int j = 0; j < 4; ++j) { v0[j] = bf4(W.e0[j]); v1[j] = bf4(W.e1[j]); }
    if (p0 >= 65536) {
#pragma unroll 1
        for (int s_ = 0; s_ < NS_MT; ++s_) { const GAS f32x4* sr = (const GAS f32x4*)(MT + ((size_t)s_ * MT_TILES * 256 + (p0 - 65536)) * DM) + lane;
#pragma unroll
            for (int j = 0; j < 4; ++j) v0[j] += sr[64 * j]; } }
    if (p1 >= 65536) {
#pragma unroll 1
        for (int s_ = 0; s_ < NS_MT; ++s_) { const GAS f32x4* sr = (const GAS f32x4*)(MT + ((size_t)s_ * MT_TILES * 256 + (p1 - 65536)) * DM) + lane;
#pragma unroll
            for (int j = 0; j < 4; ++j) v1[j] += sr[64 * j]; } }
#pragma unroll
    for (int j = 0; j < 4; ++j) { x[j] = bf4(W.x[j]) + G[j] * (v0[j] * g0 + v1[j] * g1); ss += dot4(x[j], x[j]); }
    const float rinv = rsqrtf(wave_sum(ss, lane) * (1.f / DM) + EPS);
    GAS f32x4* xw = (GAS f32x4*)orow + lane;
#pragma unroll
    for (int j = 0; j < 4; ++j) xw[64 * j] = x[j] * rinv * Wn[j];
}
__device__ __forceinline__ void phase_final(Frame& F, CAP a) {
    const float* nw = ain(a, 21);
    const int b = F.gw & 3, wpb = F.NGW >> 2;
    const float* gv = (const float*)(F.ws + WS_MODS) + (size_t)5 * 6144 + 5 * 1024 + b * 6144;
    f32x4 G[4], Wn[4];
#pragma unroll
    for (int j = 0; j < 4; ++j) { G[j] = *(const f32x4*)(gv + 256 * j + 4 * F.lane); Wn[j] = *(const f32x4*)(nw + 256 * j + 4 * F.lane); }
    const int* TOKPOS = (const int*)(F.ws + WS_ROUTE + RT_ROWTOK) + (size_t)2 * b * TL; const float* TOKG = (const float*)(F.ws + WS_ROUTE + RT_TOKG) + (size_t)2 * b * TL;
    const bf16* AS = (const bf16*)(F.ws + WS_EOUT); const float* MT = (const float*)(F.ws + WS_SLAB_MT);
    float* out = aout(a) + (size_t)b * TL * DM; const unsigned char* xres = F.ws + WS_RESID + (size_t)b * TL * RP;
    typedef int i32x4v __attribute__((ext_vector_type(4)));
    int t = 2 * (F.gw >> 2);
    if (t >= TL) return;
    i32x4v pc = *(const GAS i32x4v*)(TOKPOS + 2 * t); f32x4 gc = *(const GAS f32x4*)(TOKG + 2 * t);
    int q0 = __builtin_amdgcn_readfirstlane(pc.x), q1 = __builtin_amdgcn_readfirstlane(pc.y), q2 = __builtin_amdgcn_readfirstlane(pc.z), q3 = __builtin_amdgcn_readfirstlane(pc.w);
    FinRaw N0 = fin_load(xres + (size_t)t * RP, AS, q0, q1, F.lane), N1 = fin_load(xres + (size_t)(t + 1) * RP, AS, q2, q3, F.lane);
    i32x4v pn = pc; f32x4 gn = gc;
    if (t + 2 * wpb < TL) { pn = *(const GAS i32x4v*)(TOKPOS + 2 * (t + 2 * wpb)); gn = *(const GAS f32x4*)(TOKG + 2 * (t + 2 * wpb)); }
#pragma unroll 1
    for (; t < TL; t += 2 * wpb) {
        const FinRaw W0 = N0, W1 = N1; const int c0 = q0, c1 = q1, c2 = q2, c3 = q3; const f32x4 gw_ = gc;
        const int tn = t + 2 * wpb;
        if (tn < TL) {
            q0 = __builtin_amdgcn_readfirstlane(pn.x); q1 = __builtin_amdgcn_readfirstlane(pn.y); q2 = __builtin_amdgcn_readfirstlane(pn.z); q3 = __builtin_amdgcn_readfirstlane(pn.w); gc = gn;
            N0 = fin_load(xres + (size_t)tn * RP, AS, q0, q1, F.lane); N1 = fin_load(xres + (size_t)(tn + 1) * RP, AS, q2, q3, F.lane);
            if (tn + 2 * wpb < TL) { pn = *(const GAS i32x4v*)(TOKPOS + 2 * (tn + 2 * wpb)); gn = *(const GAS f32x4*)(TOKG + 2 * (tn + 2 * wpb)); }
        }
        fin_row(W0, c0, c1, gw_.x, gw_.y, G, Wn, MT, out + (size_t)t * DM, F.lane);
        fin_row(W1, c2, c3, gw_.z, gw_.w, G, Wn, MT, out + (size_t)(t + 1) * DM, F.lane);
    }
}

__device__ __forceinline__ void unpack8(v4u raw, float (&x)[8]) {
    x[0] = bflo(raw.x); x[1] = bfhi(raw.x); x[2] = bflo(raw.y); x[3] = bfhi(raw.y); x[4] = bflo(raw.z); x[5] = bfhi(raw.z); x[6] = bflo(raw.w); x[7] = bfhi(raw.w);
}
__device__ __forceinline__ v4u pack8(const float (&x)[8]) { v4u o; o.x = pk2(x[0], x[1]); o.y = pk2(x[2], x[3]); o.z = pk2(x[4], x[5]); o.w = pk2(x[6], x[7]); return o; }
__device__ __forceinline__ void phase_qknorm(Frame& F, CAP a, int L) {
    const bf16* P = (const bf16*)(F.ws + WS_P); bf16* KN = (bf16*)(F.ws + WS_KN);
    const int l16 = F.lane & 15, l8 = F.lane & 7, rsub = F.lane >> 4;
    float kwv[8], invf[4];
#pragma unroll
    for (int e = 0; e < 8; ++e) kwv[e] = ain(a, 12)[L * 64 + 8 * l8 + e];
#pragma unroll
    for (int p = 0; p < 4; ++p) invf[p] = __builtin_amdgcn_exp2f(-(float)((4 * l8 + p) & 15) * 0.83048202372184058f);
    const bool use_row = l8 < 4;
    for (int r0 = 16 * F.gw; r0 < MROWS; r0 += 16 * F.NGW) {
        v4u rk[4];
#pragma unroll
        for (int q = 0; q < 4; ++q) rk[q] = *(const GAS v4u*)(P + (size_t)(r0 + 4 * q + rsub) * NP + CAK + 8 * l16);
#pragma unroll
        for (int q = 0; q < 4; ++q) {
            const int r = r0 + 4 * q + rsub, b = r / TT, tp = r - b * TT, t = tp - TC;
            const float pos = tp >= TC ? (float)(use_row ? (t >> 6) : (t & 63)) : 0.f;
            float x[8]; unpack8(rk[q], x);
            float ss = 0.f;
#pragma unroll
            for (int e = 0; e < 8; ++e) ss += x[e] * x[e];
            ss += shx(ss, 1, F.lane); ss += shx(ss, 2, F.lane); ss += shx(ss, 4, F.lane);
            const float rinv = rsqrtf(ss * (1.f / 64.f) + EPS);
#pragma unroll
            for (int p = 0; p < 4; ++p) { const float ang = pos * invf[p], cs = __cosf(ang), sn = __sinf(ang);
                const float xe = x[2 * p] * rinv * kwv[2 * p], xo = x[2 * p + 1] * rinv * kwv[2 * p + 1]; x[2 * p] = xe * cs - xo * sn; x[2 * p + 1] = xe * sn + xo * cs; }
            *(GAS v4u*)(KN + (size_t)r * 128 + 8 * l16) = pack8(x);
        }
    }
}

__device__ __forceinline__ int scan_ci(int tb, int dir) { return dir == 0 ? tb : (tb < 2 ? 1 - tb : 67 - tb); }

__device__ __forceinline__ void phase_mlstm_local(Frame& F, CAP a, int L) {
    LAS bf16* Vs = (LAS bf16*)(F.lds);
    LAS bf16* KF = (LAS bf16*)(F.lds + 36864);
    LAS bf16* KB = (LAS bf16*)(F.lds + 55296);
    LAS float* GL = (LAS float*)(F.lds + 73728);
    LAS float* WV = (LAS float*)(F.lds + 75776);
    const bf16* P = (const bf16*)(F.ws + WS_P); const float* Gt = (const float*)(F.ws + WS_GATES);
    bf16* CSTC = (bf16*)(F.ws + WS_CSTC); float* CSTN = (float*)(F.ws + WS_CSTN); float* CSTM = (float*)(F.ws + WS_CSTM);
    const int lane = F.lane, tid = F.tid, wave = F.wave, q4 = lane >> 4, c16 = lane & 15;
    for (int u = blockIdx.x; u < NB * 4 * NBLK; u += F.G) {
        const int tb = u % NBLK, bh = u / NBLK, b = bh >> 2, h = bh & 3;
        const int r0 = b * TT + 128 * tb;
        v4u rv[4], rk[2];
#pragma unroll
        for (int i = 0; i < 4; ++i) { const int q = tid + 512 * i, s = q >> 4, dc = q & 15; rv[i] = *(const GAS v4u*)(P + (size_t)(r0 + s) * NP + CV + h * 128 + dc * 8); }
#pragma unroll
        for (int i = 0; i < 2; ++i) { const int q = tid + 512 * i, s = q >> 3, kc = q & 7; rk[i] = *(const GAS v4u*)(P + (size_t)(r0 + s) * NP + CK + h * 64 + kc * 8); }
        { const int g = tid >> 7, i = tid & 127; GL[g * 128 + i] = Gt[(size_t)(r0 + i) * 16 + g * 4 + h]; }
        __syncthreads();
        if (wave < 2) {
            const int dir = wave;
            const float lf0 = GL[(1 + 2 * dir) * 128 + 2 * lane], lf1 = GL[(1 + 2 * dir) * 128 + 2 * lane + 1];
            const float ig0 = GL[(2 * dir) * 128 + 2 * lane], ig1 = GL[(2 * dir) * 128 + 2 * lane + 1];
            const float s = lf0 + lf1, inc = wave_incl_scan_add(s, lane), tot = shi(inc, 63), exc = inc - s;
            float wl0, wl1;
            if (dir == 0) { wl0 = (tot - (exc + lf0)) + ig0; wl1 = (tot - inc) + ig1; }
            else          { wl0 = exc + ig0;                 wl1 = (exc + lf0) + ig1; }
            const float ml = wave_max(fmaxf(wl0, wl1), lane);
            WV[dir * 128 + 2 * lane] = __expf(wl0 - ml); WV[dir * 128 + 2 * lane + 1] = __expf(wl1 - ml);
            if (lane == 0) { const int sidx = (bh * 2 + dir) * NBLK + scan_ci(tb, dir); CSTM[sidx * 2] = ml; CSTM[sidx * 2 + 1] = tot; }
        }
        else if (wave < 4) {
            const int dir = wave - 2;
            const int ta = dir ? 127 - 2 * lane : 2 * lane, tc = dir ? 126 - 2 * lane : 2 * lane + 1;
            const float lf0 = GL[(1 + 2 * dir) * 128 + ta], lf1 = GL[(1 + 2 * dir) * 128 + tc], ig0 = GL[(2 * dir) * 128 + ta], ig1 = GL[(2 * dir) * 128 + tc];
            const float s = lf0 + lf1, inc = wave_incl_scan_add(s, lane), exc = inc - s;
            const float b0 = exc + lf0, b1 = inc, g0 = ig0 - b0, g1 = ig1 - b1;
            const float mx1 = fmaxf(g0, g1), pm = wave_incl_scan_max(mx1, lane);
            float pe = shu(pm, 1, lane); if (lane == 0) pe = -INFINITY;
            typedef float f32x2g __attribute__((ext_vector_type(2)));
            GAS f32x2g* gp = (GAS f32x2g*)(F.ws + WS_GPRE) + (size_t)((bh * 2 + dir) * NBLK + tb) * 128;
            gp[ta] = (f32x2g){g0, fmaxf(pe, g0)}; gp[tc] = (f32x2g){g1, pm};
        }
#pragma unroll
        for (int i = 0; i < 4; ++i) { const int q = tid + 512 * i, s = q >> 4, dc = q & 15; *(LAS v4u*)(Vs + s * 144 + dc * 8) = rv[i]; }
        { const int s = tid >> 2, part = tid & 3; *(LAS unsigned long long*)(Vs + s * 144 + 128 + 4 * part) = part == 0 ? 0x3F80ull : 0ull; }
        __syncthreads();
#pragma unroll
        for (int i = 0; i < 2; ++i) { const int q = tid + 512 * i, s = q >> 3, kc = q & 7;
            float kv[8], o[8]; unpack8(rk[i], kv);
            const float wf = WV[s], wb = WV[128 + s];
#pragma unroll
            for (int e = 0; e < 8; ++e) o[e] = kv[e] * wf;
            *(LAS v4u*)(KF + s * 72 + kc * 8) = pack8(o);
#pragma unroll
            for (int e = 0; e < 8; ++e) o[e] = kv[e] * wb;
            *(LAS v4u*)(KB + s * 72 + kc * 8) = pack8(o); }
        __syncthreads();
        {
            const attn_body::lds_cptr vbase = (attn_body::lds_cptr)Vs + (8 * q4 + (c16 >> 2)) * 288 + 8 * (c16 & 3);
            bf16x8 vf[4], v1[4];
#pragma unroll
            for (int s4 = 0; s4 < 4; ++s4) { const attn_body::s16x4 lo = attn_body::vtr(vbase + 32 * s4 * 288 + 32 * wave), hi = attn_body::vtr(vbase + (32 * s4 + 4) * 288 + 32 * wave);
                vf[s4] = (bf16x8){lo[0], lo[1], lo[2], lo[3], hi[0], hi[1], hi[2], hi[3]};
                const attn_body::s16x4 lo1 = attn_body::vtr(vbase + 32 * s4 * 288 + 32 * 8), hi1 = attn_body::vtr(vbase + (32 * s4 + 4) * 288 + 32 * 8);
                v1[s4] = (bf16x8){lo1[0], lo1[1], lo1[2], lo1[3], hi1[0], hi1[1], hi1[2], hi1[3]}; }
#pragma unroll
            for (int dir = 0; dir < 2; ++dir) {
                const attn_body::lds_cptr kbase = (attn_body::lds_cptr)(dir ? KB : KF) + (8 * q4 + (c16 >> 2)) * 144 + 8 * (c16 & 3);
                const int sidx = (bh * 2 + dir) * NBLK + scan_ci(tb, dir);
                bf16* cdst = CSTC + (size_t)sidx * 8192;
#pragma unroll
                for (int kt = 0; kt < 4; ++kt) {
                    f32x4 acc = (f32x4){0.f, 0.f, 0.f, 0.f}, accn = acc;
                    const bool mine = (kt == (wave & 3)) && (dir == (wave >> 2));
#pragma unroll
                    for (int s4 = 0; s4 < 4; ++s4) { const attn_body::s16x4 lo = attn_body::vtr(kbase + 32 * s4 * 144 + 32 * kt), hi = attn_body::vtr(kbase + (32 * s4 + 4) * 144 + 32 * kt);
                        const bf16x8 kf = (bf16x8){lo[0], lo[1], lo[2], lo[3], hi[0], hi[1], hi[2], hi[3]};
                        acc = MFMA16(kf, vf[s4], acc);
                        if (mine) accn = MFMA16(kf, v1[s4], accn); }
                    *(GAS unsigned long long*)(cdst + (16 * wave + c16) * 64 + 16 * kt + 4 * q4) = (unsigned long long)pk2(acc[0], acc[1]) | ((unsigned long long)pk2(acc[2], acc[3]) << 32);
                    if (mine && c16 == 0) *(GAS f32x4*)(CSTN + (size_t)sidx * 64 + 16 * kt + 4 * q4) = accn;
                }
            }
        }
        __syncthreads();
    }
}

template <bool PROBE> __device__ __forceinline__ void phase_scan(Frame& F) {
    unsigned* CSTC = (unsigned*)(F.ws + WS_CSTC); float* CSTN = (float*)(F.ws + WS_CSTN); const float* CSTM = (const float*)(F.ws + WS_CSTM); float* CSTE = (float*)(F.ws + WS_CSTE);
    const int tid = F.tid;
    for (int u = blockIdx.x; u < NSEQ * 8; u += F.G) {
        const int seq = u >> 3, js = u & 7; const bool nown = (js == 0 && tid < 64);
        float C0 = 0.f, C1 = 0.f, n = 0.f, m = 0.f;
        unsigned* cb = CSTC + (size_t)seq * NBLK * 4096 + js * 512 + tid;
        constexpr int SB = 11;
        unsigned cl[2][SB]; float ml[2][SB], g[2][SB], nl[2][SB];
#define SCAN_LOAD(buf, c0) do { _Pragma("unroll") for (int i = 0; i < SB; ++i) { const size_t si = (size_t)seq * NBLK + (c0) + i; cl[buf][i] = cb[(size_t)((c0) + i) * 4096]; \
            ml[buf][i] = CSTM[si * 2]; g[buf][i] = CSTM[si * 2 + 1]; nl[buf][i] = nown ? CSTN[si * 64 + tid] : 0.f; } } while (0)
#define SCAN_STEP(buf, c0) do { _Pragma("unroll") for (int i = 0; i < SB; ++i) { const size_t si = (size_t)seq * NBLK + (c0) + i; \
            const float mnew = fmaxf(g[buf][i] + m, ml[buf][i]), aa = __expf(g[buf][i] + m - mnew), sv = __expf(ml[buf][i] - mnew); \
            cb[(size_t)((c0) + i) * 4096] = PROBE ? cl[buf][i] : pk2(C0, C1); \
            if (nown) CSTN[si * 64 + tid] = PROBE ? nl[buf][i] : n; \
            if (!PROBE && js == 0 && tid == 0) CSTE[si] = m; \
            C0 = aa * C0 + sv * bflo(cl[buf][i]); C1 = aa * C1 + sv * bfhi(cl[buf][i]); n = aa * n + sv * nl[buf][i]; m = mnew; } } while (0)
        SCAN_LOAD(0, 0);
#pragma unroll
        for (int k = 0; k < NBLK / SB; ++k) {
            if (k + 1 < NBLK / SB) { if ((k & 1) == 0) SCAN_LOAD(1, (k + 1) * SB); else SCAN_LOAD(0, (k + 1) * SB); }
            if ((k & 1) == 0) SCAN_STEP(0, k * SB); else SCAN_STEP(1, k * SB);
        }
#undef SCAN_LOAD
#undef SCAN_STEP
    }
}

template <int PRB  > __device__ __forceinline__ void phase_mlstm_out(Frame& F, CAP a, int L) {
    LAS bf16* Qs = (LAS bf16*)(F.lds);
    LAS bf16* Ks = (LAS bf16*)(F.lds + 18432);
    LAS bf16* Vs = (LAS bf16*)(F.lds + 36864);
    LAS bf16* Es = (LAS bf16*)(F.lds + 73728);
    LAS bf16* Sm = (LAS bf16*)(F.lds + 111168) + F.wave * (128 * 16);
    LAS float* GL = (LAS float*)(F.lds + 143936);
    LAS float* VG = (LAS float*)(F.lds + 145984);
    LAS float* Hs = (LAS float*)(F.lds + 36864);
    const bf16* P = (const bf16*)(F.ws + WS_P); const float* Gt = (const float*)(F.ws + WS_GATES);
    const bf16* CSTC = (const bf16*)(F.ws + WS_CSTC); const float* CSTN = (const float*)(F.ws + WS_CSTN); const float* CSTE = (const float*)(F.ws + WS_CSTE);
    bf16* Y = (bf16*)(F.ws + WS_HY);
    const float* mnw = ain(a, 10) + L * 512;
    const int wave = F.wave, t0 = 16 * wave;
    const int nblk = (L == 0) ? NBLK : NBLK - 2;
#define MO_LOAD(uu, tid, RMO) do { \
        const int bh_ = (uu) / nblk, tb_ = (uu) % nblk + (NBLK - nblk), b_ = bh_ >> 2, h_ = bh_ & 3, r0_ = b_ * TT + 128 * tb_; \
        const int s0_ = (bh_ * 2 + 0) * NBLK + scan_ci(tb_, 0), s1_ = (bh_ * 2 + 1) * NBLK + scan_ci(tb_, 1); \
        _Pragma("unroll") for (int i = 0; i < 2; ++i) { const int q = (tid) + 512 * i, s = q >> 3, c = q & 7; \
            rq[i] = *(const GAS v4u*)(P + (size_t)(r0_ + s) * NP + CQ + h_ * 64 + c * 8); rk[i] = *(const GAS v4u*)(P + (size_t)(r0_ + s) * NP + CK + h_ * 64 + c * 8); } \
        _Pragma("unroll") for (int i = 0; i < 4; ++i) { const int q = (tid) + 512 * i, s = q >> 4, dc = q & 15; rv[i] = *(const GAS v4u*)(P + (size_t)(r0_ + s) * NP + CV + h_ * 128 + dc * 8); } \
        gval = 0.f; gpre = (f32x2m){0.f, 0.f}; \
        if ((tid) < 256) { gval = Gt[(size_t)(r0_ + ((tid) & 127)) * 16 + (2 * ((tid) >> 7)) * 4 + h_]; gpre = *((const GAS f32x2m*)(F.ws + WS_GPRE) + (size_t)((bh_ * 2 + ((tid) >> 7)) * NBLK + tb_) * 128 + ((tid) & 127)); } \
        _Pragma("unroll") for (int i = 0; i < 4; ++i) { const int q = (tid) + 512 * i; RMO[i] = *(const GAS v4u*)(P + (size_t)(r0_ + (q >> 4)) * NP + CO + h_ * 128 + (q & 15) * 8); } \
        _Pragma("unroll") for (int i = 0; i < 4; ++i) { const int idx = (tid) + 512 * i; e0[i] = *(const GAS unsigned long long*)(CSTC + (size_t)s0_ * 8192 + idx * 4); e1[i] = *(const GAS unsigned long long*)(CSTC + (size_t)s1_ * 8192 + idx * 4); } \
        n0 = (f32x4){0.f, 0.f, 0.f, 0.f}; n1 = n0; \
        if ((tid) < 16) n0 = *(const GAS f32x4*)(CSTN + (size_t)s0_ * 64 + (tid) * 4); else if ((tid) < 32) n1 = *(const GAS f32x4*)(CSTN + (size_t)s1_ * 64 + ((tid) - 16) * 4); \
        me0 = CSTE[s0_]; me1 = CSTE[s1_]; } while (0)
    typedef float f32x2m __attribute__((ext_vector_type(2)));
    v4u rq[2], rk[2], rv[4], rmo[4], rmo_n[4]; unsigned long long e0[4], e1[4]; f32x4 n0, n1; float gval, me0, me1; f32x2m gpre;
    if ((int)blockIdx.x < NB * 4 * nblk) { int t0_ = F.tid; asm volatile("" : "+v"(t0_)); MO_LOAD((int)blockIdx.x, t0_, rmo); }
    for (int u = blockIdx.x; u < NB * 4 * nblk; u += F.G) {
        int tid_ = F.tid; asm volatile("" : "+v"(tid_));
        const int tid = tid_, lane = tid & 63, q4 = lane >> 4, c16 = lane & 15;
        const int bh = u / nblk, tb = u % nblk + (NBLK - nblk), b = bh >> 2, h = bh & 3;
        const int r0 = b * TT + 128 * tb;
        const int sidx0 = (bh * 2 + 0) * NBLK + scan_ci(tb, 0), sidx1 = (bh * 2 + 1) * NBLK + scan_ci(tb, 1);
        { const int s = tid >> 2, part = tid & 3; *(LAS unsigned long long*)(Vs + s * 144 + 128 + 4 * part) = part == 0 ? 0x3F80ull : 0ull; }
#pragma unroll
        for (int i = 0; i < 2; ++i) { const int q = tid + 512 * i, s = q >> 3, c = q & 7; *(LAS v4u*)(Qs + s * 72 + c * 8) = rq[i]; *(LAS v4u*)(Ks + s * 72 + c * 8) = rk[i]; }
#pragma unroll
        for (int i = 0; i < 4; ++i) { const int q = tid + 512 * i, s = q >> 4, dc = q & 15; *(LAS v4u*)(Vs + s * 144 + dc * 8) = rv[i]; }
        if (tid < 256) { LAS float* V_ = VG + 512 * (tid >> 7); const int t_ = tid & 127;
            const float me = (tid >> 7) ? me1 : me0, g_ = gpre.x, M_ = fmaxf(me, gpre.y), b_ = gval - g_;
            V_[t_] = g_; V_[128 + t_] = M_; V_[256 + t_] = __expf(me - M_); V_[384 + t_] = __expf(-(b_ + M_)); }
#pragma unroll
        for (int i = 0; i < 4; ++i) { const int idx = tid + 512 * i, d = idx >> 4, c4 = idx & 15; *(LAS unsigned long long*)(Es + d * 72 + c4 * 4) = e0[i]; *(LAS unsigned long long*)(Es + 130 * 72 + d * 72 + c4 * 4) = e1[i]; }
        if (tid < 16) *(LAS unsigned long long*)(Es + 128 * 72 + tid * 4) = (unsigned long long)pk2(n0.x, n0.y) | ((unsigned long long)pk2(n0.z, n0.w) << 32);
        else if (tid < 32) *(LAS unsigned long long*)(Es + 130 * 72 + 128 * 72 + (tid - 16) * 4) = (unsigned long long)pk2(n1.x, n1.y) | ((unsigned long long)pk2(n1.z, n1.w) << 32);
        __syncthreads();
        f32x4 hsum[8];
#pragma unroll
        for (int ct = 0; ct < 8; ++ct) hsum[ct] = (f32x4){0.f, 0.f, 0.f, 0.f};
#pragma unroll 1
        for (int dir = 0; dir < ((PRB & 1) ? 0 : 2); ++dir) {
            const LAS float* V_ = VG + 512 * dir;
            const LAS bf16* Ed = Es + dir * (130 * 72);
            float Mr[4], ar[4], er[4];
#pragma unroll
            for (int j = 0; j < 4; ++j) { const int t = t0 + 4 * q4 + j; Mr[j] = V_[128 + t]; ar[j] = V_[256 + t] * 0.125f; er[j] = V_[384 + t]; }
            bf16x8 qa[2];
#pragma unroll
            for (int k = 0; k < 2; ++k) qa[k] = *(const LAS bf16x8*)(Qs + (t0 + c16) * 72 + 32 * k + 8 * q4);
            const int slo = dir ? (wave >> 1) : 0, shi_ = dir ? 3 : (wave >> 1);
#pragma unroll
            for (int st = 0; st < 8; ++st) if ((st >> 1) >= slo && (st >> 1) <= shi_) {
                f32x4 acc = (f32x4){0.f, 0.f, 0.f, 0.f};
#pragma unroll
                for (int k = 0; k < 2; ++k) acc = MFMA16(qa[k], *(const LAS bf16x8*)(Ks + (16 * st + c16) * 72 + 32 * k + 8 * q4), acc);
                const int s = 16 * st + c16; const float gs = V_[s];
                float w[4];
#pragma unroll
                for (int j = 0; j < 4; ++j) { const int t = t0 + 4 * q4 + j; const bool ok = dir == 0 ? (s <= t) : (s >= t); w[j] = ok ? acc[j] * 0.125f * __expf(gs - Mr[j]) : 0.f; }
                *(LAS unsigned long long*)(Sm + s * 16 + 4 * q4) = (unsigned long long)pg8::cvt_pk_bf16(w[0], w[1]) | ((unsigned long long)pg8::cvt_pk_bf16(w[2], w[3]) << 32);
            }
            bf16x8 sa[4];
            { const attn_body::lds_cptr sp = (attn_body::lds_cptr)Sm + (8 * q4 + (c16 >> 2)) * 32 + 8 * (c16 & 3);
#pragma unroll
              for (int s4 = 0; s4 < 4; ++s4) { const attn_body::s16x4 lo = attn_body::vtr(sp + 32 * s4 * 32), hi = attn_body::vtr(sp + (32 * s4 + 4) * 32);
                  sa[s4] = (bf16x8){lo[0], lo[1], lo[2], lo[3], hi[0], hi[1], hi[2], hi[3]}; } }
            f32x4 res[9];
#pragma unroll
            for (int ct = 0; ct < 9; ++ct) {
                f32x4 acc1 = (f32x4){0.f, 0.f, 0.f, 0.f}, acc2 = (f32x4){0.f, 0.f, 0.f, 0.f};
#pragma unroll
                for (int s4 = 0; s4 < 4; ++s4) if (s4 >= slo && s4 <= shi_)
                { const attn_body::lds_cptr vp = (attn_body::lds_cptr)Vs + (32 * s4 + 8 * q4 + (c16 >> 2)) * 288 + 32 * ct + 8 * (c16 & 3);
                    const attn_body::s16x4 lo = attn_body::vtr(vp), hi = attn_body::vtr(vp + 4 * 288);
                    acc1 = MFMA16(sa[s4], ((bf16x8){lo[0], lo[1], lo[2], lo[3], hi[0], hi[1], hi[2], hi[3]}), acc1); }
#pragma unroll
                for (int k = 0; k < 2; ++k) acc2 = MFMA16(qa[k], *(const LAS bf16x8*)(Ed + (16 * ct + c16) * 72 + 32 * k + 8 * q4), acc2);
#pragma unroll
                for (int j = 0; j < 4; ++j) res[ct][j] = acc1[j] + ar[j] * acc2[j];
                if (ct % 3 == 2) asm volatile("" ::: "memory");
            }
#pragma unroll
            for (int j = 0; j < 4; ++j) { const float den = shi(res[8][j], lane & 48); const float inv = __builtin_amdgcn_rcpf(fmaxf(fabsf(den), er[j]));
#pragma unroll
                for (int ct = 0; ct < 8; ++ct) hsum[ct][j] += res[ct][j] * inv; }
        }
        { const int un_ = (u + F.G < NB * 4 * nblk) ? u + F.G : u; MO_LOAD(un_, tid, rmo_n); }
        const f32x4 wa = *(const f32x4*)(mnw + h * 128 + (tid & 15) * 8), wb = *(const f32x4*)(mnw + h * 128 + (tid & 15) * 8 + 4);
        __syncthreads();
#pragma unroll
        for (int j = 0; j < 4; ++j) {
            float ss = 0.f;
#pragma unroll
            for (int ct = 0; ct < 8; ++ct) ss += hsum[ct][j] * hsum[ct][j];
            ss += WAVE_DPP(ss, 0xB1); ss += WAVE_DPP(ss, 0x4E); ss += WAVE_DPP(ss, 0x141); ss += WAVE_DPP(ss, 0x140);
            const float rinv = rsqrtf(ss * (1.f / 128.f) + EPS);
#pragma unroll
            for (int ct = 0; ct < 8; ++ct) Hs[(t0 + 4 * q4 + j) * 132 + 16 * ct + c16] = hsum[ct][j] * rinv;
        }
        __syncthreads();
#pragma unroll
        for (int i = 0; i < ((PRB & 2) ? 0 : 4); ++i) { const int q = tid + 512 * i, t = q >> 4, c = q & 15; const size_t r = (size_t)(r0 + t);
            float mo[8]; unpack8(rmo[i], mo);
            const f32x4 ha = *(const LAS f32x4*)(Hs + t * 132 + c * 8), hb = *(const LAS f32x4*)(Hs + t * 132 + c * 8 + 4);
            float o[8];
            o[0] = ha.x * wa.x * __builtin_amdgcn_rcpf(1.f + __expf(-mo[0])); o[1] = ha.y * wa.y * __builtin_amdgcn_rcpf(1.f + __expf(-mo[1]));
            o[2] = ha.z * wa.z * __builtin_amdgcn_rcpf(1.f + __expf(-mo[2])); o[3] = ha.w * wa.w * __builtin_amdgcn_rcpf(1.f + __expf(-mo[3]));
            o[4] = hb.x * wb.x * __builtin_amdgcn_rcpf(1.f + __expf(-mo[4])); o[5] = hb.y * wb.y * __builtin_amdgcn_rcpf(1.f + __expf(-mo[5]));
            o[6] = hb.z * wb.z * __builtin_amdgcn_rcpf(1.f + __expf(-mo[6])); o[7] = hb.w * wb.w * __builtin_amdgcn_rcpf(1.f + __expf(-mo[7]));
            *(GAS v4u*)(Y + r * DM + h * 128 + c * 8) = pack8(o); }
#pragma unroll
        for (int i = 0; i < 4; ++i) rmo[i] = rmo_n[i];
        __syncthreads();
    }
#undef MO_LOAD
}

__device__ __forceinline__ void phase_attn(Frame& F, CAP a, int L, char* lds_generic) {
    const attn_body::bf16* KN = (const attn_body::bf16*)(F.ws + WS_KN);
    const attn_body::bf16* P = (const attn_body::bf16*)(F.ws + WS_P); attn_body::bf16* Y = (attn_body::bf16*)(F.ws + WS_HY);
    const float* qw = ain(a, 11) + L * 64;
    float mq = 0.f, mk = 0.f;
    { f32x4 qv[16], kv[16]; const float* kw = ain(a, 12) + L * 64;
#pragma unroll
      for (int d = 0; d < 16; ++d) { qv[d] = *(const GAS f32x4*)(qw + 4 * d); kv[d] = *(const GAS f32x4*)(kw + 4 * d); }
#pragma unroll
      for (int d = 0; d < 16; ++d) { mq = fmaxf(fmaxf(mq, fmaxf(fabsf(qv[d].x), fabsf(qv[d].y))), fmaxf(fabsf(qv[d].z), fabsf(qv[d].w))); mk = fmaxf(fmaxf(mk, fmaxf(fabsf(kv[d].x), fabsf(kv[d].y))), fmaxf(fabsf(kv[d].z), fabsf(kv[d].w))); } }
    const float negB = -(8.f * mq * mk * 1.4426950408889634f * 1.03f + 0.25f);
    bool conv_pending = (L == 0);
    for (int v = F.vcu; v < 256; v += F.G)
        for (int i = 0; i < 5; ++i) {
            if (i == 4 && !(L == 0 && (v & 7) == 0)) break;
            if (conv_pending && i == (v & 3)) { conv_pending = false; convert_weights(F, a, I_SMALL, I_MOE, (LAS float*)(F.lds + 86016 + F.wave * 8448)); }
            const int bh = v >> 3, b = bh >> 3, h = bh & 7;
            int qrow0, NT, tok0;
            if (i < 4) { const int qb = ((4 * v + i) & 31); qrow0 = b * TT + TC + qb * 256; NT = TT / 64; tok0 = qb * 256; }
            else { qrow0 = b * TT; NT = TC / 64; tok0 = -1; }
            const size_t krow0 = (size_t)b * TT;
            attn_body::attn_unit<8, true, true>(P + (size_t)qrow0 * NP + CAQ + h * 64, KN + krow0 * 128 + (h >> 2) * 64, P + krow0 * NP + CAV + (h >> 2) * 64,
                                                Y + (size_t)qrow0 * DM + 512 + h * 64, NT, negB, qw, tok0, lds_generic);
        }
    if (conv_pending) convert_weights(F, a, I_SMALL, I_MOE, (LAS float*)(F.lds + 86016 + F.wave * 8448));
}

__device__ __forceinline__ void phase_norm2_route(Frame& F, CAP a) {
    LAS float* rT = (LAS float*)F.lds;
    LAS unsigned* hist = (LAS unsigned*)(F.lds + 32768);
    { float rv_[16];
#pragma unroll
      for (int i = 0; i < 16; ++i) rv_[i] = ain(a, 17)[F.tid + NTHR * i];
#pragma unroll
      for (int i = 0; i < 16; ++i) { const int idx = F.tid + NTHR * i, k = idx >> 3, e = idx & 7; rT[e * 1024 + k] = rv_[i]; } }
    const float* nw = ain(a, 7) + 1 * DM;
    const float* mods = (const float*)(F.ws + WS_MODS) + (size_t)1 * 5 * 6144;
    unsigned char* H2 = F.ws + WS_H2B; const bf16* T = (const bf16*)(F.ws + WS_P);
    int* TOKE = (int*)(F.ws + WS_ROUTE + RT_TOKE); float* TOKG = (float*)(F.ws + WS_ROUTE + RT_TOKG); int* CNT = (int*)(F.ws + WS_ROUTE + RT_CNT);
    for (int tb = blockIdx.x; tb < 256; tb += F.G) {
        if (F.tid < 8) hist[F.tid] = 0u;
        __syncthreads();
        const int tok0 = tb * 128 + F.wave * 16, b = tok0 >> 13;
        const float* mv = mods + b * 6144;
        const RowPar PR = load_par(mv + 2 * 1024, nw, mv + 3 * 1024, mv + 4 * 1024, F.lane);
        unsigned char* xblk = F.ws + WS_RESID + (size_t)tok0 * RP; const bf16* tblk = T + ((size_t)b * TT + TC + (tok0 & (TL - 1))) * DM;
        RowRaw<true> N0 = load_raw<true>(xblk, nullptr, F.lane), N1 = load_raw<true>(xblk + RP, nullptr, F.lane);
#pragma unroll 1
        for (int i = 0; i < 16; i += 2) {
            const int tok = tok0 + i;
            const RowRaw<true> W0 = N0, W1 = N1;
            if (i + 2 < 16) { N0 = load_raw<true>(xblk + (size_t)(i + 2) * RP, nullptr, F.lane); N1 = load_raw<true>(xblk + (size_t)(i + 3) * RP, nullptr, F.lane); }
            unsigned char* xrow = nullptr;
            RowVec R[2];
            R[0] = finish_row(cook<true>(W0), false, PR, xrow, F.lane); R[1] = finish_row(cook<true>(W1), false, PR, xrow, F.lane);
            store_row_fp8(H2 + (size_t)tok * DM, R[0], F.lane); store_row_fp8(H2 + (size_t)(tok + 1) * DM, R[1], F.lane);
            float lg[2][8];
#pragma unroll
            for (int e = 0; e < 8; ++e) { float s0 = 0.f, s1 = 0.f;
#pragma unroll
                for (int j = 0; j < 4; ++j) { const f32x4 w4 = *(const LAS f32x4*)(rT + e * 1024 + 256 * j + 4 * F.lane); s0 += dot4(R[0].h[j], w4); s1 += dot4(R[1].h[j], w4); }
                lg[0][e] = wave_sum(s0, F.lane); lg[1][e] = wave_sum(s1, F.lane); }
#pragma unroll
            for (int q = 0; q < 2; ++q) {
                float v0 = -INFINITY, v1 = -INFINITY; int i0 = 0, i1 = 0;
#pragma unroll
                for (int e = 0; e < 8; ++e) if (lg[q][e] > v0) { v0 = lg[q][e]; i0 = e; }
#pragma unroll
                for (int e = 0; e < 8; ++e) if (e != i0 && lg[q][e] > v1) { v1 = lg[q][e]; i1 = e; }
                if (F.lane == 0) { const float ex = __expf(v1 - v0), g0 = 1.f / (1.f + ex);
                    TOKE[tok + q] = i0 | (i1 << 8); TOKG[2 * (tok + q)] = g0; TOKG[2 * (tok + q) + 1] = ex * g0;
                    __hip_atomic_fetch_add(hist + i0, 1u, __ATOMIC_RELAXED, __HIP_MEMORY_SCOPE_WORKGROUP);
                    __hip_atomic_fetch_add(hist + i1, 1u, __ATOMIC_RELAXED, __HIP_MEMORY_SCOPE_WORKGROUP); }
            }
        }
        __syncthreads();
        if (F.tid < 8) CNT[tb * 8 + F.tid] = (int)hist[F.tid];
        __syncthreads();
    }
}
__device__ __forceinline__ void phase_moe_sort(Frame& F, CAP a) {
    LAS int* gbase = (LAS int*)F.lds;  LAS int* gtot = gbase + 16;  LAS unsigned* cur = (LAS unsigned*)(gbase + 32);  LAS int* postab = gbase + 64;
    const int* TOKE = (const int*)(F.ws + WS_ROUTE + RT_TOKE); const int* CNT = (const int*)(F.ws + WS_ROUTE + RT_CNT);
    int* INFO = (int*)(F.ws + WS_ROUTE + RT_INFO); int* TILEE = (int*)(F.ws + WS_ROUTE + RT_TILEE); int* TOKPOS = (int*)(F.ws + WS_ROUTE + RT_ROWTOK);
    const unsigned char* H2 = F.ws + WS_H2B; unsigned char* AS = F.ws + WS_ASORT;
    for (int tb = blockIdx.x; tb < 256; tb += F.G) {
        if (F.tid < 8) { gtot[F.tid] = 0; cur[F.tid] = 0u; }
        __syncthreads();
        if (F.tid < 256) {
            typedef int i32x4s __attribute__((ext_vector_type(4)));
            const i32x4s c0 = *(const GAS i32x4s*)(CNT + F.tid * 8), c1 = *(const GAS i32x4s*)(CNT + F.tid * 8 + 4);
            const int cv[8] = {c0.x, c0.y, c0.z, c0.w, c1.x, c1.y, c1.z, c1.w};
#pragma unroll
            for (int g = 0; g < 8; ++g) { __hip_atomic_fetch_add(gtot + g, cv[g], __ATOMIC_RELAXED, __HIP_MEMORY_SCOPE_WORKGROUP);
                if (F.tid < tb) __hip_atomic_fetch_add(cur + g, (unsigned)cv[g], __ATOMIC_RELAXED, __HIP_MEMORY_SCOPE_WORKGROUP); } }
        __syncthreads();
        if (F.tid == 0) { int acc = 0; for (int g = 0; g < 8; ++g) { gbase[g] = acc; acc += (gtot[g] + 255) & ~255; } }
        __syncthreads();
        if (F.tid < 8) cur[F.tid] += (unsigned)gbase[F.tid];
        __syncthreads();
        if (F.tid < 128) { const int tok = tb * 128 + F.tid, ee = TOKE[tok], i0 = ee & 255, i1 = ee >> 8;
            const int p0 = (int)__hip_atomic_fetch_add(cur + i0, 1u, __ATOMIC_RELAXED, __HIP_MEMORY_SCOPE_WORKGROUP);
            const int p1 = (int)__hip_atomic_fetch_add(cur + i1, 1u, __ATOMIC_RELAXED, __HIP_MEMORY_SCOPE_WORKGROUP);
            TOKPOS[2 * tok] = p0; TOKPOS[2 * tok + 1] = p1;
            postab[2 * F.tid] = p0; postab[2 * F.tid + 1] = p1; }
        __syncthreads();
#pragma unroll 1
        for (int c = 0; c < 16; c += 8) {
            v4u v[8];
#pragma unroll
            for (int q = 0; q < 8; ++q) v[q] = *((const GAS v4u*)(H2 + (size_t)(tb * 128 + F.wave * 16 + c + q) * DM) + F.lane);
#pragma unroll
            for (int q = 0; q < 8; ++q) { const int p0 = postab[2 * (F.wave * 16 + c + q)], p1 = postab[2 * (F.wave * 16 + c + q) + 1];
                *((GAS v4u*)(AS + (size_t)p0 * DM) + F.lane) = v[q]; *((GAS v4u*)(AS + (size_t)p1 * DM) + F.lane) = v[q]; }
        }
        if (tb == 0) {
            const int nt = (gbase[7] + ((gtot[7] + 255) & ~255)) >> 8;
            if (F.tid < nt) { const int row0 = F.tid * 256; int e = 0;
#pragma unroll 1
                for (int g = 0; g < 8; ++g) if (row0 >= gbase[g] && row0 < gbase[g] + ((gtot[g] + 255) & ~255)) e = g;
                TILEE[F.tid] = e; }
            if (F.tid == 0) INFO[0] = nt;
        }
        __syncthreads();
    }
}

struct RowOrder : pg8::StaticOrder {
    int latent_only;
    __device__ __forceinline__ bool next(int i, pg8::Unit& u) const { if (!pg8::StaticOrder::next(i, u)) return false; if (latent_only) u.pm = (u.pm >> 5) * 33 + 1 + (u.pm & 31); return true; }
};
struct MoeUpOrder : pg8::StaticOrder {
    int lo; const LAS int* tile_e;
    __device__ __forceinline__ bool next(int i, pg8::Unit& u) const { if (!pg8::StaticOrder::next(i, u)) return false; const int e = tile_e[lo + u.pm]; u.pm += lo; u.pn += e * 28; return true; }
};
struct MoeDownOrder : pg8::StaticOrder {
    int lo; const LAS int* tile_e;
    __device__ __forceinline__ bool next(int i, pg8::Unit& u) const { if (!pg8::StaticOrder::next(i, u)) return false; const int e = tile_e[lo + u.pm]; u.pn += e * 4; return true; }
};
struct EpiNull {
    static constexpr bool PERM = true, AFTER_DRAIN = false; static constexpr int NST = 0; unsigned char* O; int mode;
    __device__ __forceinline__ void operator()(const pg8::f32x4 (&acc)[2][2][4][2], const pg8::Unit& u, int wr, int wc, int fr, int fq) const {
        if (mode == 2) {
#pragma unroll
            for (int ai = 0; ai < 2; ++ai)
#pragma unroll
                for (int m = 0; m < 4; ++m) { const pg8::f32x4 g0 = acc[ai][0][m][0] + acc[ai][1][m][0], g1 = acc[ai][0][m][1] + acc[ai][1][m][1];
                    *(unsigned long long*)(O + (size_t)(((u.pm & 127) * 256) + wr * 64 + fr + ai * 128 + m * 16) * 3584 + (u.pn % 28) * 128 + wc * 32 + 8 * fq) = (unsigned long long)__float_as_uint(g0[0] + g0[1] + g0[2] + g0[3]) | ((unsigned long long)__float_as_uint(g1[0] + g1[1] + g1[2] + g1[3]) << 32); }
        } else if (mode == 1 && acc[0][0][0][0][0] == 123456.789f) O[0] = 1;
    }
};
struct SplitOrder {
    int nT, nN, nS, ksub, G, c, pm_mul, lo, e_mul; const LAS int* tile_e;
    __device__ __forceinline__ bool next(int i, pg8::Unit& u) const {
        const long L = (long)i * G + c; if (L >= (long)nT * nN * nS) return false;
        const int ks = (int)(L % nS), r = (int)(L / nS), pn = r % nN, tm = r / nN;
        u.pm = tm * pm_mul; u.pn = pn + (tile_e ? tile_e[lo + tm] * e_mul : 0); u.ko = ks * ksub; return true; }
    __device__ __forceinline__ void a_ready(const pg8::Unit&) const {}
    __device__ __forceinline__ void done(const pg8::Unit&) const {}
};
struct EpiSlab {
    static constexpr bool PERM = false, AFTER_DRAIN = false; static constexpr int NST = 32;
    float* S; size_t sstride; int ksub, pm_div; float scale;
    __device__ __forceinline__ void operator()(const pg8::f32x4 (&acc)[2][2][4][2], const pg8::Unit& u, int wr, int wc, int fr, int fq) const {
        char* base = (char*)(S + (size_t)(u.ko / ksub) * sstride + (size_t)((u.pm / pm_div) * 256) * DM + (u.pn & 3) * 256);
        const unsigned off0 = (unsigned)((wr * 64 + fr) * DM + wc * 32 + 4 * fq) * 4u;
#pragma unroll
        for (int ai = 0; ai < 2; ++ai)
#pragma unroll
            for (int m = 0; m < 4; ++m) { const unsigned ro = off0 + (unsigned)((ai * 128 + m * 16) * DM * 4);
#pragma unroll
                for (int bj = 0; bj < 2; ++bj)
#pragma unroll
                    for (int n = 0; n < 2; ++n) *(pg8::f32x4*)(base + ro + (unsigned)((bj * 128 + n * 16) * 4)) = acc[ai][bj][m][n] * scale;
                asm volatile("" ::: "memory"); }
    }
};
template <bool I8> struct EpiBf16R {
    static constexpr bool PERM = true, AFTER_DRAIN = false; static constexpr int NST = 16;
    bf16* O; int ldc; const float* rowsc; const gu32* cmax;
    __device__ __forceinline__ void operator()(const pg8::f32x4 (&acc)[2][2][4][2], const pg8::Unit& u, int wr, int wc, int fr, int fq) const {
        const int row0 = u.pm * 256 + wr * 64 + fr, col0 = u.pn * 256 + wc * 32 + 8 * fq;
        pg8::f32x4 cs[2][2];
        if constexpr (I8) {
#pragma unroll
            for (int bj = 0; bj < 2; ++bj)
#pragma unroll
                for (int n = 0; n < 2; ++n)
#pragma unroll
                    for (int e = 0; e < 4; ++e) cs[bj][n][e] = __uint_as_float(cmax[col0 + bj * 128 + 4 * n + e]) * (1.f / 127.f); }
        float rsv[2][4];
#pragma unroll
        for (int ai = 0; ai < 2; ++ai)
#pragma unroll
            for (int m = 0; m < 4; ++m) rsv[ai][m] = I8 ? rowsc[row0 + ai * 128 + m * 16] : 1.f;
        asm volatile("" ::: "memory");
#pragma unroll
        for (int ai = 0; ai < 2; ++ai)
#pragma unroll
            for (int m = 0; m < 4; ++m) { const int r = row0 + ai * 128 + m * 16; bf16* rowp = O + (size_t)r * ldc + col0; const float rs = rsv[ai][m];
#pragma unroll
                for (int bj = 0; bj < 2; ++bj) { pg8::f32x4 v0 = acc[ai][bj][m][0], v1 = acc[ai][bj][m][1];
                    if constexpr (I8) {
#pragma unroll
                        for (int e = 0; e < 4; ++e) { v0[e] = (float)__float_as_int(v0[e]) * (rs * cs[bj][0][e]); v1[e] = (float)__float_as_int(v1[e]) * (rs * cs[bj][1][e]); } }
                    v4u w; w.x = pg8::cvt_pk_bf16(v0[0], v0[1]); w.y = pg8::cvt_pk_bf16(v0[2], v0[3]); w.z = pg8::cvt_pk_bf16(v1[0], v1[1]); w.w = pg8::cvt_pk_bf16(v1[2], v1[3]);
                    *(v4u*)(rowp + bj * 128) = w; } }
    }
};
struct EpiBf16S {
    static constexpr bool PERM = true, AFTER_DRAIN = false; static constexpr int NST = 16;
    bf16* O; int lo; float scale;
    __device__ __forceinline__ void operator()(const pg8::f32x4 (&acc)[2][2][4][2], const pg8::Unit& u, int wr, int wc, int fr, int fq) const {
        const int row0 = (lo + u.pm) * 256 + wr * 64 + fr, col0 = (u.pn & 3) * 256 + wc * 32 + 8 * fq;
#pragma unroll
        for (int ai = 0; ai < 2; ++ai)
#pragma unroll
            for (int m = 0; m < 4; ++m) { bf16* rowp = O + (size_t)(row0 + ai * 128 + m * 16) * DM + col0;
#pragma unroll
                for (int bj = 0; bj < 2; ++bj) { const pg8::f32x4 v0 = acc[ai][bj][m][0] * scale, v1 = acc[ai][bj][m][1] * scale;
                    v4u w; w.x = pg8::cvt_pk_bf16(v0[0], v0[1]); w.y = pg8::cvt_pk_bf16(v0[2], v0[3]); w.z = pg8::cvt_pk_bf16(v1[0], v1[1]); w.w = pg8::cvt_pk_bf16(v1[2], v1[3]);
                    *(v4u*)(rowp + bj * 128) = w; } }
    }
};
template <bool XB> struct EpiResid {
    static constexpr bool PERM = true, AFTER_DRAIN = false; static constexpr int NST = 16;
    const void* X; unsigned char* R; const float* gate;
    __device__ __forceinline__ void operator()(const pg8::f32x4 (&acc)[2][2][4][2], const pg8::Unit& u, int wr, int wc, int fr, int fq) const {
        const int b = u.pm / 33, lt = u.pm - b * 33 - 1;
        const int row0 = b * TL + lt * 256 + wr * 64 + fr, col0 = u.pn * 256 + wc * 32 + 8 * fq;
        pg8::f32x4 g[2][2];
#pragma unroll
        for (int bj = 0; bj < 2; ++bj)
#pragma unroll
            for (int n = 0; n < 2; ++n) g[bj][n] = *(const pg8::f32x4*)(gate + b * 6144 + col0 + bj * 128 + 4 * n);
        constexpr int NBUF = XB ? 4 : 3;
        pg8::f32x4 xf[XB ? 1 : NBUF][2][2]; v4u xb[XB ? NBUF : 1][2];
#define ER_LOAD(buf, k) do { const size_t row_ = (size_t)(row0 + ((k) >> 2) * 128 + ((k) & 3) * 16); \
        if constexpr (XB) { _Pragma("unroll") for (int bj = 0; bj < 2; ++bj) xb[buf][bj] = *(const GAS v4u*)((const unsigned char*)X + row_ * RP + (size_t)(col0 + bj * 128) * 2); } \
        else { _Pragma("unroll") for (int bj = 0; bj < 2; ++bj) _Pragma("unroll") for (int n = 0; n < 2; ++n) xf[buf][bj][n] = *(const GAS pg8::f32x4*)((const float*)X + row_ * DM + col0 + bj * 128 + 4 * n); } } while (0)
#pragma unroll
        for (int k = 0; k < NBUF; ++k) ER_LOAD(k, k);
#pragma unroll
        for (int k = 0; k < 8; ++k) { const int ai = k >> 2, m = k & 3, cb = k % NBUF;
            unsigned char* rowp = R + (size_t)(row0 + ai * 128 + m * 16) * RP + (size_t)col0 * 2;
#pragma unroll
            for (int bj = 0; bj < 2; ++bj) { pg8::f32x4 x0, x1;
                if constexpr (XB) { const v4u w = xb[cb][bj]; x0 = (pg8::f32x4){bflo(w.x), bfhi(w.x), bflo(w.y), bfhi(w.y)}; x1 = (pg8::f32x4){bflo(w.z), bfhi(w.z), bflo(w.w), bfhi(w.w)}; }
                else { x0 = xf[cb][bj][0]; x1 = xf[cb][bj][1]; }
                const pg8::f32x4 v0 = x0 + g[bj][0] * acc[ai][bj][m][0], v1 = x1 + g[bj][1] * acc[ai][bj][m][1];
                v4u o; o.x = pg8::cvt_pk_bf16(v0[0], v0[1]); o.y = pg8::cvt_pk_bf16(v0[2], v0[3]); o.z = pg8::cvt_pk_bf16(v1[0], v1[1]); o.w = pg8::cvt_pk_bf16(v1[2], v1[3]);
                *(GAS v4u*)(rowp + bj * 256) = o; }
            if (k + NBUF < 8) ER_LOAD(cb, k + NBUF);
        }
#undef ER_LOAD
    }
};
template <int QM> struct EpiSwiGLU {
    static constexpr bool PERM = true, AFTER_DRAIN = false; static constexpr int NST = 8;
    unsigned char* O; int ldc; int pm_sub; int pn_mod;
    const float* rowsc; const gu32* cmax;
    static __device__ __forceinline__ float gu(float G, float U, float k1, float ic) {
        const float e = __builtin_amdgcn_exp2f(G * k1);
        return (G * U) * __builtin_amdgcn_rcpf(__builtin_fmaf(e, ic, ic));
    }
    __device__ __forceinline__ void operator()(const pg8::f32x4 (&acc)[2][2][4][2], const pg8::Unit& u, int wr, int wc, int fr, int fq) const {
        const int row0 = (u.pm - pm_sub) * 256 + wr * 64 + fr, col0 = (u.pn % pn_mod) * 128 + wc * 32 + 8 * fq;
        constexpr float si = QM == 1 ? 1.f / W_UP_SCALE : 1.f, so = QM == 1 ? ACT_SCALE : 1.f;
        pg8::f32x4 cs[2][2];
        if constexpr (QM == 2) {
#pragma unroll
            for (int bj = 0; bj < 2; ++bj)
#pragma unroll
                for (int n = 0; n < 2; ++n)
#pragma unroll
                    for (int e = 0; e < 4; ++e) cs[bj][n][e] = __uint_as_float(cmax[u.pn * 256 + bj * 128 + wc * 32 + 8 * fq + 4 * n + e]) * (1.f / 127.f); }
        float rsv[2][4];
#pragma unroll
        for (int ai = 0; ai < 2; ++ai)
#pragma unroll
            for (int m = 0; m < 4; ++m) rsv[ai][m] = QM == 2 ? rowsc[u.pm * 256 + wr * 64 + fr + ai * 128 + m * 16] : 1.f;
        asm volatile("" ::: "memory");
#pragma unroll
        for (int ai = 0; ai < 2; ++ai)
#pragma unroll
            for (int m = 0; m < 4; ++m) {
                pg8::f32x4 g0 = acc[ai][0][m][0], g1 = acc[ai][0][m][1], u0 = acc[ai][1][m][0], u1 = acc[ai][1][m][1];
                float k1 = -si * 1.4426950408889634f, ic = 1.f / (si * si * so);
                if constexpr (QM == 2) {
                    const float rs = rsv[ai][m]; k1 = -1.4426950408889634f; ic = 1.f;
#pragma unroll
                    for (int e = 0; e < 4; ++e) { g0[e] = (float)__float_as_int(g0[e]) * (rs * cs[0][0][e]); g1[e] = (float)__float_as_int(g1[e]) * (rs * cs[0][1][e]);
                        u0[e] = (float)__float_as_int(u0[e]) * (rs * cs[1][0][e]); u1[e] = (float)__float_as_int(u1[e]) * (rs * cs[1][1][e]); } }
                const size_t off = (size_t)(row0 + ai * 128 + m * 16) * ldc + col0;
                if constexpr (QM == 1) {
                    const unsigned lo = pk4_fp8(gu(g0[0], u0[0], k1, ic), gu(g0[1], u0[1], k1, ic), gu(g0[2], u0[2], k1, ic), gu(g0[3], u0[3], k1, ic));
                    const unsigned hi = pk4_fp8(gu(g1[0], u1[0], k1, ic), gu(g1[1], u1[1], k1, ic), gu(g1[2], u1[2], k1, ic), gu(g1[3], u1[3], k1, ic));
                    *(unsigned long long*)(O + off) = (unsigned long long)lo | ((unsigned long long)hi << 32);
                } else {
                    v4u w; w.x = pg8::cvt_pk_bf16(gu(g0[0], u0[0], k1, ic), gu(g0[1], u0[1], k1, ic)); w.y = pg8::cvt_pk_bf16(gu(g0[2], u0[2], k1, ic), gu(g0[3], u0[3], k1, ic));
                    w.z = pg8::cvt_pk_bf16(gu(g1[0], u1[0], k1, ic), gu(g1[1], u1[1], k1, ic)); w.w = pg8::cvt_pk_bf16(gu(g1[2], u1[2], k1, ic), gu(g1[3], u1[3], k1, ic));
                    *(v4u*)((bf16*)O + off) = w; }
            }
    }
};


#ifndef MK_PER_PHASE
#define MK_PER_PHASE 0
#endif
#ifndef EN_MASK
#define EN_MASK 0xFFFFFFFFu
#endif
#define EN(bit) (((EN_MASK) >> (bit)) & 1u)
#ifndef DUP_MASK
#define DUP_MASK 0u
#endif
#define DUP(bit) (((DUP_MASK) >> (bit)) & 1u)
__global__ void __launch_bounds__(NTHR, 2) mk_fwd(Args a_unused) {
    extern __shared__ __attribute__((aligned(16))) unsigned char lds[];
    Frame F;
    F.lds = (LAS unsigned char*)lds;
    F.MISC = (volatile LAS unsigned*)(F.lds + MISC_OFF);
    F.tid = threadIdx.x; F.lane = F.tid & 63; F.wave = __builtin_amdgcn_readfirstlane(F.tid >> 6);
    F.G = gridDim.x; { const int bx = blockIdx.x; F.vcu = (F.G % 8 == 0) ? (bx % 8) * (F.G / 8) + bx / 8 : bx; }
    F.gw = F.vcu * NWAVES + F.wave; F.NGW = F.G * NWAVES;
    { CAP a = args_ptr(); F.ws = (unsigned char*)(GAS unsigned char*)(unsigned long long)a->ws; F.ctl = (gu32*)(F.ws + WS_CTL); }
    for (int u = F.tid; u < (LDS_BYTES - MISC_OFF) / 4; u += NTHR) ((LAS unsigned*)(F.lds + MISC_OFF))[u] = 0u;
    __syncthreads();
    XcdBarrier bar; bar.bar = (unsigned*)(F.ctl + CW_BAR); bar.x = 0; bar.st = nullptr;
    if (!MK_PER_PHASE) bar = xcd_barrier_post((unsigned*)(F.ctl + CW_BAR), F.MISC + 8);
    int lo, hi; { CAP a = args_ptr(); lo = a->ph_lo; hi = a->ph_hi; }
#define IN(k) (lo <= (k) && (k) < hi)
#define a (args_ptr())
#define FRESH() do { int t_ = threadIdx.x; asm volatile("" : "+v"(t_)); F.tid = t_; F.lane = t_ & 63; F.wave = __builtin_amdgcn_readfirstlane(t_ >> 6); F.gw = F.vcu * NWAVES + F.wave; \
        unsigned long long w_ = (unsigned long long)args_ptr()->ws; asm volatile("" : "+s"(w_)); F.ws = (unsigned char*)(GAS unsigned char*)w_; F.ctl = (gu32*)(F.ws + WS_CTL); } while (0)
#define SEAM(k) do { if (IN(k) && IN((k) + 1)) { if (MK_PER_PHASE) { if (F.tid == 0) __hip_atomic_store(F.ctl + 0, 0xBADBA0u, RLX_AGENT); } else { xcd_barrier(bar); if (DUP(20)) xcd_barrier(bar); } } } while (0)
#define HY ((bf16*)(F.ws + WS_HY))
#define CTXRES ((float*)(F.ws + WS_CTXRES))
#define MODS ((const float*)(F.ws + WS_MODS))

    FRESH();
    if (EN(0) && IN(0)) phase_prologue(F, a);
    if (DUP(0) && IN(0)) { __syncthreads(); phase_prologue(F, a); }
    SEAM(0); FRESH();
#pragma unroll 1
    for (int L = 0; L < 2; ++L) {
        const int pb = 1 + 9 * L;
        FRESH();
        if (EN(1) && IN(pb + 0)) phase_norm1(F, a, L);
        if (DUP(1) && IN(pb + 0) && L == 0) { for (int rep = 0; rep < 4; ++rep) phase_norm1(F, a, L); }
        SEAM(pb + 0); FRESH();
        if (EN(2) && IN(pb + 1)) {
            pg8::Gemm g{P_I8 ? (const bf16*)(F.ws + WS_QN) : (const bf16*)HY, (const bf16*)(F.ws + WS_WIN + (size_t)L * NP * DM * PB_), MROWS, NP, DM * PB_ / 2, DM * PB_ / 2}; pg8::StaticOrder S; S.init(MROWS, NP, F.G, (int)blockIdx.x);
            EpiBf16R<P_I8 != 0> E{(bf16*)(F.ws + WS_P), NP, (const float*)(F.ws + WS_ROUTE + RT_ROWSC_H), F.ctl + CW_CMAX_IN + L * NP};
            pg8::gemm_phase<EpiBf16R<P_I8 != 0>, pg8::StaticOrder, true, true, P_I8 ? 2 : 0>(F.lds, g, S, E);
            if (DUP(2)) pg8::gemm_phase<EpiBf16R<P_I8 != 0>, pg8::StaticOrder, true, true, P_I8 ? 2 : 0>(F.lds, g, S, E);
            phase_gates(F, a, L);
        }
        SEAM(pb + 1); FRESH();
        if (IN(pb + 2)) { if (EN(3)) phase_qknorm(F, a, L); if (DUP(3)) { for (int rep = 0; rep < 4; ++rep) phase_qknorm(F, a, L); } if (EN(4)) phase_mlstm_local(F, a, L); if (DUP(4)) { for (int rep = 0; rep < 4; ++rep) phase_mlstm_local(F, a, L); } }
        SEAM(pb + 2); FRESH();
        if (IN(pb + 3)) { if (DUP(5)) { for (int rep = 0; rep < 4; ++rep) phase_scan<true>(F); } if (EN(5)) phase_scan<false>(F); __syncthreads(); FRESH(); if (EN(6)) phase_attn(F, a, L, (char*)lds); if (DUP(6)) phase_attn(F, a, L, (char*)lds); }
        SEAM(pb + 3); FRESH();
#ifndef MO_PRB
#define MO_PRB 0
#endif
        if (DUP(7) && IN(pb + 4)) { for (int rep = 0; rep < 4; ++rep) phase_mlstm_out<MO_PRB>(F, a, L); }
        if (EN(7) && IN(pb + 4)) phase_mlstm_out<0>(F, a, L);
        SEAM(pb + 4); FRESH();
        if (EN(8) && IN(pb + 5)) {
            pg8::Gemm g{HY, (const bf16*)(F.ws + WS_WOUT) + (size_t)L * DM * DM, MLAT, DM, DM, DM}; RowOrder S; S.init(MLAT, DM, F.G, (int)blockIdx.x); S.latent_only = 1;
            pg8::EpiBf16<0> E{(bf16*)(F.ws + WS_P), DM, nullptr, 0, 0, 1.f};
            if (L == 0) {
                EpiResid<false> ER{ain(a, 0), F.ws + WS_RESID, (const float*)(F.ws + WS_MODS) + 2 * 1024};
                pg8::gemm_phase<EpiResid<false>, RowOrder, true, true>(F.lds, g, S, ER);
            } else {
                EpiResid<true> ER{F.ws + WS_RESID, F.ws + WS_RESID, (const float*)(F.ws + WS_MODS) + 5 * 6144 + 2 * 1024};
                pg8::gemm_phase<EpiResid<true>, RowOrder, true, true>(F.lds, g, S, ER);
            }
            if (L == 0) {
                int ks_ = 256; asm volatile("" : "+s"(ks_));
                pg8::Gemm g2{HY, (const bf16*)(F.ws + WS_WOUT), TC * NB, DM, ks_, DM}; SplitOrder S2{NB, 4, NS_CW, 256, F.G, (int)blockIdx.x, 33, 0, 0, nullptr};
                EpiSlab E2{(float*)(F.ws + WS_SLAB_CW), (size_t)1024 * 1024, 256, 33, 1.f};
                pg8::gemm_phase<EpiSlab, SplitOrder, true, true>(F.lds, g2, S2, E2);
            }
            if (DUP(8)) pg8::gemm_phase<pg8::EpiBf16<0>, RowOrder, true, true>(F.lds, g, S, E);
        }
        SEAM(pb + 5); FRESH();
        if (L == 0) {
            FRESH();
            if (EN(9) && IN(7)) {
#pragma unroll 1
                for (int rep = 0; rep < (DUP(9) ? 5 : 1); ++rep) phase_norm2(F, a, 0); }
            SEAM(7); FRESH();
            if (EN(10) && IN(8)) {
                pg8::Gemm g{HY, (const bf16*)(F.ws + WS_WGU), MROWS, 2 * DFF, DM * UB / 2, DM * UB / 2}; pg8::StaticOrder S; S.init(MROWS, 2 * DFF, F.G, (int)blockIdx.x);
                EpiSwiGLU<UMODE> E{F.ws + WS_ACT0, DFF, 0, 1 << 20, (const float*)(F.ws + WS_ROUTE + RT_ROWSC), F.ctl + CW_CMAX_UP};
                pg8::gemm_phase<EpiSwiGLU<UMODE>, pg8::StaticOrder, true, true, UMODE>(F.lds, g, S, E);
                if (DUP(10)) pg8::gemm_phase<EpiSwiGLU<UMODE>, pg8::StaticOrder, true, true, UMODE>(F.lds, g, S, E);
            }
            SEAM(8); FRESH();
            if (EN(11) && IN(9)) {
                constexpr bool CSPLIT = (DENSE_FP8 == 0);
                pg8::Gemm g{(const bf16*)(F.ws + WS_ACT0), (const bf16*)(F.ws + WS_WD), CSPLIT ? MLAT : MROWS, DM, DFF * DB / 2, DFF * DB / 2}; RowOrder S; S.init(CSPLIT ? MLAT : MROWS, DM, F.G, (int)blockIdx.x); S.latent_only = CSPLIT ? 1 : 0;
                EpiBf16S E{HY, 0, DENSE_FP8 ? 1.f / (W_DN_SCALE * ACT_SCALE) : 1.f};
                static_assert(CSPLIT && DENSE_FP8 == 0, "the fused residual epilogue is written for the bf16, latent-only down GEMM");
                { EpiResid<true> ER{F.ws + WS_RESID, F.ws + WS_RESID, (const float*)(F.ws + WS_MODS) + 5 * 1024};
                  pg8::gemm_phase<EpiResid<true>, RowOrder, true, true>(F.lds, g, S, ER); }
                if (CSPLIT) {
                    int ks_ = 256; asm volatile("" : "+s"(ks_));
                    pg8::Gemm g2{(const bf16*)(F.ws + WS_ACT0), (const bf16*)(F.ws + WS_WD), TC * NB, DM, ks_, DFF}; SplitOrder S2{NB, 4, 11, 256, F.G, (int)blockIdx.x, 33, 0, 0, nullptr};
                    EpiSlab E2{(float*)(F.ws + WS_SLAB_CD), (size_t)1024 * 1024, 256, 33, 1.f};
                    pg8::gemm_phase<EpiSlab, SplitOrder, true, true>(F.lds, g2, S2, E2);
                }
                if (DUP(11)) pg8::gemm_phase<EpiBf16S, RowOrder, true, true, DENSE_FP8 != 0>(F.lds, g, S, E);
            }
            SEAM(9); FRESH();
        } else {
            FRESH();
            if (EN(12) && IN(16)) phase_norm2_route(F, a);
            if (DUP(12) && IN(16)) phase_norm2_route(F, a);
            SEAM(16); FRESH();
            if (EN(13) && IN(17)) phase_moe_sort(F, a);
            if (DUP(13) && IN(17)) phase_moe_sort(F, a);
            SEAM(17); FRESH();
            const int* INFO = (const int*)(F.ws + WS_ROUTE + RT_INFO); const int* TILEE_G = (const int*)(F.ws + WS_ROUTE + RT_TILEE);
            LAS int* TILEE = (LAS int*)(F.lds + pg8::STAGE_BYTES);
#define STAGE_TILEE() do { for (int i_ = F.tid; i_ < 272; i_ += NTHR) TILEE[i_] = TILEE_G[i_]; __syncthreads(); } while (0)
#pragma unroll 1
            for (int p = 0; p < 2; ++p) {
                FRESH();
                int tlo = 0, thi = 0;
                if (IN(18 + 2 * p) || IN(19 + 2 * p)) { const int nt = INFO[0]; tlo = 128 * p; thi = p == 1 ? nt : 128; if (thi > nt) thi = nt; if (tlo > thi) tlo = thi; }
                const int ntile = thi - tlo;
                if (EN(14) && IN(18 + 2 * p)) {
                    STAGE_TILEE();
                    pg8::Gemm g{(const bf16*)(F.ws + WS_ASORT), (const bf16*)(F.ws + WS_MGU), ntile * 256, 2 * DFE, DM / 2, DM / 2}; MoeUpOrder S; S.init(ntile * 256, 2 * DFE, F.G, (int)blockIdx.x); S.lo = tlo; S.tile_e = TILEE;
                    EpiSwiGLU<1> E{F.ws + WS_ACT1, DFE, tlo, 28, nullptr, nullptr};
                    pg8::gemm_phase<EpiSwiGLU<1>, MoeUpOrder, true, true, 1>(F.lds, g, S, E);
#ifndef PROBE_EPI
                    if (DUP(14)) pg8::gemm_phase<EpiSwiGLU<1>, MoeUpOrder, true, true, 1>(F.lds, g, S, E);
#else
                    if (DUP(14)) { EpiNull EN{F.ws + WS_ACT1, PROBE_EPI}; pg8::gemm_phase<EpiNull, MoeUpOrder, true, true, 1>(F.lds, g, S, EN); pg8::gemm_phase<EpiSwiGLU<1>, MoeUpOrder, true, true, 1>(F.lds, g, S, E); }
#endif
                }
                SEAM(18 + 2 * p); FRESH();
                if (EN(15) && IN(19 + 2 * p)) {
                    STAGE_TILEE();
                    const int nreg = ntile < PASS_TILES ? ntile : PASS_TILES, nl = ntile - nreg;
                    {
                    pg8::Gemm g{(const bf16*)(F.ws + WS_ACT1), (const bf16*)(F.ws + WS_MD), nreg * 256, DM, DFE / 2, DFE / 2}; MoeDownOrder S; S.init(nreg * 256, DM, F.G, (int)blockIdx.x); S.lo = tlo; S.tile_e = TILEE;
                    EpiBf16S E{(bf16*)(F.ws + WS_EOUT), tlo, 1.f / (W_DN_SCALE * ACT_SCALE)};
                    pg8::gemm_phase<EpiBf16S, MoeDownOrder, true, true, true>(F.lds, g, S, E);
                    }
                    if (nl > 0) {
                    pg8::Gemm g2{(const bf16*)(F.ws + WS_ACT1 + (size_t)nreg * 256 * DFE), (const bf16*)(F.ws + WS_MD), nl * 256, DM, 256, DFE / 2}; SplitOrder S2{nl, 4, NS_MT, 256, F.G, (int)blockIdx.x, 1, tlo + nreg, 4, TILEE};
                    EpiSlab E2{(float*)(F.ws + WS_SLAB_MT), (size_t)MT_TILES * 256 * 1024, 256, 1, 1.f / (W_DN_SCALE * ACT_SCALE)};
                    pg8::gemm_phase<EpiSlab, SplitOrder, true, true, true>(F.lds, g2, S2, E2);
                    }
                }
                SEAM(19 + 2 * p); FRESH();
            }
        }
    }
    FRESH();
    if (EN(16) && IN(22)) phase_final(F, a);
#undef IN
#undef SEAM
#undef a
#undef FRESH
#undef HY
#undef CTXRES
#undef MODS
}

extern "C" void kernel_launch(void* const* d_in, const int* in_sizes, int n_in, void* d_out, int out_size, void* d_ws, size_t ws_size, hipStream_t stream) {
    static int grid = 0;
    if (grid == 0) {
        if (n_in != 22 || in_sizes[0] != MLAT * DM || out_size != MLAT * DM || ws_size < WS_END) { fprintf(stderr, "kernel_launch: unexpected shapes (n_in %d, in0 %d, out %d, ws %zu); nothing launched\n", n_in, n_in > 0 ? in_sizes[0] : -1, out_size, ws_size); grid = -1; return; }
        int dev = 0, cus = 0, per_cu = 0;
        if (hipGetDevice(&dev) != hipSuccess || hipDeviceGetAttribute(&cus, hipDeviceAttributeMultiprocessorCount, dev) != hipSuccess) { grid = -1; return; }
        if (hipFuncSetAttribute((const void*)mk_fwd, hipFuncAttributeMaxDynamicSharedMemorySize, LDS_BYTES) != hipSuccess) { fprintf(stderr, "kernel_launch: hipFuncSetAttribute failed\n"); grid = -1; return; }
        if (hipOccupancyMaxActiveBlocksPerMultiprocessor(&per_cu, (const void*)mk_fwd, NTHR, LDS_BYTES) != hipSuccess || per_cu < 1) { fprintf(stderr, "kernel_launch: occupancy query says %d\n", per_cu); }
        (void)hipGetLastError();
        grid = cus;
    }
    if (grid < 0) return;
    if (hipMemsetAsync((char*)d_ws + WS_CTL, 0, CTL_ZERO_BYTES, stream) != hipSuccess) return;
    Args ha{};
    for (int i = 0; i < 22; ++i) ha.in[i] = (const float*)d_in[i];
    ha.out = (float*)d_out; ha.ws = (unsigned char*)d_ws; ha.li = 0; ha.pad = 0;
#if MK_PER_PHASE
    for (int k = 0; k < N_PHASES; ++k) { ha.ph_lo = k; ha.ph_hi = k + 1; hipLaunchKernelGGL(mk_fwd, dim3(grid), dim3(NTHR), LDS_BYTES, stream, ha); }
#else
    ha.ph_lo = 0; ha.ph_hi = N_PHASES;
    hipLaunchKernelGGL(mk_fwd, dim3(grid), dim3(NTHR), LDS_BYTES, stream, ha);
#endif
    (void)hipPeekAtLastError();
}
```

```cpp
#include <hip/hip_runtime.h>
#include <hip/hip_bf16.h>
#include <cstdio>
#include <cstdint>
#include <cmath>
namespace pg8 {
#define PG8_LAS __attribute__((address_space(3)))
typedef unsigned short bf16_t;
typedef short bf16x8 __attribute__((ext_vector_type(8)));
typedef float f32x4 __attribute__((ext_vector_type(4)));
typedef unsigned u32x4 __attribute__((ext_vector_type(4)));
typedef int i32x4_t __attribute__((ext_vector_type(4)));
typedef int i32x8_t __attribute__((ext_vector_type(8)));
constexpr int BM = 256, BK = 64, HALF = 128, HTB = HALF * BK * 2  , STAGE_BYTES = 8 * HTB, NXCD = 8, WGM = 8;

__host__ __device__ __forceinline__ int lds_byte(int r, int c) { const int st = (r >> 4) * 2 + (c >> 5), rr = r & 15, cc = c & 31, ob = rr * 64 + cc * 2; return st * 1024 + (ob ^ (((ob >> 9) & 1) << 5)); }
__host__ __device__ __forceinline__ void stage_rc(int b, int& R, int& C) { const int st = b / 1024, sb = b % 1024, swz = sb ^ (((sb >> 9) & 1) << 5); R = (st >> 1) * 16 + swz / 64; C = (st & 1) * 32 + (swz % 64) / 2; }
__host__ __device__ __forceinline__ int perm32(int rho) { const int n = rho >> 4, i = rho & 15; return 8 * (i >> 2) + 4 * n + (i & 3); }

struct Unit { int pm, pn, ko; };
struct Gemm { const bf16_t* A; const bf16_t* Bt; int M, N, K, ld; };

struct StaticOrder {
    int nM, nN, nwg, G, c;
    __host__ __device__ void init(int M, int N, int G_, int c_) { nM = M / BM; nN = N / BM; nwg = nM * nN; G = G_; c = c_; }
    __host__ __device__ bool next(int i, Unit& u) const {
        const long L = (long)i * G + c; if (L >= nwg) return false;
        int wgid = (int)L; { const int q = nwg / NXCD, r = nwg % NXCD, xcd = wgid % NXCD, off = wgid / NXCD; wgid = (xcd < r ? xcd * (q + 1) : r * (q + 1) + (xcd - r) * q) + off; }
        const int nig = WGM * nN, gid = wgid / nig, fm = gid * WGM, gsz = (nM - fm) < WGM ? (nM - fm) : WGM;
        u.pm = fm + ((wgid % nig) % gsz); u.pn = (wgid % nig) / gsz; u.ko = 0; return true;
    }
    __device__ __forceinline__ void a_ready(const Unit&) const {}
    __device__ __forceinline__ void done(const Unit&) const {}
};

__device__ __forceinline__ unsigned cvt_pk_bf16(float lo, float hi) { unsigned r; asm volatile("v_cvt_pk_bf16_f32 %0, %1, %2" : "=v"(r) : "v"(lo), "v"(hi)); return r; }
typedef float f32x2 __attribute__((ext_vector_type(2)));
__device__ __forceinline__ f32x2 gelu_pk(f32x2 v) {
    const f32x2 av = __builtin_elementwise_abs(v), d = av * 0.2316418882f + 1.0f;
    f32x2 t; t.x = __builtin_amdgcn_rcpf(d.x); t.y = __builtin_amdgcn_rcpf(d.y);
    f32x2 q = t * 0.5307027145f + (-0.7265760135f); q = q * t + 0.7107068705f; q = q * t + (-0.142248368f); q = q * t + 0.127414796f; q = q * t;
    const f32x2 s = (v * v) * (-0.72134752044f);
    f32x2 e; e.x = __builtin_amdgcn_exp2f(s.x); e.y = __builtin_amdgcn_exp2f(s.y);
    const f32x2 m = v * (q * e), r = v - m;
    f32x2 o; o.x = v.x < 0.f ? m.x : r.x; o.y = v.y < 0.f ? m.y : r.y; return o;
}

template <int ACT  > struct EpiBf16 {
    static constexpr bool PERM = true, AFTER_DRAIN = false; static_assert(ACT == 0 || ACT == 1, "EpiBf16: ACT is 0 (none) or 1 (gelu_pk)");
    bf16_t* O; int ldc; const float* bias; int split_cols; size_t split_stride; float scale0;
    __device__ __forceinline__ void operator()(const f32x4 (&acc)[2][2][4][2], const Unit& u, int wr, int wc, int fr, int fq) const {
        const int row0 = u.pm * BM + wr * 64 + fr; int colt = u.pn * BM; bf16_t* base = O;
        float sc = 1.f; if (split_cols) { const int t = colt / split_cols; base += (size_t)t * split_stride; colt -= t * split_cols; if (t == 0) sc = scale0; }
        const int col0 = colt + wc * 32 + 8 * fq, bcol0 = u.pn * BM + wc * 32 + 8 * fq;
        f32x4 bv[2][2];
#pragma unroll
        for (int bj = 0; bj < 2; ++bj)
#pragma unroll
            for (int n = 0; n < 2; ++n) bv[bj][n] = bias ? *(const f32x4*)(bias + bcol0 + bj * HALF + 4 * n) : (f32x4){0.f, 0.f, 0.f, 0.f};
#pragma unroll
        for (int ai = 0; ai < 2; ++ai)
#pragma unroll
            for (int m = 0; m < 4; ++m) { bf16_t* rowp = base + (size_t)(row0 + ai * HALF + m * 16) * ldc + col0;
#pragma unroll
                for (int bj = 0; bj < 2; ++bj) { f32x4 v0 = acc[ai][bj][m][0] + bv[bj][0], v1 = acc[ai][bj][m][1] + bv[bj][1];
                    if (ACT == 1) { f32x2 a = gelu_pk((f32x2){v0[0], v0[1]}), b = gelu_pk((f32x2){v0[2], v0[3]}), c = gelu_pk((f32x2){v1[0], v1[1]}), d = gelu_pk((f32x2){v1[2], v1[3]});
                        v0 = (f32x4){a.x, a.y, b.x, b.y}; v1 = (f32x4){c.x, c.y, d.x, d.y}; }
                    v0 = v0 * sc; v1 = v1 * sc; u32x4 w; w.x = cvt_pk_bf16(v0[0], v0[1]); w.y = cvt_pk_bf16(v0[2], v0[3]); w.z = cvt_pk_bf16(v1[0], v1[1]); w.w = cvt_pk_bf16(v1[2], v1[3]);
                    *(u32x4*)(rowp + bj * HALF) = w; } }
    }
};

struct PanelStats {
    unsigned* xbuf;
    unsigned* cnt;
    unsigned* tmo;
    int ntn; float eps;
    unsigned code;
    __device__ __forceinline__ bool run(const f32x4 (&v)[2][2][4][2], const Unit& u, int wr, int wc, int fr, int fq, PG8_LAS unsigned char* lds, int wid, int lane) const {
        typedef float f32x2v __attribute__((ext_vector_type(2)));
        PG8_LAS f32x2v* P = (PG8_LAS f32x2v*)lds;
        PG8_LAS f32x2v* S = (PG8_LAS f32x2v*)(lds + 8192);
        PG8_LAS unsigned* flag = (PG8_LAS unsigned*)(lds + 8192 + 2048);
#pragma unroll
        for (int ai = 0; ai < 2; ++ai)
#pragma unroll
            for (int m = 0; m < 4; ++m) {
                float s = 0.f;
#pragma unroll
                for (int bj = 0; bj < 2; ++bj)
#pragma unroll
                    for (int n = 0; n < 2; ++n) { const f32x4 x = v[ai][bj][m][n]; s += (x[0] + x[1]) + (x[2] + x[3]); }
                s += __shfl_xor(s, 16); s += __shfl_xor(s, 32);
                const float mw = s * (1.0f / 64.0f); float q = 0.f;
#pragma unroll
                for (int bj = 0; bj < 2; ++bj)
#pragma unroll
                    for (int n = 0; n < 2; ++n) { const f32x4 d = v[ai][bj][m][n] - mw; q += (d[0] * d[0] + d[1] * d[1]) + (d[2] * d[2] + d[3] * d[3]); }
                q += __shfl_xor(q, 16); q += __shfl_xor(q, 32);
                if (fq == 0) P[(ai * HALF + wr * 64 + m * 16 + fr) * 4 + wc] = (f32x2v){mw, q};
            }
        asm volatile("s_waitcnt lgkmcnt(0)" ::: "memory"); __builtin_amdgcn_s_barrier(); asm volatile("" ::: "memory");
#if defined(BROKEN_EXCHANGE_NO_WAIT)
#warning BROKEN CONTROL BUILD: the row-statistics exchange does not wait; results are wrong by design
        if (blockIdx.x >= 64) { const long long t0_ = clock64(); while (clock64() - t0_ < 60000) __builtin_amdgcn_s_sleep(8); }
#endif
        const int row = wid * 32 + (lane & 31);
        if (lane < 32) {
            const f32x2v a = P[row * 4 + 0], b = P[row * 4 + 1], c = P[row * 4 + 2], d = P[row * 4 + 3];
            const float mt = (a.x + b.x + c.x + d.x) * 0.25f;
            const float da = a.x - mt, db = b.x - mt, dc = c.x - mt, dd = d.x - mt;
            const float m2 = (a.y + b.y) + (c.y + d.y) + 64.0f * ((da * da + db * db) + (dc * dc + dd * dd));
            unsigned long long* slot = (unsigned long long*)xbuf + ((size_t)(u.pm * BM + row) * 4 + u.pn);
            __hip_atomic_store(slot, ((unsigned long long)__float_as_uint(m2) << 32) | __float_as_uint(mt), __ATOMIC_RELAXED, __HIP_MEMORY_SCOPE_AGENT);
        }
        asm volatile("s_waitcnt vmcnt(0)" ::: "memory");
        if (lane == 0) __hip_atomic_fetch_add(cnt + 64 * u.pm, 1u, __ATOMIC_RELAXED, __HIP_MEMORY_SCOPE_AGENT);
        if (wid == 0) {
            bool dead = false; const unsigned long long t0 = __builtin_amdgcn_s_memrealtime(); const unsigned want = 8u * (unsigned)ntn;
            for (;;) {
#if defined(BROKEN_EXCHANGE_NO_WAIT)
                break;
#endif
                if ((unsigned)__builtin_amdgcn_readfirstlane(__hip_atomic_load(cnt + 64 * u.pm, __ATOMIC_RELAXED, __HIP_MEMORY_SCOPE_AGENT)) >= want) break;
                if (__builtin_amdgcn_s_memrealtime() - t0 > 2000000ull) {
                    if (lane == 0) { unsigned expect = 0u; __hip_atomic_compare_exchange_strong(tmo + 1, &expect, code | (unsigned)(u.pm & 0xff), __ATOMIC_RELAXED, __ATOMIC_RELAXED, __HIP_MEMORY_SCOPE_AGENT);
                                     __hip_atomic_store(tmo, 1u, __ATOMIC_RELAXED, __HIP_MEMORY_SCOPE_AGENT); }
                    dead = true; break; }
                __builtin_amdgcn_s_sleep(2);
            }
            __builtin_amdgcn_fence(__ATOMIC_ACQUIRE, "agent");
            if (lane == 0) flag[0] = dead ? 1u : 0u;
        }
        asm volatile("s_waitcnt vmcnt(0) lgkmcnt(0)" ::: "memory"); __builtin_amdgcn_s_barrier(); asm volatile("" ::: "memory");
        const bool bad = flag[0] != 0u;
        if (lane < 32) {
            const unsigned long long* slot = (const unsigned long long*)xbuf + (size_t)(u.pm * BM + row) * 4; float mt[4], m2[4]; float ms = 0.f;
#pragma unroll
            for (int t = 0; t < 4; ++t) { if (t < ntn) { const unsigned long long w = __hip_atomic_load(slot + t, __ATOMIC_RELAXED, __HIP_MEMORY_SCOPE_AGENT); mt[t] = __uint_as_float((unsigned)w); m2[t] = __uint_as_float((unsigned)(w >> 32)); } else { mt[t] = 0.f; m2[t] = 0.f; } ms += mt[t]; }
            const float mean = ms / (float)ntn; float q = 0.f;
#pragma unroll
            for (int t = 0; t < 4; ++t) if (t < ntn) { const float dm = mt[t] - mean; q += m2[t] + 256.0f * dm * dm; }
            S[row] = (f32x2v){mean, 1.0f / sqrtf(q / (256.0f * (float)ntn) + eps)};
        }
        asm volatile("s_waitcnt lgkmcnt(0)" ::: "memory"); __builtin_amdgcn_s_barrier(); asm volatile("" ::: "memory");
        return bad;
    }
};
struct EpiLnRes {
    static constexpr bool PERM = false, AFTER_DRAIN = true;
    const float* base; float* out; int ldc; const float* bias; PanelStats st; unsigned poison;
    __device__ __forceinline__ void fused(f32x4 (&acc)[2][2][4][2], const Unit& u, int wr, int wc, int fr, int fq, PG8_LAS unsigned char* lds, int wid, int lane) const {
        typedef float f32x2v __attribute__((ext_vector_type(2)));
        const PG8_LAS f32x2v* S = (const PG8_LAS f32x2v*)(lds + 8192);
        const int col0 = u.pn * BM + wc * 32 + 4 * fq;
#pragma unroll
        for (int bj = 0; bj < 2; ++bj)
#pragma unroll
            for (int n = 0; n < 2; ++n) { const f32x4 bv = bias ? *(const f32x4*)(bias + col0 + bj * HALF + n * 16) : (f32x4){0.f, 0.f, 0.f, 0.f};
#pragma unroll
                for (int ai = 0; ai < 2; ++ai)
#pragma unroll
                    for (int m = 0; m < 4; ++m) acc[ai][bj][m][n] += bv; }
        f32x4 pre[4][2][2];
#pragma unroll
        for (int m = 0; m < 4; ++m) { const size_t off = (size_t)(u.pm * BM + wr * 64 + m * 16 + fr) * ldc + col0;
#pragma unroll
            for (int bj = 0; bj < 2; ++bj)
#pragma unroll
                for (int n = 0; n < 2; ++n) pre[m][bj][n] = *(const f32x4*)(base + off + bj * HALF + n * 16); }
        const bool bad = st.run(acc, u, wr, wc, fr, fq, lds, wid, lane) || poison != 0u;
        const float qnan = __builtin_nanf("");
#pragma unroll
        for (int ai = 0; ai < 2; ++ai)
#pragma unroll
            for (int m = 0; m < 4; ++m) { const int r = ai * HALF + wr * 64 + m * 16 + fr; const f32x2v sr = S[r]; const size_t off = (size_t)(u.pm * BM + r) * ldc + col0;
#pragma unroll
                for (int bj = 0; bj < 2; ++bj)
#pragma unroll
                    for (int n = 0; n < 2; ++n) { const f32x4 bs = ai == 0 ? pre[m][bj][n] : *(const f32x4*)(base + off + bj * HALF + n * 16); f32x4 o = bs + (acc[ai][bj][m][n] - sr.x) * sr.y;
                        if (bad) o = (f32x4){qnan, qnan, qnan, qnan}; *(f32x4*)(out + off + bj * HALF + n * 16) = o; }
                if (m & 1) asm volatile("" ::: "memory"); }
    }
};
struct EpiLnResLn {
    static constexpr bool PERM = false, AFTER_DRAIN = true;
    const float* base; float* out; bf16_t* xn; int ldc; const float* bias; PanelStats st1, st2; unsigned poison;
    __device__ __forceinline__ void fused(f32x4 (&acc)[2][2][4][2], const Unit& u, int wr, int wc, int fr, int fq, PG8_LAS unsigned char* lds, int wid, int lane) const {
        typedef float f32x2v __attribute__((ext_vector_type(2))); typedef unsigned u32x2v __attribute__((ext_vector_type(2)));
        const PG8_LAS f32x2v* S = (const PG8_LAS f32x2v*)(lds + 8192);
        const int col0 = u.pn * BM + wc * 32 + 4 * fq;
#pragma unroll
        for (int bj = 0; bj < 2; ++bj)
#pragma unroll
            for (int n = 0; n < 2; ++n) { const f32x4 bv = bias ? *(const f32x4*)(bias + col0 + bj * HALF + n * 16) : (f32x4){0.f, 0.f, 0.f, 0.f};
#pragma unroll
                for (int ai = 0; ai < 2; ++ai)
#pragma unroll
                    for (int m = 0; m < 4; ++m) acc[ai][bj][m][n] += bv; }
        bool bad = st1.run(acc, u, wr, wc, fr, fq, lds, wid, lane) || poison != 0u;
        const float qnan = __builtin_nanf("");
#pragma unroll
        for (int ai = 0; ai < 2; ++ai)
#pragma unroll
            for (int m = 0; m < 4; ++m) { const int r = ai * HALF + wr * 64 + m * 16 + fr; const f32x2v sr = S[r]; const size_t off = (size_t)(u.pm * BM + r) * ldc + col0;
#pragma unroll
                for (int bj = 0; bj < 2; ++bj)
#pragma unroll
                    for (int n = 0; n < 2; ++n) { const f32x4 bs = *(const f32x4*)(base + off + bj * HALF + n * 16); acc[ai][bj][m][n] = bs + (acc[ai][bj][m][n] - sr.x) * sr.y; }
                asm volatile("" : "+v"(acc[ai][0][m][0]), "+v"(acc[ai][0][m][1]), "+v"(acc[ai][1][m][0]), "+v"(acc[ai][1][m][1]));
                if (m & 1) asm volatile("" ::: "memory"); }
        const bool bad1 = bad;
        bad = st2.run(acc, u, wr, wc, fr, fq, lds, wid, lane) || bad;
#pragma unroll
        for (int ai = 0; ai < 2; ++ai)
#pragma unroll
            for (int m = 0; m < 4; ++m) { const int r = ai * HALF + wr * 64 + m * 16 + fr; const f32x2v sr = S[r]; const size_t off = (size_t)(u.pm * BM + r) * ldc + col0;
#pragma unroll
                for (int bj = 0; bj < 2; ++bj)
#pragma unroll
                    for (int n = 0; n < 2; ++n) { const f32x4 x1 = acc[ai][bj][m][n]; *(f32x4*)(out + off + bj * HALF + n * 16) = bad1 ? (f32x4){qnan, qnan, qnan, qnan} : x1;
                        const f32x4 o = (x1 - sr.x) * sr.y; u32x2v w; w.x = cvt_pk_bf16(o[0], o[1]); w.y = cvt_pk_bf16(o[2], o[3]);
                        if (bad) { w.x = 0x7fc07fc0u; w.y = 0x7fc07fc0u; } *(u32x2v*)(xn + off + bj * HALF + n * 16) = w; }
                asm volatile("" ::: "memory"); }
    }
};

template <class Epi, class Sched, bool ALIGN_EPI = false, bool SP2 = false, int MODE = 0  >
__device__ __forceinline__ void gemm_phase(PG8_LAS unsigned char* lds, const Gemm g, const Sched& S, const Epi& E) {
    int tid_ = threadIdx.x; asm volatile("" : "+v"(tid_));
    const int tid = tid_, wid = __builtin_amdgcn_readfirstlane(tid >> 6), lane = tid & 63, wr = wid >> 2, wc = wid & 3, fr = lane & 15, fq = lane >> 4;
    const int K = g.ld, nt = g.K / BK;
    unsigned voffA[2], voffB[2];
#pragma unroll
    for (int i = 0; i < 2; ++i) { int R, C; stage_rc(tid * 16 + i * 8192, R, C); const int Rb = Epi::PERM ? ((R & ~31) + perm32(R & 31)) : R;
        voffA[i] = (unsigned)(R * K + C) * 2u; voffB[i] = (unsigned)(Rb * K + C) * 2u; }
    const size_t kstep = (size_t)(BK * 2);
    const size_t hstep = (size_t)HALF * K * 2;
    const size_t tstep = 2 * hstep;
    const unsigned ldsw = (unsigned)wid * 1024u;
    const int aoff = lds_byte(wr * 64 + fr, fq * 8), boff = lds_byte(wc * 32 + fr, fq * 8);
#define PG8_SA(b, h) (((b) * 2 + (h)) * HTB)
#define PG8_SB(b, h) ((4 + (b) * 2 + (h)) * HTB)
#define PG8_STAGE(bufoff, gbase, voff) do { _Pragma("unroll") for (int _i = 0; _i < 2; ++_i) \
        __builtin_amdgcn_global_load_lds((const unsigned*)((const char*)(gbase) + (voff)[_i]), (PG8_LAS unsigned*)(lds + (bufoff) + ldsw + _i * 8192), 16, 0, 0); } while (0)
#define PG8_LDA(dst, b, h) do { _Pragma("unroll") for (int m = 0; m < 4; ++m) dst[m] = PG8_CAT(*(const PG8_LAS bf16x8*)(lds + PG8_SA(b, h) + aoff + m * 2048), *(const PG8_LAS bf16x8*)(lds + PG8_SA(b, h) + aoff + m * 2048 + 1024)); } while (0)
#define PG8_LDB(dst, b, h) do { _Pragma("unroll") for (int n = 0; n < 2; ++n) dst[n] = PG8_CAT(*(const PG8_LAS bf16x8*)(lds + PG8_SB(b, h) + boff + n * 2048), *(const PG8_LAS bf16x8*)(lds + PG8_SB(b, h) + boff + n * 2048 + 1024)); } while (0)
#define PG8_CAT(lo, hi) __builtin_shufflevector(__builtin_bit_cast(i32x4_t, lo), __builtin_bit_cast(i32x4_t, hi), 0, 1, 2, 3, 4, 5, 6, 7)
#define PG8_LO(x) __builtin_bit_cast(bf16x8, __builtin_shufflevector(x, x, 0, 1, 2, 3))
#define PG8_HI(x) __builtin_bit_cast(bf16x8, __builtin_shufflevector(x, x, 4, 5, 6, 7))
#define PG8_MMA(ai, bj, At, Bt) do { __builtin_amdgcn_s_setprio(1); _Pragma("unroll") for (int m = 0; m < 4; ++m) _Pragma("unroll") for (int n = 0; n < 2; ++n) { \
        if constexpr (MODE == 1) asm volatile("v_mfma_scale_f32_16x16x128_f8f6f4 %0, %1, %2, %0, %3, %3 op_sel_hi:[0,0,0]" : "+v"(acc[ai][bj][m][n]) : "v"(Bt[n]), "v"(At[m]), "v"(sc1)); \
        else if constexpr (MODE == 2) { asm volatile("v_mfma_i32_16x16x64_i8 %0, %1, %2, %0" : "+v"(acc[ai][bj][m][n]) : "v"(PG8_LO(Bt[n])), "v"(PG8_LO(At[m]))); \
               asm volatile("v_mfma_i32_16x16x64_i8 %0, %1, %2, %0" : "+v"(acc[ai][bj][m][n]) : "v"(PG8_HI(Bt[n])), "v"(PG8_HI(At[m]))); } \
        else { acc[ai][bj][m][n] = __builtin_amdgcn_mfma_f32_16x16x32_bf16(PG8_LO(Bt[n]), PG8_LO(At[m]), acc[ai][bj][m][n], 0, 0, 0); \
               acc[ai][bj][m][n] = __builtin_amdgcn_mfma_f32_16x16x32_bf16(PG8_HI(Bt[n]), PG8_HI(At[m]), acc[ai][bj][m][n], 0, 0, 0); } } __builtin_amdgcn_s_setprio(0); } while (0)
#define PG8_WAIT_V(n) asm volatile("s_waitcnt vmcnt(" #n ")" ::: "memory")
#define PG8_WAIT_L(n) asm volatile("s_waitcnt lgkmcnt(" #n ")" ::: "memory")
#define PG8_BAR __builtin_amdgcn_s_barrier()
#define PG8_SCHED __builtin_amdgcn_sched_barrier(0)
    Unit cur, nxt; int ui = 0;
    if (!S.next(0, cur)) return;
    f32x4 acc[2][2][4][2];
#pragma unroll
    for (int a = 0; a < 2; ++a)
#pragma unroll
        for (int b = 0; b < 2; ++b)
#pragma unroll
            for (int m = 0; m < 4; ++m)
#pragma unroll
                for (int n = 0; n < 2; ++n) acc[a][b][m][n] = (f32x4){0.f, 0.f, 0.f, 0.f};
    const int sc1 = 0x7F7F7F7F;
    i32x8_t At[4], B0[2], B1[2];
    const char* cA = (const char*)g.A + (size_t)cur.pm * tstep + (size_t)cur.ko * 2; const char* cB = (const char*)g.Bt + (size_t)cur.pn * tstep + (size_t)cur.ko * 2;
    S.a_ready(cur);
    if constexpr (SP2) {
        PG8_STAGE(PG8_SB(0, 0), cB, voffB); PG8_STAGE(PG8_SB(0, 1), cB + hstep, voffB); PG8_STAGE(PG8_SA(0, 0), cA, voffA); PG8_STAGE(PG8_SA(0, 1), cA + hstep, voffA);
        if (wr == 1) PG8_BAR;
        PG8_WAIT_V(2); PG8_BAR;
        PG8_STAGE(PG8_SB(1, 0), cB + kstep, voffB); PG8_STAGE(PG8_SA(1, 0), cA + kstep, voffA); PG8_STAGE(PG8_SB(1, 1), cB + hstep + kstep, voffB);
        PG8_WAIT_V(6); PG8_BAR;
    } else {
        PG8_STAGE(PG8_SB(0, 0), cB, voffB); PG8_STAGE(PG8_SA(0, 0), cA, voffA); PG8_STAGE(PG8_SB(0, 1), cB + hstep, voffB); PG8_STAGE(PG8_SA(0, 1), cA + hstep, voffA);
        if (wr == 1) PG8_BAR;
        PG8_WAIT_V(4); PG8_BAR;
        PG8_STAGE(PG8_SB(1, 0), cB + kstep, voffB); PG8_STAGE(PG8_SA(1, 0), cA + kstep, voffA); PG8_STAGE(PG8_SB(1, 1), cB + hstep + kstep, voffB);
        PG8_WAIT_V(6); PG8_BAR;
    }
    for (;;) {
        const bool has_next = S.next(ui + 1, nxt);
        const char* nA = has_next ? (const char*)g.A + (size_t)nxt.pm * tstep + (size_t)nxt.ko * 2 : cA; const char* nB = has_next ? (const char*)g.Bt + (size_t)nxt.pn * tstep + (size_t)nxt.ko * 2 : cB;
        for (int t = 0; t < nt; t += 2) {
            const bool last = (t == nt - 2);
            const char* a1 = cA + (size_t)(t + 1) * kstep;
            const char* a2 = last ? nA : cA + (size_t)(t + 2) * kstep; const char* b2 = last ? nB : cB + (size_t)(t + 2) * kstep;
            const char* a3 = a2 + kstep; const char* b3 = b2 + kstep;
            if (last && has_next) S.a_ready(nxt);
            if constexpr (SP2) {
            PG8_LDB(B0, 0, 0); PG8_LDB(B1, 0, 1); PG8_SCHED; PG8_LDA(At, 0, 0); PG8_STAGE(PG8_SA(1, 1), a1 + hstep, voffA);
            PG8_WAIT_V(8); PG8_WAIT_L(0); PG8_BAR; PG8_MMA(0, 0, At, B0); PG8_MMA(0, 1, At, B1); PG8_BAR; PG8_SCHED;
            PG8_LDA(At, 0, 1); PG8_STAGE(PG8_SB(0, 0), b2, voffB); PG8_STAGE(PG8_SB(0, 1), b2 + hstep, voffB); PG8_STAGE(PG8_SA(0, 0), a2, voffA);
            PG8_WAIT_V(8); PG8_WAIT_L(0); PG8_BAR; PG8_MMA(1, 0, At, B0); PG8_MMA(1, 1, At, B1); PG8_BAR; PG8_SCHED;
            PG8_LDB(B0, 1, 0); PG8_LDB(B1, 1, 1); PG8_SCHED; PG8_LDA(At, 1, 0); PG8_STAGE(PG8_SA(0, 1), a2 + hstep, voffA);
            PG8_WAIT_V(8); PG8_WAIT_L(0); PG8_BAR; PG8_MMA(0, 0, At, B0); PG8_MMA(0, 1, At, B1); PG8_BAR; PG8_SCHED;
            PG8_LDA(At, 1, 1); PG8_STAGE(PG8_SB(1, 0), b3, voffB); PG8_STAGE(PG8_SB(1, 1), b3 + hstep, voffB); PG8_STAGE(PG8_SA(1, 0), a3, voffA);
            PG8_WAIT_V(8); PG8_WAIT_L(0); PG8_BAR; PG8_MMA(1, 0, At, B0); PG8_MMA(1, 1, At, B1); PG8_BAR; PG8_SCHED;
            } else {
            PG8_LDB(B0, 0, 0); PG8_SCHED; PG8_LDA(At, 0, 0); PG8_STAGE(PG8_SA(1, 1), a1 + hstep, voffA);
            PG8_WAIT_L(8); PG8_BAR; PG8_WAIT_L(0); PG8_MMA(0, 0, At, B0); PG8_BAR; PG8_SCHED;
            PG8_LDB(B1, 0, 1); PG8_STAGE(PG8_SB(0, 0), b2, voffB);
            PG8_BAR; PG8_WAIT_L(0); PG8_MMA(0, 1, At, B1); PG8_BAR;
            PG8_LDA(At, 0, 1); PG8_STAGE(PG8_SA(0, 0), a2, voffA);
            PG8_BAR; PG8_WAIT_L(0); PG8_MMA(1, 0, At, B0); PG8_BAR; PG8_SCHED;
            PG8_STAGE(PG8_SB(0, 1), b2 + hstep, voffB);
            PG8_WAIT_V(6); PG8_BAR; PG8_MMA(1, 1, At, B1); PG8_BAR;
            PG8_LDB(B0, 1, 0); PG8_SCHED; PG8_LDA(At, 1, 0); PG8_STAGE(PG8_SA(0, 1), a2 + hstep, voffA);
            PG8_WAIT_L(8); PG8_BAR; PG8_WAIT_L(0); PG8_MMA(0, 0, At, B0); PG8_BAR; PG8_SCHED;
            PG8_LDB(B1, 1, 1); PG8_STAGE(PG8_SB(1, 0), b3, voffB);
            PG8_BAR; PG8_WAIT_L(0); PG8_MMA(0, 1, At, B1); PG8_BAR;
            PG8_LDA(At, 1, 1); PG8_STAGE(PG8_SA(1, 0), a3, voffA);
            PG8_BAR; PG8_WAIT_L(0); PG8_MMA(1, 0, At, B0); PG8_BAR; PG8_SCHED;
            PG8_STAGE(PG8_SB(1, 1), b3 + hstep, voffB);
            PG8_WAIT_V(6); PG8_BAR; PG8_MMA(1, 1, At, B1); PG8_BAR;
            }
        }
        if constexpr (MODE != 0) asm volatile("s_nop 15\n\ts_nop 7" ::: "memory");
        if constexpr (ALIGN_EPI) { if (wr == 0) PG8_BAR; }
        if constexpr (!Epi::AFTER_DRAIN) { E(acc, cur, wr, wc, fr, fq); S.done(cur); }
        if (!has_next) break;
#pragma unroll
        for (int a = 0; a < 2; ++a)
#pragma unroll
            for (int b = 0; b < 2; ++b)
#pragma unroll
                for (int m = 0; m < 4; ++m)
#pragma unroll
                    for (int n = 0; n < 2; ++n) { double z0_, z1_; asm volatile("v_mov_b64 %0, 0\n\tv_mov_b64 %1, 0" : "=v"(z0_), "=v"(z1_));
                    typedef double f64x2z __attribute__((ext_vector_type(2))); acc[a][b][m][n] = __builtin_bit_cast(f32x4, (f64x2z){z0_, z1_}); }
        cur = nxt; cA = nA; cB = nB; ++ui;
        if constexpr (ALIGN_EPI) { if (wr == 1) PG8_BAR; }
    }
    PG8_WAIT_V(0);
    if constexpr (!ALIGN_EPI) { if (wr == 0) PG8_BAR; }
    PG8_BAR;
    if constexpr (Epi::AFTER_DRAIN) { E.fused(acc, cur, wr, wc, fr, fq, lds, wid, lane); S.done(cur); }
#undef PG8_SA
#undef PG8_SB
#undef PG8_STAGE
#undef PG8_LDA
#undef PG8_LDB
#undef PG8_MMA
#undef PG8_CAT
#undef PG8_LO
#undef PG8_HI
#undef PG8_WAIT_V
#undef PG8_WAIT_L
#undef PG8_BAR
#undef PG8_SCHED
}
}
namespace attn_body {
using bf16=__hip_bfloat16;
using bf16x8=__attribute__((ext_vector_type(8)))short;
using s16x4=__attribute__((ext_vector_type(4)))short;
using f32x16=__attribute__((ext_vector_type(16)))float;
using u32x4=__attribute__((ext_vector_type(4)))unsigned;
constexpr int D=64;
constexpr int NW=8,QBLK=32,QB=QBLK*NW,KVBLK=64;
constexpr int QP=512,KP=128,VP=2304,OP=1024,QPR=2304;
constexpr int ATTN_UNIT_ROWS=QB;
__device__ __forceinline__ int crow(int r,int hi){return (r&3)+8*(r>>2)+4*hi;}
#define SBAR() __builtin_amdgcn_sched_barrier(0)
__device__ __forceinline__ void cmask(f32x16&p0,f32x16&p1,int jb,int qrel,int hi){
  const float NEG=-INFINITY; int kb=64*jb+4*hi;
  #pragma unroll
  for(int r=0;r<16;++r){int kv=kb+(r&3)+8*(r>>2); if(kv>qrel)p0[r]=NEG; if(kv+32>qrel)p1[r]=NEG;}
}

constexpr int NSLOT=3, SLOTB=8192;
constexpr int LDS_K=0, LDS_V=NSLOT*SLOTB, LDS_WS=2*NSLOT*SLOTB, LDS_OST=LDS_WS+NW*64*4, LDS_BYTES=LDS_OST+NW*4096;
constexpr float C2=0.125f*1.4426950408889634f;
__device__ __forceinline__ void glds16(const void*gsrc,unsigned lds_dst){unsigned keep;
  asm volatile("s_mov_b32 %0, m0\n\ts_mov_b32 m0, %2\n\ts_nop 0\n\tglobal_load_lds_dwordx4 %1, off\n\ts_mov_b32 m0, %0":"=&s"(keep):"v"(gsrc),"s"(lds_dst):"memory");}
__device__ __forceinline__ float max3f(float a,float b,float c){float r;asm("v_max3_f32 %0, %1, %2, %3":"=v"(r):"v"(a),"v"(b),"v"(c));return r;}
__device__ __forceinline__ float max2f(float a,float b){float r;asm("v_max_f32_e32 %0, %1, %2":"=v"(r):"v"(a),"v"(b));return r;}
__device__ __forceinline__ float fadd_s(float a,float b){float r;asm("v_add_f32_e32 %0, %1, %2":"=v"(r):"v"(a),"v"(b));return r;}
__device__ __forceinline__ float fsub_s(float a,float b){float r;asm("v_sub_f32_e32 %0, %1, %2":"=v"(r):"v"(a),"v"(b));return r;}
typedef float f32x2_t __attribute__((ext_vector_type(2))); typedef __bf16 bf16x2_t __attribute__((ext_vector_type(2)));
__device__ __forceinline__ unsigned cvtpk_s(float lo,float hi){f32x2_t v={lo,hi};bf16x2_t b=__builtin_convertvector(v,bf16x2_t);return __builtin_bit_cast(unsigned,b);}
#define WAIT_BAR(N) asm volatile("s_waitcnt vmcnt(" #N ") lgkmcnt(0)\n\ts_barrier":::"memory")

__device__ __forceinline__ void qkt(f32x16&p0,f32x16&p1,const char*Kslot,const bf16x8*qr,const f32x16&negm,int r32,int hi){
  const char*kb=Kslot+hi*1024+r32*16;
  #pragma unroll
  for(int d0=0;d0<4;++d0){
    const bf16x8 b0=*reinterpret_cast<const bf16x8*>(kb+d0*2048);
    const bf16x8 b1=*reinterpret_cast<const bf16x8*>(kb+d0*2048+512);
    if(d0==0){p0=__builtin_amdgcn_mfma_f32_32x32x16_bf16(b0,qr[0],negm,0,0,0);p1=__builtin_amdgcn_mfma_f32_32x32x16_bf16(b1,qr[0],negm,0,0,0);}
    else{p0=__builtin_amdgcn_mfma_f32_32x32x16_bf16(b0,qr[d0],p0,0,0,0);p1=__builtin_amdgcn_mfma_f32_32x32x16_bf16(b1,qr[d0],p1,0,0,0);}}
}
typedef __attribute__((address_space(3))) const char* lds_cptr;
typedef short v4i16_t __attribute__((ext_vector_type(4)));
__device__ __forceinline__ void kload8(bf16x8*kf,lds_cptr kp){
  kf[0]=*(const __attribute__((address_space(3))) bf16x8*)(kp);      kf[1]=*(const __attribute__((address_space(3))) bf16x8*)(kp+512);
  kf[2]=*(const __attribute__((address_space(3))) bf16x8*)(kp+2048); kf[3]=*(const __attribute__((address_space(3))) bf16x8*)(kp+2560);
  kf[4]=*(const __attribute__((address_space(3))) bf16x8*)(kp+4096); kf[5]=*(const __attribute__((address_space(3))) bf16x8*)(kp+4608);
  kf[6]=*(const __attribute__((address_space(3))) bf16x8*)(kp+6144); kf[7]=*(const __attribute__((address_space(3))) bf16x8*)(kp+6656);
}
__device__ __forceinline__ void kload2(bf16x8*kf,lds_cptr kp,int j){ kf[2*j]=*(const __attribute__((address_space(3))) bf16x8*)(kp+j*2048); kf[2*j+1]=*(const __attribute__((address_space(3))) bf16x8*)(kp+j*2048+512); }
__device__ __forceinline__ s16x4 vtr(lds_cptr p){ return __builtin_bit_cast(s16x4,__builtin_amdgcn_ds_read_tr16_b64_v4i16((__attribute__((address_space(3))) v4i16_t*)p)); }
__device__ __forceinline__ float rowmax(const f32x16&p0,const f32x16&p1){
  float a=max3f(p0[0],p0[1],p1[0]),b=max3f(p0[2],p0[3],p1[1]);a=max3f(a,p1[2],p1[3]);
  #pragma unroll
  for(int r=4;r<16;r+=4){a=max3f(a,p0[r],p0[r+1]);b=max3f(b,p0[r+2],p0[r+3]);a=max3f(a,p1[r],p1[r+1]);b=max3f(b,p1[r+2],p1[r+3]);}
  const float m=max2f(a,b);
  auto rr=__builtin_amdgcn_permlane32_swap(__float_as_uint(m),__float_as_uint(m),false,false);
  return max2f(__uint_as_float(rr[0]),__uint_as_float(rr[1]));
}
__device__ __forceinline__ void pv(f32x16*o,int vb,bf16x8 pa0,bf16x8 pa1,bf16x8 pa2,bf16x8 pa3){
  #pragma unroll
  for(int d0=0;d0<2;++d0){s16x4 lo[4],hi[4];
    #pragma unroll
    for(int ks=0;ks<4;++ks){
      asm volatile("ds_read_b64_tr_b16 %0,%1 offset:%c2":"=&v"(lo[ks]):"v"(vb),"i"(d0*4096+ks*1024):"memory");
      asm volatile("ds_read_b64_tr_b16 %0,%1 offset:%c2":"=&v"(hi[ks]):"v"(vb),"i"(d0*4096+ks*1024+512):"memory");}
    asm volatile("s_waitcnt lgkmcnt(0)":::"memory");SBAR();
    #define PK(k) (bf16x8){lo[k][0],lo[k][1],lo[k][2],lo[k][3],hi[k][0],hi[k][1],hi[k][2],hi[k][3]}
    o[d0]=__builtin_amdgcn_mfma_f32_32x32x16_bf16(pa0,PK(0),o[d0],0,0,0);
    o[d0]=__builtin_amdgcn_mfma_f32_32x32x16_bf16(pa1,PK(1),o[d0],0,0,0);
    o[d0]=__builtin_amdgcn_mfma_f32_32x32x16_bf16(pa2,PK(2),o[d0],0,0,0);
    o[d0]=__builtin_amdgcn_mfma_f32_32x32x16_bf16(pa3,PK(3),o[d0],0,0,0);
    #undef PK
  }
}

#ifndef ATTN_STORE16
#define ATTN_STORE16(p,v) (*(u32x4*)(p)=(v))
#endif
template<int THRL,bool FIXMAX,bool QPREP> __device__ __forceinline__ void attn_unit(const bf16*Qh,const bf16*__restrict__ Kh,const bf16*__restrict__ Vh,bf16*Oh,const int NT,const float negB,const float*qw,const int tok0,char*shm){
  int tid_=threadIdx.x; asm volatile("":"+v"(tid_)); const int tid=tid_,lane=tid&63,r32=lane&31,hi=lane>>5; const int wid=__builtin_amdgcn_readfirstlane(tid>>6);
  const bf16*Qw=Qh+(long)(wid*QBLK)*(QPREP?QPR:QP);
  const unsigned lds0=(unsigned)(uintptr_t)shm;
  float*wsf=(float*)(shm+LDS_WS)+wid*64;
  const bf16*ksrc=Kh+(long)lane*KP+wid*8;
  const bf16*vsrc=Vh+(long)(16*(wid&3)+(lane>>2))*VP+(wid>>2)*32+(lane&3)*8;
  const unsigned kdst=lds0+LDS_K+wid*1024, vdst=lds0+LDS_V+wid*1024;
  #define DMA_K(t,slot) glds16(ksrc+(long)(t)*KVBLK*KP,(unsigned)__builtin_amdgcn_readfirstlane(kdst+(slot)))
  #define DMA_V(t,slot) glds16(vsrc+(long)(t)*KVBLK*VP,(unsigned)__builtin_amdgcn_readfirstlane(vdst+(slot)))
  const int vb0=(int)(lds0+LDS_V)+((lane>>4)&1)*32+(lane&3)*8+(4*hi+((lane&15)>>2))*64;
  const char*Kbase=shm+LDS_K; bf16x8 kf[8];
  const lds_cptr shm3=(lds_cptr)shm; const lds_cptr kp0=shm3+LDS_K+hi*1024+r32*16; const lds_cptr vp0=shm3+LDS_V+((lane>>4)&1)*32+(lane&3)*8+(4*hi+((lane&15)>>2))*64;
  DMA_K(0,0);DMA_V(0,0);DMA_K(1,SLOTB);
  bf16x8 qr[4];
  #pragma unroll
  for(int d0=0;d0<4;++d0)qr[d0]=*reinterpret_cast<const bf16x8*>(&Qw[(long)r32*(QPREP?QPR:QP)+d0*16+hi*8]);
  if constexpr(QPREP){
    float x[4][8]; float ss=0.f;
    #pragma unroll
    for(int d0=0;d0<4;++d0){ const u32x4 w=__builtin_bit_cast(u32x4,qr[d0]);
      x[d0][0]=__uint_as_float(w.x<<16);x[d0][1]=__uint_as_float(w.x&0xffff0000u);x[d0][2]=__uint_as_float(w.y<<16);x[d0][3]=__uint_as_float(w.y&0xffff0000u);
      x[d0][4]=__uint_as_float(w.z<<16);x[d0][5]=__uint_as_float(w.z&0xffff0000u);x[d0][6]=__uint_as_float(w.w<<16);x[d0][7]=__uint_as_float(w.w&0xffff0000u);
      #pragma unroll
      for(int e=0;e<8;++e)ss+=x[d0][e]*x[d0][e]; }
    { auto rr=__builtin_amdgcn_permlane32_swap(__float_as_uint(ss),__float_as_uint(ss),false,false); ss=__uint_as_float(rr[0])+__uint_as_float(rr[1]); }
    const float rinv=__builtin_amdgcn_rsqf(ss*(1.f/64.f)+1e-6f)*C2;
    const int tok=tok0+wid*QBLK+r32; const float prow=tok0<0?0.f:(float)(tok>>6), pcol=tok0<0?0.f:(float)(tok&63);
    #pragma unroll
    for(int d0=0;d0<4;++d0){
      const float pos=d0<2?prow:pcol;
      #pragma unroll
      for(int p=0;p<4;++p){ const int f=(d0&1)*8+hi*4+p; const float ang=pos*__builtin_amdgcn_exp2f(-(float)f*0.83048202372184058f);
        const float cs=__cosf(ang),sn=__sinf(ang);
        const float xe=x[d0][2*p]*rinv*qw[d0*16+hi*8+2*p],xo=x[d0][2*p+1]*rinv*qw[d0*16+hi*8+2*p+1];
        x[d0][2*p]=xe*cs-xo*sn; x[d0][2*p+1]=xe*sn+xo*cs; }
      u32x4 w; w.x=cvtpk_s(x[d0][0],x[d0][1]);w.y=cvtpk_s(x[d0][2],x[d0][3]);w.z=cvtpk_s(x[d0][4],x[d0][5]);w.w=cvtpk_s(x[d0][6],x[d0][7]);
      qr[d0]=__builtin_bit_cast(bf16x8,w); }
  }
  float mhat=0.f,l_reg=0.f;f32x16 o[2];o[0]=f32x16{};o[1]=f32x16{};f32x16 negm=f32x16{};
  if constexpr(FIXMAX){ int nb_=__builtin_amdgcn_readfirstlane(__float_as_int(negB)); asm volatile("":"+s"(nb_));
    const float nb=__int_as_float(nb_);
    #pragma unroll
    for(int r=0;r<16;++r)negm[r]=nb;}
  asm volatile("":"+v"(negm));
  #define CMASK(P0,P1,t) do{}while(0)
  bool resc=false;
  #define START(P0,P1) do{ resc=false; \
    if constexpr(!FIXMAX){ const float rm=rowmax(P0,P1); const float dl=rm; mhat=fadd_s(mhat,dl); \
      _Pragma("unroll") for(int r=0;r<16;++r){P0[r]=fsub_s(P0[r],dl);P1[r]=fsub_s(P1[r],dl);} \
      _Pragma("unroll") for(int r=0;r<16;++r)negm[r]=-mhat; asm volatile("":"+v"(negm)); } \
    _Pragma("unroll") for(int r=0;r<16;++r)P0[r]=__builtin_amdgcn_exp2f(P0[r]); }while(0)
  #define RESC() do{ if(resc){ asm volatile("s_waitcnt lgkmcnt(0)":::"memory"); \
      _Pragma("unroll") for(int d_=0;d_<2;++d_) _Pragma("unroll") for(int r=0;r<16;++r)o[d_][r]*=wsf[crow(r,hi)]; } }while(0)
  f32x16 pA0,pA1,pB0,pB1;
  int sl_prev=0,sl_cur=0,sl_next=SLOTB;
  #define ROT() do{sl_prev=sl_cur;sl_cur=sl_next;sl_next=(sl_next==(NSLOT-1)*SLOTB)?0:sl_next+SLOTB;}while(0)
  DMA_K(2,2*SLOTB);
  WAIT_BAR(3);
  qkt(pA0,pA1,Kbase,qr,negm,r32,hi);asm volatile("s_nop 15\n\ts_nop 7":"+v"(pA0),"+v"(pA1));CMASK(pA0,pA1,0);
  START(pA0,pA1);
  _Pragma("unroll") for(int r=0;r<16;++r)pA1[r]=__builtin_amdgcn_exp2f(pA1[r]);
  WAIT_BAR(0);
  DMA_K(3,0);DMA_V(1,SLOTB);
  ROT();
  kload8(kf,kp0+sl_cur);
  WAIT_BAR(2);
  s16x4 vlo[8],vhi[8]; u32x4 pw0,pw1,pw2,pw3;
  #define PKW(P,B) cvtpk_s(P[B],P[B+1])
  #define PAF(k) __builtin_bit_cast(bf16x8,pw##k)
  #define VFR(i) (bf16x8){vlo[i][0],vlo[i][1],vlo[i][2],vlo[i][3],vhi[i][0],vhi[i][1],vhi[i][2],vhi[i][3]}
  #define PIN(x) asm volatile("":"+v"(x))
  #define MX3(a,b,c) __builtin_fmaxf(__builtin_fmaxf((a),(b)),(c))
  #define GAPA(MF,A0,A1,A2,A3,W0,W1,PW) do{ MF; sacc+=A0; sacc+=A1; sacc+=A2; sacc+=A3; PIN(sacc); W0; W1; PIN(PW); SBAR(); }while(0)
  #define EX(v) __builtin_amdgcn_exp2f(v)
  #define GAPB(MF,X,B) do{ MF; X[B]=EX(X[B]); X[B+1]=EX(X[B+1]); X[B+2]=EX(X[B+2]); X[B+3]=EX(X[B+3]); PIN(X); SBAR(); }while(0)
  #define VRD(i) do{ vlo[i]=vtr(vp_+(((i)>>2)*4096+((i)&3)*1024)); vhi[i]=vtr(vp_+(((i)>>2)*4096+((i)&3)*1024+512)); }while(0)
  #define KRD(G,j) do{ if(G){ kload2(kf,kp0+sl_next,j); SBAR(); } }while(0)
  #define STEP(C0,C1,P0,P1,t,GK,GV,GL) do{ SBAR(); \
    const lds_cptr vp_=vp0+sl_prev; \
    VRD(0); SBAR(); float sacc=(P0[0]+P0[1]); \
    GAPA(C0=__builtin_amdgcn_mfma_f32_32x32x16_bf16(kf[0],qr[0],negm,0,0,0), P0[2],P0[3],P0[4],P0[5],     pw0[0]=PKW(P0,0), pw0[1]=PKW(P0,2), pw0); \
    VRD(4); SBAR(); GAPA(C1=__builtin_amdgcn_mfma_f32_32x32x16_bf16(kf[1],qr[0],negm,0,0,0), P0[6],P0[7],P0[8],P0[9],     pw0[2]=PKW(P0,4), pw0[3]=PKW(P0,6), pw0); \
    VRD(1); SBAR(); GAPA(C0=__builtin_amdgcn_mfma_f32_32x32x16_bf16(kf[2],qr[1],C0,0,0,0),   P0[10],P0[11],P0[12],P0[13], pw1[0]=PKW(P0,8), pw1[1]=PKW(P0,10), pw1); \
    VRD(5); SBAR(); GAPA(C1=__builtin_amdgcn_mfma_f32_32x32x16_bf16(kf[3],qr[1],C1,0,0,0),   P0[14],P0[15],P1[0],P1[1],   pw1[2]=PKW(P0,12),pw1[3]=PKW(P0,14), pw1); \
    VRD(2); SBAR(); GAPA(C0=__builtin_amdgcn_mfma_f32_32x32x16_bf16(kf[4],qr[2],C0,0,0,0),   P1[2],P1[3],P1[4],P1[5],     pw2[0]=PKW(P1,0), pw2[1]=PKW(P1,2), pw2); \
    VRD(6); SBAR(); GAPA(C1=__builtin_amdgcn_mfma_f32_32x32x16_bf16(kf[5],qr[2],C1,0,0,0),   P1[6],P1[7],P1[8],P1[9],     pw2[2]=PKW(P1,4), pw2[3]=PKW(P1,6), pw2); \
    VRD(3); SBAR(); GAPA(C0=__builtin_amdgcn_mfma_f32_32x32x16_bf16(kf[6],qr[3],C0,0,0,0),   P1[10],P1[11],P1[12],P1[13], pw3[0]=PKW(P1,8), pw3[1]=PKW(P1,10), pw3); \
    VRD(7); SBAR(); GAPA(C1=__builtin_amdgcn_mfma_f32_32x32x16_bf16(kf[7],qr[3],C1,0,0,0),   P1[14],P1[15],0.f,0.f,       pw3[2]=PKW(P1,12),pw3[3]=PKW(P1,14), pw3); \
    l_reg+=sacc; \
    if(GK){DMA_K((t)+3,sl_cur);} if(GV){DMA_V((t)+1,sl_next);} \
    CMASK(C0,C1,t); \
    if constexpr(!FIXMAX){ float a=MX3(C0[0],C0[1],C1[0]),b=MX3(C0[2],C0[3],C1[1]); a=MX3(a,C1[2],C1[3]); \
      _Pragma("unroll") for(int r=4;r<16;r+=4){a=MX3(a,C0[r],C0[r+1]);b=MX3(b,C0[r+2],C0[r+3]);a=MX3(a,C1[r],C1[r+1]);b=MX3(b,C1[r+2],C1[r+3]);} \
      float rm=__builtin_fmaxf(a,b); { auto rr=__builtin_amdgcn_permlane32_swap(__float_as_uint(rm),__float_as_uint(rm),false,false); rm=__builtin_fmaxf(__uint_as_float(rr[0]),__uint_as_float(rr[1])); } \
      resc=false; \
      if(__builtin_expect(__any(rm>(float)THRL),0)){ const float dl=__builtin_fmaxf(rm,0.f); mhat+=dl; \
        _Pragma("unroll") for(int r=0;r<16;++r){C0[r]-=dl;C1[r]-=dl;} \
        _Pragma("unroll") for(int r=0;r<16;++r)negm[r]=-mhat; asm volatile("":"+v"(negm)); \
        const float f=__builtin_amdgcn_exp2f(-dl); l_reg*=f; if(hi==0)wsf[r32]=f; resc=true; } } \
    SBAR(); \
    GAPB(o[0]=__builtin_amdgcn_mfma_f32_32x32x16_bf16(PAF(0),VFR(0),o[0],0,0,0), C0,0); \
    GAPB(o[1]=__builtin_amdgcn_mfma_f32_32x32x16_bf16(PAF(0),VFR(4),o[1],0,0,0), C0,4); \
    KRD(GL,0); GAPB(o[0]=__builtin_amdgcn_mfma_f32_32x32x16_bf16(PAF(1),VFR(1),o[0],0,0,0), C0,8); \
    KRD(GL,1); GAPB(o[1]=__builtin_amdgcn_mfma_f32_32x32x16_bf16(PAF(1),VFR(5),o[1],0,0,0), C0,12); \
    KRD(GL,2); GAPB(o[0]=__builtin_amdgcn_mfma_f32_32x32x16_bf16(PAF(2),VFR(2),o[0],0,0,0), C1,0); \
    KRD(GL,3); GAPB(o[1]=__builtin_amdgcn_mfma_f32_32x32x16_bf16(PAF(2),VFR(6),o[1],0,0,0), C1,4); \
    GAPB(o[0]=__builtin_amdgcn_mfma_f32_32x32x16_bf16(PAF(3),VFR(3),o[0],0,0,0), C1,8); \
    GAPB(o[1]=__builtin_amdgcn_mfma_f32_32x32x16_bf16(PAF(3),VFR(7),o[1],0,0,0), C1,12); \
    }while(0)
  int t=1;
  #undef CMASK
  #define CMASK(P0,P1,t) do{}while(0)
  for(;t+5<NT;t+=2){
    STEP(pB0,pB1,pA0,pA1,t,true,true,true);     WAIT_BAR(2); RESC(); ROT();
    STEP(pA0,pA1,pB0,pB1,t+1,true,true,true);   WAIT_BAR(2); RESC(); ROT();
  }
  #undef CMASK
  #define CMASK(P0,P1,t) do{}while(0)
  #define ENDW(tt) do{ if((tt)+3<NT){WAIT_BAR(2);} else if((tt)+2<NT){WAIT_BAR(1);} else {WAIT_BAR(0);} }while(0)
  for(;t+1<NT;t+=2){
    STEP(pB0,pB1,pA0,pA1,t,(t+3<NT),(t+1<NT),(t+1<NT));       ENDW(t);   RESC(); ROT();
    STEP(pA0,pA1,pB0,pB1,t+1,(t+4<NT),(t+2<NT),(t+2<NT));     ENDW(t+1); RESC(); ROT();
  }
  STEP(pB0,pB1,pA0,pA1,NT-1,false,false,false); RESC();
  { float sacc=pB0[0]+pB0[1]; _Pragma("unroll") for(int r=2;r<16;++r)sacc+=pB0[r]; _Pragma("unroll") for(int r=0;r<16;++r)sacc+=pB1[r]; l_reg+=sacc;
    pw0=(u32x4){PKW(pB0,0),PKW(pB0,2),PKW(pB0,4),PKW(pB0,6)};pw1=(u32x4){PKW(pB0,8),PKW(pB0,10),PKW(pB0,12),PKW(pB0,14)};pw2=(u32x4){PKW(pB1,0),PKW(pB1,2),PKW(pB1,4),PKW(pB1,6)};pw3=(u32x4){PKW(pB1,8),PKW(pB1,10),PKW(pB1,12),PKW(pB1,14)};
    SBAR(); pv(o,vb0+sl_cur,PAF(0),PAF(1),PAF(2),PAF(3)); }
  #undef PKW
  #undef PAF
  #undef VFR
  #undef PIN
  #undef MX3
  #undef GAPA
  #undef GAPB
  #undef EX
  #undef VRD
  #undef KRD
  #undef STEP
  #undef ENDW
  {auto rr=__builtin_amdgcn_permlane32_swap(__float_as_uint(l_reg),__float_as_uint(l_reg),false,false);l_reg=__uint_as_float(rr[0])+__uint_as_float(rr[1]);}
  if(hi==0)wsf[32+r32]=l_reg;asm volatile("s_waitcnt lgkmcnt(0)":::"memory");
  float rli[16];
  #pragma unroll
  for(int r=0;r<16;++r)rli[r]=__builtin_amdgcn_rcpf(wsf[32+crow(r,hi)]);
  bf16*Ow=Oh+(long)(wid*QBLK)*OP;
  { bf16*stg=(bf16*)(shm+LDS_OST)+wid*2048;
    #pragma unroll
    for(int r=0;r<16;++r){const int orow=crow(r,hi);
      #pragma unroll
      for(int d0=0;d0<2;++d0)stg[orow*64+d0*32+r32]=__float2bfloat16(o[d0][r]*rli[r]);}
    asm volatile("s_waitcnt lgkmcnt(0)":::"memory");
    #pragma unroll
    for(int i=0;i<4;++i){const int row=i*8+(lane>>3),ch=lane&7; const u32x4 v=*(const u32x4*)(stg+row*64+ch*8); ATTN_STORE16(Ow+(long)row*OP+ch*8,v);} }
  asm volatile("s_waitcnt lgkmcnt(0)\n\ts_barrier":::"memory");
  #undef DMA_K
  #undef DMA_V
  #undef CMASK
  #undef START
  #undef RESC
  #undef ROT
}
constexpr int ATTN_LDS_BYTES=LDS_BYTES;
#undef SBAR
#undef WAIT_BAR
}
#define GAS __attribute__((address_space(1)))
#define LAS __attribute__((address_space(3)))
typedef unsigned short bf16;
typedef unsigned v4u __attribute__((ext_vector_type(4)));
typedef float f32x4 __attribute__((ext_vector_type(4)));
typedef short bf16x8 __attribute__((ext_vector_type(8)));
typedef GAS unsigned gu32;
typedef GAS unsigned long long gu64;
#define RLX_AGENT __ATOMIC_RELAXED, __HIP_MEMORY_SCOPE_AGENT
#define LDS_WAIT() asm volatile("s_waitcnt lgkmcnt(0)" ::: "memory")
#define VM_WAIT() asm volatile("s_waitcnt vmcnt(0)" ::: "memory")
__device__ __forceinline__ unsigned long long rt() { return __builtin_amdgcn_s_memrealtime(); }
__device__ __forceinline__ unsigned f2bf(float f) { unsigned u = __builtin_bit_cast(unsigned, f); return (u + 0x7fffu + ((u >> 16) & 1u)) >> 16; }
__device__ __forceinline__ unsigned pk2(float lo, float hi) { return f2bf(lo) | (f2bf(hi) << 16); }

#define XB_TMO      128
#define XB_XCNT(j)  (256  + 64 * (j))
#define XB_XSUB(j)  (1280 + 64 * (j))
#define XB_XGEN(j)  (2304 + 64 * (j))
#define XB_TOP      3328
#define XB_TOPGEN   3392
#define XCD_BAR_WORDS 3456
#define XB_SPIN_CAP (1u << 18)

__device__ __forceinline__ unsigned xb_ld(unsigned* p)              { return __hip_atomic_load(p, __ATOMIC_RELAXED, __HIP_MEMORY_SCOPE_AGENT); }
__device__ __forceinline__ unsigned xb_add(unsigned* p, unsigned v) { return __hip_atomic_fetch_add(p, v, __ATOMIC_RELAXED, __HIP_MEMORY_SCOPE_AGENT); }
__device__ __forceinline__ unsigned xb_xcc_id() { return (unsigned)__builtin_amdgcn_s_getreg((3 << 11) | 20) & 0xFu; }
#define XB_SPIN(cond, bar) do { unsigned _sp = 0; while (cond) { __builtin_amdgcn_s_sleep(1); \
    if ((++_sp & 255u) == 0u) { if (xb_ld(&(bar)[XB_TMO])) break; if (_sp > XB_SPIN_CAP) { atomicAdd(&(bar)[XB_TMO], 1u); break; } } } } while (0)

struct XcdBarrier {
    unsigned* bar; unsigned x;
    volatile LAS unsigned* st;
};

__device__ __forceinline__ XcdBarrier xcd_barrier_post(unsigned* bar, volatile LAS unsigned* st) {
    XcdBarrier b; b.bar = bar; b.x = xb_xcc_id(); b.st = st;
    if (threadIdx.x == 0) (void)xb_add(&bar[XB_XCNT(b.x)], 1u);
    return b;
}
__device__ __forceinline__ void xcd_barrier_complete(unsigned* bar, unsigned x, unsigned& nloc, unsigned& nx) {
    const unsigned G = gridDim.x * gridDim.y * gridDim.z;
    unsigned sum, cnt, mine, sp = 0u;
    for (;;) {
        sum = 0u; cnt = 0u; mine = 0u;
#pragma unroll
        for (unsigned j = 0; j < 16; ++j) { const unsigned c = xb_ld(&bar[XB_XCNT(j)]); sum += c; cnt += (c > 0u) ? 1u : 0u; mine = (j == x) ? c : mine; }
        if (sum == G) break;
        __builtin_amdgcn_s_sleep(1);
        if ((++sp & 255u) == 0u) { if (xb_ld(&bar[XB_TMO])) break; if (sp > XB_SPIN_CAP) { atomicAdd(&bar[XB_TMO], 1u); break; } }
    }
    nloc = mine > 0u ? mine : 1u; nx = cnt > 0u ? cnt : 1u;
}

__device__ __forceinline__ void xcd_barrier(const XcdBarrier& b) {
    asm volatile("s_waitcnt vmcnt(0)" ::: "memory");
    __syncthreads();
    if (threadIdx.x == 0) {
        unsigned* bar = b.bar;
        __builtin_amdgcn_s_waitcnt(0);
        unsigned nloc = b.st[0], nx = b.st[1];
        if (nloc == 0u) { xcd_barrier_complete(bar, b.x, nloc, nx); b.st[0] = nloc; b.st[1] = nx; }
        const unsigned old = xb_add(&bar[XB_XSUB(b.x)], 1u);
        const unsigned gen = old / nloc;
        if (old + 1u == (gen + 1u) * nloc) {
            __builtin_amdgcn_fence(__ATOMIC_RELEASE, "agent");
            asm volatile("s_waitcnt vmcnt(0)" ::: "memory");
            const unsigned og = xb_add(&bar[XB_TOP], 1u);
            const unsigned tg = og / nx;
            if (og + 1u == (tg + 1u) * nx) xb_add(&bar[XB_TOPGEN], 1u);
            else XB_SPIN(xb_ld(&bar[XB_TOPGEN]) == tg, bar);
            __builtin_amdgcn_fence(__ATOMIC_ACQUIRE, "agent");
            xb_add(&bar[XB_XGEN(b.x)], 1u);
            asm volatile("s_waitcnt vmcnt(0)" ::: "memory");
        } else {
            XB_SPIN(xb_ld(&bar[XB_XGEN(b.x)]) == gen, bar);
            __builtin_amdgcn_fence(__ATOMIC_ACQUIRE, "agent");
            asm volatile("s_waitcnt vmcnt(0)" ::: "memory");
        }
    }
    __syncthreads();
}

constexpr int NWAVES = 8, NTHR = 512;
constexpr int DM = 1024, NB = 4, TL = 8192, TC = 256, TT = TL + TC, MROWS = NB * TT  , MLAT = NB * TL  ;
constexpr int NP = 2304, DIN = 2320;
constexpr int CQ = 0, CK = 256, CV = 512, CO = 1024, CAQ = 1536, CAK = 2048, CAV = 2176;
constexpr int DFF = 2816, DFE = 3584, NEXP = 8;
constexpr int NBLK = TT / 128;
constexpr int NSEQ = NB * 4 * 2;
constexpr float EPS = 1e-6f;
constexpr int N_PHASES = 23;
constexpr int PASS_TILES = 128, ACT1_TILES = 136;

constexpr size_t MiB = 1u << 20;
constexpr size_t WS_CTL = 0, CTL_ZERO_BYTES = 1 * MiB;
constexpr size_t WS_MODS = 1 * MiB;
constexpr size_t WS_ROUTE = 2 * MiB;
constexpr size_t RT_TOKE = 0, RT_TOKG = 128 * 1024, RT_CNT = 384 * 1024, RT_INFO = 400 * 1024, RT_TILEE = 404 * 1024, RT_ROWTOK = 512 * 1024, RT_ROWG = 800 * 1024;
constexpr size_t WS_CTXRES = 4 * MiB;
constexpr size_t WS_GATES = 8 * MiB;
constexpr size_t WS_CSTN = 11 * MiB, WS_CSTM = 11 * MiB + 768 * 1024, WS_CSTE = 11 * MiB + 896 * 1024;
constexpr float W_UP_SCALE = 32.f, W_DN_SCALE = 64.f, ACT_SCALE = 4.f;
#ifndef P_I8
#define P_I8 1
#endif
#ifndef DENSE_I8
#define DENSE_I8 1
#endif
#ifndef DENSE_FP8
#define DENSE_FP8 0
#endif
constexpr int DB = DENSE_FP8 ? 1 : 2;
constexpr int UB = (DENSE_FP8 || DENSE_I8) ? 1 : 2;
constexpr int UMODE = DENSE_I8 ? 2 : (DENSE_FP8 ? 1 : 0);
constexpr int PB_ = P_I8 ? 1 : 2;
constexpr int CW_CMAX_IN = 8192, CW_CMAX_UP = 8192 + 2 * NP;
constexpr size_t RT_ROWSC_H = 1400 * 1024;
constexpr int CW_WMAX = 64;
constexpr size_t RT_ROWSC = 1200 * 1024;
constexpr size_t WS_MGU = 12 * MiB, WS_MD = 68 * MiB;
constexpr size_t WS_WIN = 96 * MiB, WS_WOUT = 105 * MiB, WS_WGU = 109 * MiB, WS_WD = 120 * MiB;
constexpr size_t WS_HY = 126 * MiB;
constexpr size_t WS_P = 192 * MiB;
constexpr size_t WS_QN = WS_P + (size_t)MROWS * NP * 2;
constexpr size_t WS_KN = WS_QN + (size_t)MROWS * 512 * 2;
constexpr size_t WS_GPRE = WS_QN;
constexpr size_t WS_CSTC = 382 * MiB;
constexpr size_t WS_ACT0 = 192 * MiB;
constexpr size_t WS_H2B = 382 * MiB;
constexpr size_t WS_ASORT = 126 * MiB;
constexpr size_t WS_EOUT = 192 * MiB;
constexpr size_t WS_ACT1 = 324 * MiB;
constexpr size_t WS_RESID = 508 * MiB;
constexpr size_t WS_END = 572 * MiB;
constexpr size_t RP = 2048;
constexpr size_t WS_SLAB_CW = WS_QN, WS_SLAB_CD = WS_CSTC;
constexpr int NS_CW = 4, NS_CD = DENSE_FP8 ? 0 : 11;
constexpr size_t WS_SLAB_MT = WS_MGU;
constexpr int NS_MT = 7, MT_TILES = 8;
static_assert(WS_KN + (size_t)MROWS * 128 * 2 <= WS_CSTC && WS_CSTC + (size_t)NSEQ * NBLK * 8192 * 4 <= WS_RESID, "ws map");
static_assert(WS_ACT0 + (size_t)MROWS * DFF * DB <= WS_CSTC && WS_ASORT + (size_t)264 * 256 * DM <= WS_EOUT && WS_EOUT + (size_t)264 * 256 * DM * 2 <= WS_ACT1 && WS_ACT1 + (size_t)ACT1_TILES * 256 * DFE <= WS_RESID && WS_H2B + (size_t)MLAT * DM <= WS_RESID, "ws map 2");
static_assert(WS_MGU + (size_t)NEXP * 2 * DFE * DM <= WS_MD && WS_MD + (size_t)NEXP * DM * DFE <= WS_WIN && WS_WIN + (size_t)2 * NP * DM * 2 <= WS_WOUT && WS_WOUT + (size_t)2 * DM * DM * 2 <= WS_WGU && WS_WGU + (size_t)2 * DFF * DM * UB <= WS_WD && WS_WD + (size_t)DM * DFF * DB <= WS_HY && (size_t)NS_MT * MT_TILES * 256 * 1024 * 4 <= WS_MD - WS_MGU, "ws map 3");
constexpr int CW_BAR = 4096;

constexpr int LDS_BYTES = 155648;
constexpr int MISC_OFF = 154624;

struct Args { const float* in[22]; float* out; unsigned char* ws; int ph_lo, ph_hi, li, pad; };
typedef const __attribute__((address_space(4))) Args* CAP;
__device__ __forceinline__ const float* ain(CAP a, int k) { return (const float*)(const GAS float*)(unsigned long long)a->in[k]; }
__device__ __forceinline__ float* aout(CAP a) { return (float*)(GAS float*)(unsigned long long)a->out; }
__device__ __forceinline__ CAP args_ptr() { unsigned long long p = (unsigned long long)__builtin_amdgcn_kernarg_segment_ptr(); asm volatile("" : "+s"(p)); return (CAP)p; }

struct Frame {
    LAS unsigned char* lds; volatile LAS unsigned* MISC; gu32* ctl; unsigned char* ws;
    int tid, lane, wave, vcu, G, gw, NGW;
};

__device__ __forceinline__ float shx(float v, int o, int lane) { return __int_as_float(__builtin_amdgcn_ds_bpermute((lane ^ o) << 2, __float_as_int(v))); }
__device__ __forceinline__ float shu(float v, int o, int lane) { return __int_as_float(__builtin_amdgcn_ds_bpermute(((lane - o) & 63) << 2, __float_as_int(v))); }
__device__ __forceinline__ float shi(float v, int src) { return __int_as_float(__builtin_amdgcn_ds_bpermute(src << 2, __float_as_int(v))); }
#define WAVE_DPP(v, ctrl) __int_as_float(__builtin_amdgcn_update_dpp(0, __float_as_int(v), ctrl, 0xf, 0xf, true))
__device__ __forceinline__ float wave_sum(float v, int lane) {
    (void)lane;
    v += WAVE_DPP(v, 0xB1); v += WAVE_DPP(v, 0x4E); v += WAVE_DPP(v, 0x141); v += WAVE_DPP(v, 0x140);
    { auto rr = __builtin_amdgcn_permlane16_swap(__float_as_uint(v), __float_as_uint(v), false, false); v = __uint_as_float(rr[0]) + __uint_as_float(rr[1]); }
    { auto rr = __builtin_amdgcn_permlane32_swap(__float_as_uint(v), __float_as_uint(v), false, false); v = __uint_as_float(rr[0]) + __uint_as_float(rr[1]); }
    return v;
}
__device__ __forceinline__ float wave_max(float v, int lane) {
    (void)lane;
    v = fmaxf(v, WAVE_DPP(v, 0xB1)); v = fmaxf(v, WAVE_DPP(v, 0x4E)); v = fmaxf(v, WAVE_DPP(v, 0x141)); v = fmaxf(v, WAVE_DPP(v, 0x140));
    { auto rr = __builtin_amdgcn_permlane16_swap(__float_as_uint(v), __float_as_uint(v), false, false); v = fmaxf(__uint_as_float(rr[0]), __uint_as_float(rr[1])); }
    { auto rr = __builtin_amdgcn_permlane32_swap(__float_as_uint(v), __float_as_uint(v), false, false); v = fmaxf(__uint_as_float(rr[0]), __uint_as_float(rr[1])); }
    return v;
}
#define SCAN_DPP(idv, v, ctrl, rmask) __int_as_float(__builtin_amdgcn_update_dpp(__float_as_int(idv), __float_as_int(v), ctrl, rmask, 0xf, false))
__device__ __forceinline__ float wave_incl_scan_add(float v, int lane) {
    (void)lane;
    v += SCAN_DPP(0.f, v, 0x111, 0xf); v += SCAN_DPP(0.f, v, 0x112, 0xf); v += SCAN_DPP(0.f, v, 0x114, 0xf); v += SCAN_DPP(0.f, v, 0x118, 0xf);
    v += SCAN_DPP(0.f, v, 0x142, 0xa); v += SCAN_DPP(0.f, v, 0x143, 0xc);
    return v;
}
__device__ __forceinline__ float wave_incl_scan_max(float v, int lane) {
    (void)lane; const float ninf = -INFINITY;
    v = fmaxf(v, SCAN_DPP(ninf, v, 0x111, 0xf)); v = fmaxf(v, SCAN_DPP(ninf, v, 0x112, 0xf)); v = fmaxf(v, SCAN_DPP(ninf, v, 0x114, 0xf)); v = fmaxf(v, SCAN_DPP(ninf, v, 0x118, 0xf));
    v = fmaxf(v, SCAN_DPP(ninf, v, 0x142, 0xa)); v = fmaxf(v, SCAN_DPP(ninf, v, 0x143, 0xc));
    return v;
}
__device__ __forceinline__ float bf2f(unsigned short b) { return __uint_as_float((unsigned)b << 16); }
__device__ __forceinline__ float bflo(unsigned w) { return __uint_as_float(w << 16); }
__device__ __forceinline__ float bfhi(unsigned w) { return __uint_as_float(w & 0xffff0000u); }
__device__ __forceinline__ float logsig(float x) { return fminf(x, 0.f) - __logf(1.f + __expf(-fabsf(x))); }
__device__ __forceinline__ float siluf(float x) { return x / (1.f + __expf(-x)); }
__device__ __forceinline__ float dot4(f32x4 a, f32x4 b) { return (a.x * b.x + a.y * b.y) + (a.z * b.z + a.w * b.w); }
#define MFMA16(a, b, c) __builtin_amdgcn_mfma_f32_16x16x32_bf16((a), (b), (c), 0, 0, 0)
__device__ __forceinline__ unsigned pk4_i8(float a, float b, float c, float d) {
    const int qa = (int)__builtin_amdgcn_fmed3f(__builtin_rintf(a), -127.f, 127.f), qb = (int)__builtin_amdgcn_fmed3f(__builtin_rintf(b), -127.f, 127.f), qc = (int)__builtin_amdgcn_fmed3f(__builtin_rintf(c), -127.f, 127.f), qd = (int)__builtin_amdgcn_fmed3f(__builtin_rintf(d), -127.f, 127.f);
    return (unsigned)(qa & 255) | ((unsigned)(qb & 255) << 8) | ((unsigned)(qc & 255) << 16) | ((unsigned)(qd & 255) << 24); }
__device__ __forceinline__ float c448(float x) { return __builtin_amdgcn_fmed3f(x, -448.f, 448.f); }
__device__ __forceinline__ unsigned pk4_fp8(float a, float b, float c, float d) {
    int p = 0; p = __builtin_amdgcn_cvt_pk_fp8_f32(c448(a), c448(b), p, false); p = __builtin_amdgcn_cvt_pk_fp8_f32(c448(c), c448(d), p, true); return (unsigned)p; }

struct TrDesc { const float* src; unsigned char* dst; int ldw, ldt; float sc8; int mode; const gu32* cmax; };
constexpr int I0 = 2 * 16 * 72, I1 = 2 * 16 * 32, I2 = 16 * 176, I3 = 44 * 32, I4 = 8 * 16 * 224, I5 = 8 * 56 * 32;
constexpr int I_SMALL = I0 + I1 + I2 + I3, I_MOE = I4 + I5;
__device__ __forceinline__ TrDesc tr_desc(Frame& F, CAP a, int it) {
    TrDesc d; int r = it;
    if (r < I0) { const int L = r / 1152, rem = r % 1152, kb = rem / 72, nb = rem % 72, c0 = 32 * nb;
        d.ldw = DIN; d.src = ain(a, 8) + (size_t)L * DM * DIN + (size_t)(64 * kb) * DIN + (c0 < 1536 ? c0 : c0 + 16); d.ldt = DM * PB_; d.dst = F.ws + WS_WIN + ((size_t)L * NP * DM + (size_t)c0 * DM + 64 * kb) * PB_; d.mode = P_I8 ? 2 : 0; d.sc8 = 0.f; d.cmax = F.ctl + CW_CMAX_IN + L * NP + c0; return d; }
    r -= I0;
    if (r < I1) { const int L = r / 512, rem = r % 512, kb = rem / 32, nb = rem % 32;
        d.ldw = DM; d.src = ain(a, 13) + (size_t)L * DM * DM + (size_t)(64 * kb) * DM + 32 * nb; d.ldt = DM * 2; d.dst = F.ws + WS_WOUT + ((size_t)L * DM * DM + (size_t)(32 * nb) * DM + 64 * kb) * 2; d.sc8 = 0.f; d.mode = 0; return d; }
    r -= I1;
    if (r < I2) { const int kb = r / 176, nb = r % 176, r0 = 32 * nb, pn = r0 >> 8, wi = r0 & 255;
        d.ldw = DFF; d.src = (wi < 128 ? ain(a, 14) : ain(a, 15)) + (size_t)(64 * kb) * DFF + 128 * pn + (wi & 127); d.ldt = DM * UB; d.dst = F.ws + WS_WGU + ((size_t)r0 * DM + 64 * kb) * UB; d.mode = UMODE; d.sc8 = DENSE_FP8 ? W_UP_SCALE : 0.f; d.cmax = F.ctl + CW_CMAX_UP + r0; return d; }
    r -= I2;
    if (r < I3) { const int kb = r / 32, nb = r % 32;
        d.ldw = DM; d.src = ain(a, 16) + (size_t)(64 * kb) * DM + 32 * nb; d.ldt = DFF * DB; d.dst = F.ws + WS_WD + ((size_t)(32 * nb) * DFF + 64 * kb) * DB; d.sc8 = DENSE_FP8 ? W_DN_SCALE : 0.f; d.mode = DENSE_FP8 ? 1 : 0; return d; }
    r -= I3;
    if (r < I4) { const int e = r / 3584, rem = r % 3584, kb = rem / 224, nb = rem % 224, r0 = 32 * nb, pn = r0 >> 8, wi = r0 & 255;
        d.ldw = DFE; d.src = (wi < 128 ? ain(a, 18) : ain(a, 19)) + (size_t)e * DM * DFE + (size_t)(64 * kb) * DFE + 128 * pn + (wi & 127); d.ldt = DM; d.dst = F.ws + WS_MGU + (size_t)e * 2 * DFE * DM + (size_t)r0 * DM + 64 * kb; d.sc8 = W_UP_SCALE; d.mode = 1; return d; }
    r -= I4;
    { const int e = r / 1792, rem = r % 1792, kb = rem / 32, nb = rem % 32;
        d.ldw = DM; d.src = ain(a, 20) + (size_t)e * DFE * DM + (size_t)(64 * kb) * DM + 32 * nb; d.ldt = DFE; d.dst = F.ws + WS_MD + (size_t)e * DM * DFE + (size_t)(32 * nb) * DFE + 64 * kb; d.sc8 = W_DN_SCALE; d.mode = 1; return d; }
}
struct TrRegs { f32x4 v[8]; unsigned cm[4]; };
__device__ __forceinline__ TrRegs tr_load(const TrDesc& d, int lane) {
    TrRegs R;
#pragma unroll
    for (int i = 0; i < 8; ++i) R.v[i] = __builtin_nontemporal_load((const GAS f32x4*)(d.src + (size_t)(8 * i + (lane >> 3)) * d.ldw + 4 * (lane & 7)));
#pragma unroll
    for (int j = 0; j < 4; ++j) R.cm[j] = d.mode == 2 ? d.cmax[(lane >> 3) + 8 * j] : 0u;
    return R;
}
__device__ __forceinline__ void tr_finish(const TrDesc& d, const TrRegs& R, LAS float* scr, int lane) {
#pragma unroll
    for (int i = 0; i < 8; ++i) { LAS float* p = scr + (8 * i + (lane >> 3)) * 33 + 4 * (lane & 7); p[0] = R.v[i].x; p[1] = R.v[i].y; p[2] = R.v[i].z; p[3] = R.v[i].w; }
    LDS_WAIT(); asm volatile("" ::: "memory");
    const int c = lane & 7;
#pragma unroll
    for (int j = 0; j < 4; ++j) { const int n = (lane >> 3) + 8 * j; const LAS float* s = scr + (8 * c) * 33 + n;
        if (d.mode == 0) { v4u o; o.x = pk2(s[0 * 33], s[1 * 33]); o.y = pk2(s[2 * 33], s[3 * 33]); o.z = pk2(s[4 * 33], s[5 * 33]); o.w = pk2(s[6 * 33], s[7 * 33]);
            *(GAS v4u*)(d.dst + (size_t)n * d.ldt + 16 * c) = o; }
        else if (d.mode == 2) { const float sc8 = 127.f / fmaxf(__uint_as_float(R.cm[j]), 1e-30f); const unsigned lo = pk4_i8(s[0 * 33] * sc8, s[1 * 33] * sc8, s[2 * 33] * sc8, s[3 * 33] * sc8), hi = pk4_i8(s[4 * 33] * sc8, s[5 * 33] * sc8, s[6 * 33] * sc8, s[7 * 33] * sc8);
            *(GAS unsigned long long*)(d.dst + (size_t)n * d.ldt + 8 * c) = (unsigned long long)lo | ((unsigned long long)hi << 32); }
        else { const float sc8 = d.sc8; const unsigned lo = pk4_fp8(s[0 * 33] * sc8, s[1 * 33] * sc8, s[2 * 33] * sc8, s[3 * 33] * sc8), hi = pk4_fp8(s[4 * 33] * sc8, s[5 * 33] * sc8, s[6 * 33] * sc8, s[7 * 33] * sc8);
            *(GAS unsigned long long*)(d.dst + (size_t)n * d.ldt + 8 * c) = (unsigned long long)lo | ((unsigned long long)hi << 32); } }
    LDS_WAIT(); asm volatile("" ::: "memory");
}
__device__ __forceinline__ void convert_weights(Frame& F, CAP a, int first, int count, LAS float* scr) {
    int it = first + F.gw; const int end = first + count;
    if (it >= end) return;
    TrDesc d = tr_desc(F, a, it); TrRegs R = tr_load(d, F.lane);
    for (;;) {
        const int nx = it + F.NGW; const bool more = nx < end;
        TrDesc dn = d; TrRegs Rn = R;
        if (more) { dn = tr_desc(F, a, nx); Rn = tr_load(dn, F.lane); }
        tr_finish(d, R, scr, F.lane);
        if (!more) break;
        d = dn; R = Rn; it = nx;
    }
}
__device__ __forceinline__ void phase_prologue(Frame& F, CAP a) {
    {
        LAS float* sc = (LAS float*)F.lds;
        LAS float* red = (LAS float*)(F.lds + 20480);
        float* mods = (float*)(F.ws + WS_MODS);
        for (int u = blockIdx.x; u < 192; u += F.G) {
            const int L = u / 96, cb = u % 96;
            { float xv[10];
#pragma unroll
              for (int i = 0; i < 10; ++i) { const int idx = F.tid + NTHR * i, v = idx >> 10, k = idx & 1023; xv[i] = v < 4 ? ain(a, 1)[v * 1024 + k] : ain(a, 3)[k]; }
#pragma unroll
              for (int i = 0; i < 10; ++i) sc[F.tid + NTHR * i] = siluf(xv[i]); }
            __syncthreads();
            float acc[5] = {0.f, 0.f, 0.f, 0.f, 0.f};
            const float* wp = ain(a, 4) + ((size_t)L * 1024 + 128 * F.wave) * 6144 + cb * 64 + F.lane;
#pragma unroll 1
            for (int k0 = 0; k0 < 128; k0 += 64) { float wv[64];
#pragma unroll
                for (int q = 0; q < 64; ++q) wv[q] = *(const GAS float*)(wp + (size_t)(k0 + q) * 6144);
#pragma unroll
                for (int q = 0; q < 64; ++q) {
#pragma unroll
                    for (int v = 0; v < 5; ++v) acc[v] += wv[q] * sc[v * 1024 + 128 * F.wave + k0 + q]; } }
#pragma unroll
            for (int v = 0; v < 5; ++v) red[(F.wave * 5 + v) * 64 + F.lane] = acc[v];
            __syncthreads();
            if (F.tid < 320) { const int v = F.tid >> 6, cc = F.tid & 63; float sum = ain(a, 5)[L * 6144 + cb * 64 + cc];
#pragma unroll
                for (int w = 0; w < 8; ++w) sum += red[(w * 5 + v) * 64 + cc];
                mods[(size_t)(L * 5 + v) * 6144 + cb * 64 + cc] = sum; }
            __syncthreads();
        }
    }
    {
        constexpr int NB_IN = P_I8 ? 2 * 16 * (NP / 64) : 0, NB_UP = DENSE_I8 ? 16 * (2 * DFF / 64) : 0;
        for (int blk = F.gw; blk < NB_IN + NB_UP; blk += F.NGW) {
            const float* src; int ldw; gu32* cm;
            if (blk < NB_IN) { const int L = blk / (16 * (NP / 64)), rem = blk % (16 * (NP / 64)), kb = rem / (NP / 64), c0 = 64 * (rem % (NP / 64));
                ldw = DIN; src = ain(a, 8) + (size_t)L * DM * DIN + (size_t)(64 * kb) * DIN + (c0 < 1536 ? c0 : c0 + 16); cm = F.ctl + CW_CMAX_IN + L * NP + c0; }
            else { const int r = blk - NB_IN, kb = r / (2 * DFF / 64), r0 = 64 * (r % (2 * DFF / 64)), pn = r0 >> 8, wi = r0 & 255;
                ldw = DFF; src = (wi < 128 ? ain(a, 14) : ain(a, 15)) + (size_t)(64 * kb) * DFF + 128 * pn + (wi & 127); cm = F.ctl + CW_CMAX_UP + r0; }
            unsigned mx = 0u;
#pragma unroll 1
            for (int k0 = 0; k0 < 64; k0 += 32) { unsigned wv[32];
#pragma unroll
                for (int q = 0; q < 32; ++q) wv[q] = __float_as_uint(*(const GAS float*)(src + (size_t)(k0 + q) * ldw + F.lane));
#pragma unroll
                for (int q = 0; q < 32; ++q) { const unsigned av = wv[q] & 0x7fffffffu; mx = mx > av ? mx : av; } }
            __hip_atomic_fetch_max(cm + F.lane, mx, RLX_AGENT);
        }
    }
    {
        LAS float* scr = (LAS float*)(F.lds + F.wave * 16384);
        if (!P_I8) convert_weights(F, a, 0, I0, scr);
        convert_weights(F, a, I0, I1, scr);
        if (!DENSE_I8) convert_weights(F, a, I0 + I1, I2, scr);
        convert_weights(F, a, I0 + I1 + I2, I3, scr);
    }
}

struct RowVec { f32x4 h[4]; };
__device__ __forceinline__ f32x4 bf4(unsigned long long w) { return (f32x4){bflo((unsigned)w), bfhi((unsigned)w), bflo((unsigned)(w >> 32)), bfhi((unsigned)(w >> 32))}; }
struct RowIn { f32x4 x[4]; f32x4 t[4]; };
template <bool XB> __device__ __forceinline__ RowIn load_row(const void* src, const bf16* T, int lane) {
    RowIn I;
    if constexpr (XB) { const GAS unsigned long long* xr = (const GAS unsigned long long*)src + lane;
#pragma unroll
        for (int j = 0; j < 4; ++j) I.x[j] = bf4(xr[64 * j]); }
    else { const GAS f32x4* xr = (const GAS f32x4*)src + lane;
#pragma unroll
        for (int j = 0; j < 4; ++j) I.x[j] = xr[64 * j]; }
    if (T) { const GAS unsigned long long* tr = (const GAS unsigned long long*)T + lane;
#pragma unroll
        for (int j = 0; j < 4; ++j) I.t[j] = bf4(tr[64 * j]); }
    else {
#pragma unroll
        for (int j = 0; j < 4; ++j) I.t[j] = (f32x4){0.f, 0.f, 0.f, 0.f}; }
    return I;
}
template <bool XB> __device__ __forceinline__ RowIn load_row_slabs(const void* src, const float* S, int ns, size_t sstride, int lane) {
    RowIn I = load_row<XB>(src, nullptr, lane);
#pragma unroll 1
    for (int q = 0; q < ns; ++q) { const GAS f32x4* sr = (const GAS f32x4*)(S + (size_t)q * sstride) + lane;
#pragma unroll
        for (int j = 0; j < 4; ++j) I.t[j] += sr[64 * j]; }
    return I;
}
template <bool XB> struct RowRaw { f32x4 xf[XB ? 1 : 4]; unsigned long long xb[XB ? 4 : 1]; unsigned long long t[4]; };
template <bool XB> __device__ __forceinline__ RowRaw<XB> load_raw(const void* src, const bf16* T, int lane) {
    RowRaw<XB> I;
    if constexpr (XB) { const GAS unsigned long long* xr = (const GAS unsigned long long*)src + lane;
#pragma unroll
        for (int j = 0; j < 4; ++j) I.xb[j] = xr[64 * j]; }
    else { const GAS f32x4* xr = (const GAS f32x4*)src + lane;
#pragma unroll
        for (int j = 0; j < 4; ++j) I.xf[j] = xr[64 * j]; }
    if (T) { const GAS unsigned long long* tr = (const GAS unsigned long long*)T + lane;
#pragma unroll
        for (int j = 0; j < 4; ++j) I.t[j] = tr[64 * j]; }
    else {
#pragma unroll
        for (int j = 0; j < 4; ++j) I.t[j] = 0ull; }
    return I;
}
template <bool XB> __device__ __forceinline__ RowIn cook(const RowRaw<XB>& W) {
    RowIn I;
#pragma unroll
    for (int j = 0; j < 4; ++j) { if constexpr (XB) I.x[j] = bf4(W.xb[j]); else I.x[j] = W.xf[j]; I.t[j] = bf4(W.t[j]); }
    return I;
}
struct RowPar { f32x4 g[4], w[4], sh[4]; };
__device__ __forceinline__ RowPar load_par(const float* gate, const float* nw, const float* shift, const float* scale, int lane) {
    RowPar P;
#pragma unroll
    for (int j = 0; j < 4; ++j) { const int c = 256 * j + 4 * lane;
        P.g[j] = gate ? *(const f32x4*)(gate + c) : (f32x4){0.f, 0.f, 0.f, 0.f};
        const f32x4 w = *(const f32x4*)(nw + c), sc = *(const f32x4*)(scale + c); P.w[j] = w * (sc + 1.f); P.sh[j] = *(const f32x4*)(shift + c); }
    return P;
}
__device__ __forceinline__ RowVec finish_row(const RowIn& I, bool upd, const RowPar& P, void* dst, int lane) {
    f32x4 x[4]; float ss = 0.f;
    if (upd) { GAS unsigned long long* xw = (GAS unsigned long long*)dst + lane;
#pragma unroll
        for (int j = 0; j < 4; ++j) { x[j] = I.x[j] + P.g[j] * I.t[j]; xw[64 * j] = (unsigned long long)pk2(x[j].x, x[j].y) | ((unsigned long long)pk2(x[j].z, x[j].w) << 32); } }
    else {
#pragma unroll
        for (int j = 0; j < 4; ++j) x[j] = I.x[j]; }
#pragma unroll
    for (int j = 0; j < 4; ++j) ss += dot4(x[j], x[j]);
    const float rinv = rsqrtf(wave_sum(ss, lane) * (1.f / DM) + EPS);
    RowVec R;
#pragma unroll
    for (int j = 0; j < 4; ++j) R.h[j] = (x[j] * rinv) * P.w[j] + P.sh[j];
    return R;
}
__device__ __forceinline__ void store_row_bf16(bf16* dst, const RowVec& R, int lane) {
    GAS unsigned long long* o8 = (GAS unsigned long long*)dst + lane;
#pragma unroll
    for (int j = 0; j < 4; ++j) o8[64 * j] = (unsigned long long)pk2(R.h[j].x, R.h[j].y) | ((unsigned long long)pk2(R.h[j].z, R.h[j].w) << 32);
}
__device__ __forceinline__ void store_row_fp8(unsigned char* dst, const RowVec& R, int lane) {
    GAS unsigned* o4 = (GAS unsigned*)dst + lane;
#pragma unroll
    for (int j = 0; j < 4; ++j) o4[64 * j] = pk4_fp8(R.h[j].x, R.h[j].y, R.h[j].z, R.h[j].w);
}
__device__ __forceinline__ void store_row_i8(unsigned char* dst, float* rs, const RowVec& R, int lane) {
    float m = 0.f;
#pragma unroll
    for (int j = 0; j < 4; ++j) m = fmaxf(fmaxf(m, fmaxf(fabsf(R.h[j].x), fabsf(R.h[j].y))), fmaxf(fabsf(R.h[j].z), fabsf(R.h[j].w)));
    m = fmaxf(wave_max(m, lane), 1e-30f);
    const float inv = 127.f / m;
    GAS unsigned* o4 = (GAS unsigned*)dst + lane;
#pragma unroll
    for (int j = 0; j < 4; ++j) o4[64 * j] = pk4_i8(R.h[j].x * inv, R.h[j].y * inv, R.h[j].z * inv, R.h[j].w * inv);
    if (lane == 0) *rs = m * (1.f / 127.f);
}
__device__ __forceinline__ const float* input_row(CAP a, int b, int tp) {
    if (tp < TC) return ain(a, 2) + (size_t)(b * TC + tp) * DM;
    return ain(a, 0) + (size_t)(b * TL + tp - TC) * DM;
}
__device__ __forceinline__ unsigned char* resid_ptr(const Frame& F, CAP a, int b, int tp) {
    if (tp < TC) return F.ws + WS_CTXRES + (size_t)(b * TC + tp) * RP;
    return F.ws + WS_RESID + (size_t)(b * TL + tp - TC) * RP;
}
__device__ __forceinline__ void phase_norm1(Frame& F, CAP a, int L) {
    const float* nw = ain(a, 6) + L * DM;
    const float* mods = (const float*)(F.ws + WS_MODS) + (size_t)L * 5 * 6144;
    const float* gts = (const float*)(F.ws + WS_MODS) + 5 * 1024;
    bf16* H = (bf16*)(F.ws + WS_HY);
    unsigned char* H8 = F.ws + WS_QN; float* RS = (float*)(F.ws + WS_ROUTE + RT_ROWSC_H);
    static_assert(P_I8 == 1, "phase_norm1 writes int8 rows");
    if (P_I8 && L == 0) convert_weights(F, a, 0, I0, (LAS float*)(F.lds + F.wave * 16384));
    if (DENSE_I8 && L == 0) convert_weights(F, a, I0 + I1, I2, (LAS float*)(F.lds + F.wave * 16384));
    if (2 * F.gw < NB * TC) {
        const RowPar Pc = load_par(L ? gts + 4 * 6144 : nullptr, nw, mods + 4 * 6144, mods + 4 * 6144 + 1024, F.lane);
        for (int rc = 2 * F.gw; rc < NB * TC; rc += 2 * F.NGW) {
            const int b = rc / TC, tp = rc - b * TC, r = b * TT + tp;
            RowVec R0, R1;
            if (L == 0) { const float* src = ain(a, 2) + (size_t)rc * DM;
                const RowIn I0 = load_row<false>(src, nullptr, F.lane), I1 = load_row<false>(src + DM, nullptr, F.lane);
                R0 = finish_row(I0, false, Pc, nullptr, F.lane); R1 = finish_row(I1, false, Pc, nullptr, F.lane); }
            else { unsigned char* xr = F.ws + WS_CTXRES + (size_t)rc * RP; const float* S = (const float*)(F.ws + WS_SLAB_CD) + (size_t)rc * DM;
                const RowIn I0 = load_row_slabs<true>(xr, S, NS_CD, (size_t)1024 * 1024, F.lane), I1 = load_row_slabs<true>(xr + RP, S + DM, NS_CD, (size_t)1024 * 1024, F.lane);
                R0 = finish_row(I0, true, Pc, xr, F.lane); R1 = finish_row(I1, true, Pc, xr + RP, F.lane); }
            store_row_i8(H8 + (size_t)r * DM, RS + r, R0, F.lane); store_row_i8(H8 + (size_t)(r + 1) * DM, RS + r + 1, R1, F.lane);
        }
    }
    const int b = F.gw & 3, wpb = F.NGW >> 2;
    const RowPar P = load_par(L ? gts + b * 6144 : nullptr, nw, mods + b * 6144, mods + b * 6144 + 1024, F.lane);
    const float* xin = ain(a, 0) + (size_t)b * TL * DM; unsigned char* xres = F.ws + WS_RESID + (size_t)b * TL * RP;
    const bf16* T2 = H + ((size_t)b * TT + TC) * DM;
    int t = 2 * (F.gw >> 2);
    if (L == 0) {
        RowRaw<false> N0, N1;
        if (t < TL) { N0 = load_raw<false>(xin + (size_t)t * DM, nullptr, F.lane); N1 = load_raw<false>(xin + (size_t)(t + 1) * DM, nullptr, F.lane); }
#pragma unroll 1
        for (; t < TL; t += 2 * wpb) {
            const RowRaw<false> W0 = N0, W1 = N1; const int tn = t + 2 * wpb;
            if (tn < TL) { N0 = load_raw<false>(xin + (size_t)tn * DM, nullptr, F.lane); N1 = load_raw<false>(xin + (size_t)(tn + 1) * DM, nullptr, F.lane); }
            const int r = b * TT + TC + t;
            const RowVec R0 = finish_row(cook<false>(W0), false, P, nullptr, F.lane), R1 = finish_row(cook<false>(W1), false, P, nullptr, F.lane);
            store_row_i8(H8 + (size_t)r * DM, RS + r, R0, F.lane); store_row_i8(H8 + (size_t)(r + 1) * DM, RS + r + 1, R1, F.lane);
        }
    } else {
        RowRaw<true> N0, N1;
        if (t < TL) { N0 = load_raw<true>(xres + (size_t)t * RP, nullptr, F.lane); N1 = load_raw<true>(xres + (size_t)(t + 1) * RP, nullptr, F.lane); }
#pragma unroll 1
        for (; t < TL; t += 2 * wpb) {
            const RowRaw<true> W0 = N0, W1 = N1; const int tn = t + 2 * wpb;
            if (tn < TL) { N0 = load_raw<true>(xres + (size_t)tn * RP, nullptr, F.lane); N1 = load_raw<true>(xres + (size_t)(tn + 1) * RP, nullptr, F.lane); }
            const int r = b * TT + TC + t; unsigned char* xr = xres + (size_t)t * RP;
            const RowVec R0 = finish_row(cook<true>(W0), false, P, xr, F.lane), R1 = finish_row(cook<true>(W1), false, P, xr + RP, F.lane);
            store_row_i8(H8 + (size_t)r * DM, RS + r, R0, F.lane); store_row_i8(H8 + (size_t)(r + 1) * DM, RS + r + 1, R1, F.lane);
        }
    }
}
__device__ __forceinline__ void phase_gates(Frame& F, CAP a, int L, int wrank, int nwv) {
    LAS bf16* WgT = (LAS bf16*)F.lds;
    const float* win = ain(a, 8) + (size_t)L * DM * DIN;
    { float wv_[32];
#pragma unroll
      for (int i = 0; i < 32; ++i) { const int idx = F.tid + NTHR * i, k = idx >> 4, g = idx & 15; wv_[i] = *(const GAS float*)(win + (size_t)k * DIN + 1536 + g); }
#pragma unroll
      for (int i = 0; i < 32; ++i) { const int idx = F.tid + NTHR * i, k = idx >> 4, g = idx & 15; WgT[g * 1032 + k] = (bf16)f2bf(wv_[i]); } }
    __syncthreads();
    const bf16* H = (const bf16*)(F.ws + WS_HY); const unsigned char* H8 = F.ws + WS_QN; const float* RS = (const float*)(F.ws + WS_ROUTE + RT_ROWSC_H); float* Gt = (float*)(F.ws + WS_GATES);
    const int c16 = F.lane & 15, q4 = F.lane >> 4;
    const float gbias = ain(a, 9)[L * 16 + c16];
    for (int grp = wrank; grp < MROWS / 16; grp += nwv) {
        f32x4 acc = (f32x4){0.f, 0.f, 0.f, 0.f};
        unsigned long long rawa[32];
        float rsg[4];
        if (P_I8) {
#pragma unroll
            for (int kk = 0; kk < 32; ++kk) rawa[kk] = *(const GAS unsigned long long*)(H8 + (size_t)(grp * 16 + c16) * DM + 8 * q4 + 32 * kk);
#pragma unroll
            for (int j = 0; j < 4; ++j) rsg[j] = RS[grp * 16 + 4 * q4 + j]; }
#pragma unroll
        for (int k0 = 0; k0 < 1024; k0 += 256) {
            bf16x8 av[8];
            if (P_I8) {
#pragma unroll
                for (int kk = 0; kk < 8; ++kk) { const unsigned long long rw = rawa[(k0 >> 5) + kk]; const int lo = (int)(unsigned)rw, hi = (int)(unsigned)(rw >> 32);
                    v4u w; w.x = pk2((float)(signed char)(lo), (float)(signed char)(lo >> 8)); w.y = pk2((float)(signed char)(lo >> 16), (float)(signed char)(lo >> 24));
                    w.z = pk2((float)(signed char)(hi), (float)(signed char)(hi >> 8)); w.w = pk2((float)(signed char)(hi >> 16), (float)(signed char)(hi >> 24)); av[kk] = __builtin_bit_cast(bf16x8, w); }
            } else { const bf16* arow = H + (size_t)(grp * 16 + c16) * DM + 8 * q4;
#pragma unroll
                for (int kk = 0; kk < 8; ++kk) av[kk] = *(const GAS bf16x8*)(arow + k0 + 32 * kk); }
#pragma unroll
            for (int kk = 0; kk < 8; ++kk) acc = MFMA16(av[kk], *(const LAS bf16x8*)(WgT + c16 * 1032 + k0 + 32 * kk + 8 * q4), acc);
        }
        if (P_I8) {
#pragma unroll
            for (int j = 0; j < 4; ++j) acc[j] *= rsg[j]; }
#pragma unroll
        for (int j = 0; j < 4; ++j) { float v = acc[j] + gbias; if ((c16 >> 2) & 1) v = logsig(v); Gt[(size_t)(grp * 16 + 4 * q4 + j) * 16 + c16] = v; }
    }
    __syncthreads();
}
__device__ __forceinline__ void phase_norm2(Frame& F, CAP a, int L) {
    const float* nw = ain(a, 7) + L * DM;
    const float* mods = (const float*)(F.ws + WS_MODS) + (size_t)L * 5 * 6144;
    unsigned char* H8 = F.ws + WS_HY; const bf16* T = (const bf16*)(F.ws + WS_P);
    float* RS = (float*)(F.ws + WS_ROUTE + RT_ROWSC);
    static_assert(DENSE_I8 == 1, "phase_norm2 writes int8 rows");
    if (2 * F.gw < NB * TC) {
        const float* mv = mods + 4 * 6144;
        const RowPar Pc = load_par(mv + 2 * 1024, nw, mv + 3 * 1024, mv + 4 * 1024, F.lane);
        for (int rc = 2 * F.gw; rc < NB * TC; rc += 2 * F.NGW) {
            const int b = rc / TC, tp = rc - b * TC, r = b * TT + tp;
            const float* src = ain(a, 2) + (size_t)rc * DM; unsigned char* dst = F.ws + WS_CTXRES + (size_t)rc * RP;
            const float* S = (const float*)(F.ws + WS_SLAB_CW) + (size_t)rc * DM;
            const RowIn I0 = load_row_slabs<false>(src, S, NS_CW, (size_t)1024 * 1024, F.lane), I1 = load_row_slabs<false>(src + DM, S + DM, NS_CW, (size_t)1024 * 1024, F.lane);
            const RowVec R0 = finish_row(I0, true, Pc, dst, F.lane), R1 = finish_row(I1, true, Pc, dst + RP, F.lane);
            store_row_i8(H8 + (size_t)r * DM, RS + r, R0, F.lane); store_row_i8(H8 + (size_t)(r + 1) * DM, RS + r + 1, R1, F.lane);
        }
    }
    const int b = F.gw & 3, wpb = F.NGW >> 2;
    const float* mv = mods + b * 6144;
    const RowPar P = load_par(mv + 2 * 1024, nw, mv + 3 * 1024, mv + 4 * 1024, F.lane);
    const float* xin = ain(a, 0) + (size_t)b * TL * DM; unsigned char* xres = F.ws + WS_RESID + (size_t)b * TL * RP;
    const bf16* Tb = T + ((size_t)b * TT + TC) * DM;
    int t = 2 * (F.gw >> 2);
    RowRaw<true> N0, N1;
    if (t < TL) { N0 = load_raw<true>(xres + (size_t)t * RP, nullptr, F.lane); N1 = load_raw<true>(xres + (size_t)(t + 1) * RP, nullptr, F.lane); }
#pragma unroll 1
    for (; t < TL; t += 2 * wpb) {
        const RowRaw<true> W0 = N0, W1 = N1; const int tn = t + 2 * wpb;
        if (tn < TL) { N0 = load_raw<true>(xres + (size_t)tn * RP, nullptr, F.lane); N1 = load_raw<true>(xres + (size_t)(tn + 1) * RP, nullptr, F.lane); }
        const int r = b * TT + TC + t;
        const RowVec R0 = finish_row(cook<true>(W0), false, P, nullptr, F.lane), R1 = finish_row(cook<true>(W1), false, P, nullptr, F.lane);
        store_row_i8(H8 + (size_t)r * DM, RS + r, R0, F.lane); store_row_i8(H8 + (size_t)(r + 1) * DM, RS + r + 1, R1, F.lane);
    }
}
struct FinRaw { unsigned long long x[4], e0[4], e1[4]; };
__device__ __forceinline__ FinRaw fin_load(const unsigned char* xrow, const bf16* AS, int p0, int p1, int lane) {
    FinRaw R; const GAS unsigned long long* xr = (const GAS unsigned long long*)xrow + lane;
    const GAS unsigned long long* e0 = (const GAS unsigned long long*)(AS + (size_t)p0 * DM) + lane; const GAS unsigned long long* e1 = (const GAS unsigned long long*)(AS + (size_t)p1 * DM) + lane;
#pragma unroll
    for (int j = 0; j < 4; ++j) R.x[j] = xr[64 * j];
    if (p0 < 65536) {
#pragma unroll
        for (int j = 0; j < 4; ++j) R.e0[j] = e0[64 * j]; }
    else {
#pragma unroll
        for (int j = 0; j < 4; ++j) R.e0[j] = 0ull; }
    if (p1 < 65536) {
#pragma unroll
        for (int j = 0; j < 4; ++j) R.e1[j] = e1[64 * j]; }
    else {
#pragma unroll
        for (int j = 0; j < 4; ++j) R.e1[j] = 0ull; }
    return R;
}
__device__ __forceinline__ void fin_row(const FinRaw& W, int p0, int p1, float g0, float g1, const f32x4 (&G)[4], const f32x4 (&Wn)[4], const float* MT, float* orow, int lane) {
    f32x4 v0[4], v1[4], x[4]; float ss = 0.f;
#pragma unroll
    for (int j = 0; j < 4; ++j) { v0[j] = bf4(W.e0[j]); v1[j] = bf4(W.e1[j]); }
    if (p0 >= 65536) {
#pragma unroll 1
        for (int s_ = 0; s_ < NS_MT; ++s_) { const GAS f32x4* sr = (const GAS f32x4*)(MT + ((size_t)s_ * MT_TILES * 256 + (p0 - 65536)) * DM) + lane;
#pragma unroll
            for (int j = 0; j < 4; ++j) v0[j] += sr[64 * j]; } }
    if (p1 >= 65536) {
#pragma unroll 1
        for (int s_ = 0; s_ < NS_MT; ++s_) { const GAS f32x4* sr = (const GAS f32x4*)(MT + ((size_t)s_ * MT_TILES * 256 + (p1 - 65536)) * DM) + lane;
#pragma unroll
            for (int j = 0; j < 4; ++j) v1[j] += sr[64 * j]; } }
#pragma unroll
    for (int j = 0; j < 4; ++j) { x[j] = bf4(W.x[j]) + G[j] * (v0[j] * g0 + v1[j] * g1); ss += dot4(x[j], x[j]); }
    const float rinv = rsqrtf(wave_sum(ss, lane) * (1.f / DM) + EPS);
    GAS f32x4* xw = (GAS f32x4*)orow + lane;
#pragma unroll
    for (int j = 0; j < 4; ++j) xw[64 * j] = x[j] * rinv * Wn[j];
}
__device__ __forceinline__ void phase_final(Frame& F, CAP a) {
    const float* nw = ain(a, 21);
    const int b = F.gw & 3, wpb = F.NGW >> 2;
    const float* gv = (const float*)(F.ws + WS_MODS) + (size_t)5 * 6144 + 5 * 1024 + b * 6144;
    f32x4 G[4], Wn[4];
#pragma unroll
    for (int j = 0; j < 4; ++j) { G[j] = *(const f32x4*)(gv + 256 * j + 4 * F.lane); Wn[j] = *(const f32x4*)(nw + 256 * j + 4 * F.lane); }
    const int* TOKPOS = (const int*)(F.ws + WS_ROUTE + RT_ROWTOK) + (size_t)2 * b * TL; const float* TOKG = (const float*)(F.ws + WS_ROUTE + RT_TOKG) + (size_t)2 * b * TL;
    const bf16* AS = (const bf16*)(F.ws + WS_EOUT); const float* MT = (const float*)(F.ws + WS_SLAB_MT);
    float* out = aout(a) + (size_t)b * TL * DM; const unsigned char* xres = F.ws + WS_RESID + (size_t)b * TL * RP;
    typedef int i32x4v __attribute__((ext_vector_type(4)));
    int t = 2 * (F.gw >> 2);
    if (t >= TL) return;
    i32x4v pc = *(const GAS i32x4v*)(TOKPOS + 2 * t); f32x4 gc = *(const GAS f32x4*)(TOKG + 2 * t);
    int q0 = __builtin_amdgcn_readfirstlane(pc.x), q1 = __builtin_amdgcn_readfirstlane(pc.y), q2 = __builtin_amdgcn_readfirstlane(pc.z), q3 = __builtin_amdgcn_readfirstlane(pc.w);
    FinRaw N0 = fin_load(xres + (size_t)t * RP, AS, q0, q1, F.lane), N1 = fin_load(xres + (size_t)(t + 1) * RP, AS, q2, q3, F.lane);
    i32x4v pn = pc; f32x4 gn = gc;
    if (t + 2 * wpb < TL) { pn = *(const GAS i32x4v*)(TOKPOS + 2 * (t + 2 * wpb)); gn = *(const GAS f32x4*)(TOKG + 2 * (t + 2 * wpb)); }
#pragma unroll 1
    for (; t < TL; t += 2 * wpb) {
        const FinRaw W0 = N0, W1 = N1; const int c0 = q0, c1 = q1, c2 = q2, c3 = q3; const f32x4 gw_ = gc;
        const int tn = t + 2 * wpb;
        if (tn < TL) {
            q0 = __builtin_amdgcn_readfirstlane(pn.x); q1 = __builtin_amdgcn_readfirstlane(pn.y); q2 = __builtin_amdgcn_readfirstlane(pn.z); q3 = __builtin_amdgcn_readfirstlane(pn.w); gc = gn;
            N0 = fin_load(xres + (size_t)tn * RP, AS, q0, q1, F.lane); N1 = fin_load(xres + (size_t)(tn + 1) * RP, AS, q2, q3, F.lane);
            if (tn + 2 * wpb < TL) { pn = *(const GAS i32x4v*)(TOKPOS + 2 * (tn + 2 * wpb)); gn = *(const GAS f32x4*)(TOKG + 2 * (tn + 2 * wpb)); }
        }
        fin_row(W0, c0, c1, gw_.x, gw_.y, G, Wn, MT, out + (size_t)t * DM, F.lane);
        fin_row(W1, c2, c3, gw_.z, gw_.w, G, Wn, MT, out + (size_t)(t + 1) * DM, F.lane);
    }
}

__device__ __forceinline__ void unpack8(v4u raw, float (&x)[8]) {
    x[0] = bflo(raw.x); x[1] = bfhi(raw.x); x[2] = bflo(raw.y); x[3] = bfhi(raw.y); x[4] = bflo(raw.z); x[5] = bfhi(raw.z); x[6] = bflo(raw.w); x[7] = bfhi(raw.w);
}
__device__ __forceinline__ v4u pack8(const float (&x)[8]) { v4u o; o.x = pk2(x[0], x[1]); o.y = pk2(x[2], x[3]); o.z = pk2(x[4], x[5]); o.w = pk2(x[6], x[7]); return o; }
__device__ __forceinline__ void phase_qknorm(Frame& F, CAP a, int L) {
    const bf16* P = (const bf16*)(F.ws + WS_P); bf16* KN = (bf16*)(F.ws + WS_KN);
    const int l16 = F.lane & 15, l8 = F.lane & 7, rsub = F.lane >> 4;
    float kwv[8], invf[4];
#pragma unroll
    for (int e = 0; e < 8; ++e) kwv[e] = ain(a, 12)[L * 64 + 8 * l8 + e];
#pragma unroll
    for (int p = 0; p < 4; ++p) invf[p] = __builtin_amdgcn_exp2f(-(float)((4 * l8 + p) & 15) * 0.83048202372184058f);
    const bool use_row = l8 < 4;
    for (int r0 = 16 * F.gw; r0 < MROWS; r0 += 16 * F.NGW) {
        v4u rk[4];
#pragma unroll
        for (int q = 0; q < 4; ++q) rk[q] = *(const GAS v4u*)(P + (size_t)(r0 + 4 * q + rsub) * NP + CAK + 8 * l16);
#pragma unroll
        for (int q = 0; q < 4; ++q) {
            const int r = r0 + 4 * q + rsub, b = r / TT, tp = r - b * TT, t = tp - TC;
            const float pos = tp >= TC ? (float)(use_row ? (t >> 6) : (t & 63)) : 0.f;
            float x[8]; unpack8(rk[q], x);
            float ss = 0.f;
#pragma unroll
            for (int e = 0; e < 8; ++e) ss += x[e] * x[e];
            ss += shx(ss, 1, F.lane); ss += shx(ss, 2, F.lane); ss += shx(ss, 4, F.lane);
            const float rinv = rsqrtf(ss * (1.f / 64.f) + EPS);
#pragma unroll
            for (int p = 0; p < 4; ++p) { const float ang = pos * invf[p], cs = __cosf(ang), sn = __sinf(ang);
                const float xe = x[2 * p] * rinv * kwv[2 * p], xo = x[2 * p + 1] * rinv * kwv[2 * p + 1]; x[2 * p] = xe * cs - xo * sn; x[2 * p + 1] = xe * sn + xo * cs; }
            *(GAS v4u*)(KN + (size_t)r * 128 + 8 * l16) = pack8(x);
        }
    }
}

__device__ __forceinline__ int scan_ci(int tb, int dir) { return dir == 0 ? tb : (tb < 2 ? 1 - tb : 67 - tb); }

__device__ __forceinline__ void phase_mlstm_local(Frame& F, CAP a, int L) {
    LAS bf16* Vs = (LAS bf16*)(F.lds);
    LAS bf16* KF = (LAS bf16*)(F.lds + 36864);
    LAS bf16* KB = (LAS bf16*)(F.lds + 55296);
    LAS float* GL = (LAS float*)(F.lds + 73728);
    LAS float* WV = (LAS float*)(F.lds + 75776);
    const bf16* P = (const bf16*)(F.ws + WS_P); const float* Gt = (const float*)(F.ws + WS_GATES);
    bf16* CSTC = (bf16*)(F.ws + WS_CSTC); float* CSTN = (float*)(F.ws + WS_CSTN); float* CSTM = (float*)(F.ws + WS_CSTM);
    const int lane = F.lane, tid = F.tid, wave = F.wave, q4 = lane >> 4, c16 = lane & 15;
    for (int u = blockIdx.x; u < NB * 4 * NBLK; u += F.G) {
        const int tb = u % NBLK, bh = u / NBLK, b = bh >> 2, h = bh & 3;
        const int r0 = b * TT + 128 * tb;
        v4u rv[4], rk[2];
#pragma unroll
        for (int i = 0; i < 4; ++i) { const int q = tid + 512 * i, s = q >> 4, dc = q & 15; rv[i] = *(const GAS v4u*)(P + (size_t)(r0 + s) * NP + CV + h * 128 + dc * 8); }
#pragma unroll
        for (int i = 0; i < 2; ++i) { const int q = tid + 512 * i, s = q >> 3, kc = q & 7; rk[i] = *(const GAS v4u*)(P + (size_t)(r0 + s) * NP + CK + h * 64 + kc * 8); }
        { const int g = tid >> 7, i = tid & 127; GL[g * 128 + i] = Gt[(size_t)(r0 + i) * 16 + g * 4 + h]; }
        __syncthreads();
        if (wave < 2) {
            const int dir = wave;
            const float lf0 = GL[(1 + 2 * dir) * 128 + 2 * lane], lf1 = GL[(1 + 2 * dir) * 128 + 2 * lane + 1];
            const float ig0 = GL[(2 * dir) * 128 + 2 * lane], ig1 = GL[(2 * dir) * 128 + 2 * lane + 1];
            const float s = lf0 + lf1, inc = wave_incl_scan_add(s, lane), tot = shi(inc, 63), exc = inc - s;
            float wl0, wl1;
            if (dir == 0) { wl0 = (tot - (exc + lf0)) + ig0; wl1 = (tot - inc) + ig1; }
            else          { wl0 = exc + ig0;                 wl1 = (exc + lf0) + ig1; }
            const float ml = wave_max(fmaxf(wl0, wl1), lane);
            WV[dir * 128 + 2 * lane] = __expf(wl0 - ml); WV[dir * 128 + 2 * lane + 1] = __expf(wl1 - ml);
            if (lane == 0) { const int sidx = (bh * 2 + dir) * NBLK + scan_ci(tb, dir); CSTM[sidx * 2] = ml; CSTM[sidx * 2 + 1] = tot; }
        }
        else if (wave < 4) {
            const int dir = wave - 2;
            const int ta = dir ? 127 - 2 * lane : 2 * lane, tc = dir ? 126 - 2 * lane : 2 * lane + 1;
            const float lf0 = GL[(1 + 2 * dir) * 128 + ta], lf1 = GL[(1 + 2 * dir) * 128 + tc], ig0 = GL[(2 * dir) * 128 + ta], ig1 = GL[(2 * dir) * 128 + tc];
            const float s = lf0 + lf1, inc = wave_incl_scan_add(s, lane), exc = inc - s;
            const float b0 = exc + lf0, b1 = inc, g0 = ig0 - b0, g1 = ig1 - b1;
            const float mx1 = fmaxf(g0, g1), pm = wave_incl_scan_max(mx1, lane);
            float pe = shu(pm, 1, lane); if (lane == 0) pe = -INFINITY;
            typedef float f32x2g __attribute__((ext_vector_type(2)));
            GAS f32x2g* gp = (GAS f32x2g*)(F.ws + WS_GPRE) + (size_t)((bh * 2 + dir) * NBLK + tb) * 128;
            gp[ta] = (f32x2g){g0, fmaxf(pe, g0)}; gp[tc] = (f32x2g){g1, pm};
        }
#pragma unroll
        for (int i = 0; i < 4; ++i) { const int q = tid + 512 * i, s = q >> 4, dc = q & 15; *(LAS v4u*)(Vs + s * 144 + dc * 8) = rv[i]; }
        { const int s = tid >> 2, part = tid & 3; *(LAS unsigned long long*)(Vs + s * 144 + 128 + 4 * part) = part == 0 ? 0x3F80ull : 0ull; }
        __syncthreads();
#pragma unroll
        for (int i = 0; i < 2; ++i) { const int q = tid + 512 * i, s = q >> 3, kc = q & 7;
            float kv[8], o[8]; unpack8(rk[i], kv);
            const float wf = WV[s], wb = WV[128 + s];
#pragma unroll
            for (int e = 0; e < 8; ++e) o[e] = kv[e] * wf;
            *(LAS v4u*)(KF + s * 72 + kc * 8) = pack8(o);
#pragma unroll
            for (int e = 0; e < 8; ++e) o[e] = kv[e] * wb;
            *(LAS v4u*)(KB + s * 72 + kc * 8) = pack8(o); }
        __syncthreads();
        {
            const attn_body::lds_cptr vbase = (attn_body::lds_cptr)Vs + (8 * q4 + (c16 >> 2)) * 288 + 8 * (c16 & 3);
            bf16x8 vf[4], v1[4];
#pragma unroll
            for (int s4 = 0; s4 < 4; ++s4) { const attn_body::s16x4 lo = attn_body::vtr(vbase + 32 * s4 * 288 + 32 * wave), hi = attn_body::vtr(vbase + (32 * s4 + 4) * 288 + 32 * wave);
                vf[s4] = (bf16x8){lo[0], lo[1], lo[2], lo[3], hi[0], hi[1], hi[2], hi[3]};
                const attn_body::s16x4 lo1 = attn_body::vtr(vbase + 32 * s4 * 288 + 32 * 8), hi1 = attn_body::vtr(vbase + (32 * s4 + 4) * 288 + 32 * 8);
                v1[s4] = (bf16x8){lo1[0], lo1[1], lo1[2], lo1[3], hi1[0], hi1[1], hi1[2], hi1[3]}; }
#pragma unroll
            for (int dir = 0; dir < 2; ++dir) {
                const attn_body::lds_cptr kbase = (attn_body::lds_cptr)(dir ? KB : KF) + (8 * q4 + (c16 >> 2)) * 144 + 8 * (c16 & 3);
                const int sidx = (bh * 2 + dir) * NBLK + scan_ci(tb, dir);
                bf16* cdst = CSTC + (size_t)sidx * 8192;
#pragma unroll
                for (int kt = 0; kt < 4; ++kt) {
                    f32x4 acc = (f32x4){0.f, 0.f, 0.f, 0.f}, accn = acc;
                    const bool mine = (kt == (wave & 3)) && (dir == (wave >> 2));
#pragma unroll
                    for (int s4 = 0; s4 < 4; ++s4) { const attn_body::s16x4 lo = attn_body::vtr(kbase + 32 * s4 * 144 + 32 * kt), hi = attn_body::vtr(kbase + (32 * s4 + 4) * 144 + 32 * kt);
                        const bf16x8 kf = (bf16x8){lo[0], lo[1], lo[2], lo[3], hi[0], hi[1], hi[2], hi[3]};
                        acc = MFMA16(kf, vf[s4], acc);
                        if (mine) accn = MFMA16(kf, v1[s4], accn); }
                    *(GAS unsigned long long*)(cdst + (16 * wave + c16) * 64 + 16 * kt + 4 * q4) = (unsigned long long)pk2(acc[0], acc[1]) | ((unsigned long long)pk2(acc[2], acc[3]) << 32);
                    if (mine && c16 == 0) *(GAS f32x4*)(CSTN + (size_t)sidx * 64 + 16 * kt + 4 * q4) = accn;
                }
            }
        }
        __syncthreads();
    }
}

template <bool PROBE> __device__ __forceinline__ void phase_scan(Frame& F) {
    unsigned* CSTC = (unsigned*)(F.ws + WS_CSTC); float* CSTN = (float*)(F.ws + WS_CSTN); const float* CSTM = (const float*)(F.ws + WS_CSTM); float* CSTE = (float*)(F.ws + WS_CSTE);
    const int tid = F.tid;
    for (int u = blockIdx.x; u < NSEQ * 8; u += F.G) {
        const int seq = u >> 3, js = u & 7; const bool nown = (js == 0 && tid < 64);
        float C0 = 0.f, C1 = 0.f, n = 0.f, m = 0.f;
        unsigned* cb = CSTC + (size_t)seq * NBLK * 4096 + js * 512 + tid;
        constexpr int SB = 11;
        unsigned cl[2][SB]; float ml[2][SB], g[2][SB], nl[2][SB];
#define SCAN_LOAD(buf, c0) do { _Pragma("unroll") for (int i = 0; i < SB; ++i) { const size_t si = (size_t)seq * NBLK + (c0) + i; cl[buf][i] = cb[(size_t)((c0) + i) * 4096]; \
            ml[buf][i] = CSTM[si * 2]; g[buf][i] = CSTM[si * 2 + 1]; nl[buf][i] = nown ? CSTN[si * 64 + tid] : 0.f; } } while (0)
#define SCAN_STEP(buf, c0) do { _Pragma("unroll") for (int i = 0; i < SB; ++i) { const size_t si = (size_t)seq * NBLK + (c0) + i; \
            const float mnew = fmaxf(g[buf][i] + m, ml[buf][i]), aa = __expf(g[buf][i] + m - mnew), sv = __expf(ml[buf][i] - mnew); \
            cb[(size_t)((c0) + i) * 4096] = PROBE ? cl[buf][i] : pk2(C0, C1); \
            if (nown) CSTN[si * 64 + tid] = PROBE ? nl[buf][i] : n; \
            if (!PROBE && js == 0 && tid == 0) CSTE[si] = m; \
            C0 = aa * C0 + sv * bflo(cl[buf][i]); C1 = aa * C1 + sv * bfhi(cl[buf][i]); n = aa * n + sv * nl[buf][i]; m = mnew; } } while (0)
        SCAN_LOAD(0, 0);
#pragma unroll
        for (int k = 0; k < NBLK / SB; ++k) {
            if (k + 1 < NBLK / SB) { if ((k & 1) == 0) SCAN_LOAD(1, (k + 1) * SB); else SCAN_LOAD(0, (k + 1) * SB); }
            if ((k & 1) == 0) SCAN_STEP(0, k * SB); else SCAN_STEP(1, k * SB);
        }
#undef SCAN_LOAD
#undef SCAN_STEP
    }
}

template <int PRB  > __device__ __forceinline__ void phase_mlstm_out(Frame& F, CAP a, int L) {
    LAS bf16* Qs = (LAS bf16*)(F.lds);
    LAS bf16* Ks = (LAS bf16*)(F.lds + 18432);
    LAS bf16* Vs = (LAS bf16*)(F.lds + 36864);
    LAS bf16* Es = (LAS bf16*)(F.lds + 73728);
    LAS bf16* Sm = (LAS bf16*)(F.lds + 111168) + F.wave * (128 * 16);
    LAS float* GL = (LAS float*)(F.lds + 143936);
    LAS float* VG = (LAS float*)(F.lds + 145984);
    LAS float* Hs = (LAS float*)(F.lds + 36864);
    const bf16* P = (const bf16*)(F.ws + WS_P); const float* Gt = (const float*)(F.ws + WS_GATES);
    const bf16* CSTC = (const bf16*)(F.ws + WS_CSTC); const float* CSTN = (const float*)(F.ws + WS_CSTN); const float* CSTE = (const float*)(F.ws + WS_CSTE);
    bf16* Y = (bf16*)(F.ws + WS_HY);
    const float* mnw = ain(a, 10) + L * 512;
    const int wave = F.wave, t0 = 16 * wave;
    const int nblk = (L == 0) ? NBLK : NBLK - 2;
#define MO_LOAD(uu, tid, RMO) do { \
        const int bh_ = (uu) / nblk, tb_ = (uu) % nblk + (NBLK - nblk), b_ = bh_ >> 2, h_ = bh_ & 3, r0_ = b_ * TT + 128 * tb_; \
        const int s0_ = (bh_ * 2 + 0) * NBLK + scan_ci(tb_, 0), s1_ = (bh_ * 2 + 1) * NBLK + scan_ci(tb_, 1); \
        _Pragma("unroll") for (int i = 0; i < 2; ++i) { const int q = (tid) + 512 * i, s = q >> 3, c = q & 7; \
            rq[i] = *(const GAS v4u*)(P + (size_t)(r0_ + s) * NP + CQ + h_ * 64 + c * 8); rk[i] = *(const GAS v4u*)(P + (size_t)(r0_ + s) * NP + CK + h_ * 64 + c * 8); } \
        _Pragma("unroll") for (int i = 0; i < 4; ++i) { const int q = (tid) + 512 * i, s = q >> 4, dc = q & 15; rv[i] = *(const GAS v4u*)(P + (size_t)(r0_ + s) * NP + CV + h_ * 128 + dc * 8); } \
        gval = 0.f; gpre = (f32x2m){0.f, 0.f}; \
        if ((tid) < 256) { gval = Gt[(size_t)(r0_ + ((tid) & 127)) * 16 + (2 * ((tid) >> 7)) * 4 + h_]; gpre = *((const GAS f32x2m*)(F.ws + WS_GPRE) + (size_t)((bh_ * 2 + ((tid) >> 7)) * NBLK + tb_) * 128 + ((tid) & 127)); } \
        _Pragma("unroll") for (int i = 0; i < 4; ++i) { const int q = (tid) + 512 * i; RMO[i] = *(const GAS v4u*)(P + (size_t)(r0_ + (q >> 4)) * NP + CO + h_ * 128 + (q & 15) * 8); } \
        _Pragma("unroll") for (int i = 0; i < 4; ++i) { const int idx = (tid) + 512 * i; e0[i] = *(const GAS unsigned long long*)(CSTC + (size_t)s0_ * 8192 + idx * 4); e1[i] = *(const GAS unsigned long long*)(CSTC + (size_t)s1_ * 8192 + idx * 4); } \
        n0 = (f32x4){0.f, 0.f, 0.f, 0.f}; n1 = n0; \
        if ((tid) < 16) n0 = *(const GAS f32x4*)(CSTN + (size_t)s0_ * 64 + (tid) * 4); else if ((tid) < 32) n1 = *(const GAS f32x4*)(CSTN + (size_t)s1_ * 64 + ((tid) - 16) * 4); \
        me0 = CSTE[s0_]; me1 = CSTE[s1_]; } while (0)
    typedef float f32x2m __attribute__((ext_vector_type(2)));
    v4u rq[2], rk[2], rv[4], rmo[4], rmo_n[4]; unsigned long long e0[4], e1[4]; f32x4 n0, n1; float gval, me0, me1; f32x2m gpre;
    if ((int)blockIdx.x < NB * 4 * nblk) { int t0_ = F.tid; asm volatile("" : "+v"(t0_)); MO_LOAD((int)blockIdx.x, t0_, rmo); }
    for (int u = blockIdx.x; u < NB * 4 * nblk; u += F.G) {
        int tid_ = F.tid; asm volatile("" : "+v"(tid_));
        const int tid = tid_, lane = tid & 63, q4 = lane >> 4, c16 = lane & 15;
        const int bh = u / nblk, tb = u % nblk + (NBLK - nblk), b = bh >> 2, h = bh & 3;
        const int r0 = b * TT + 128 * tb;
        const int sidx0 = (bh * 2 + 0) * NBLK + scan_ci(tb, 0), sidx1 = (bh * 2 + 1) * NBLK + scan_ci(tb, 1);
        { const int s = tid >> 2, part = tid & 3; *(LAS unsigned long long*)(Vs + s * 144 + 128 + 4 * part) = part == 0 ? 0x3F80ull : 0ull; }
#pragma unroll
        for (int i = 0; i < 2; ++i) { const int q = tid + 512 * i, s = q >> 3, c = q & 7; *(LAS v4u*)(Qs + s * 72 + c * 8) = rq[i]; *(LAS v4u*)(Ks + s * 72 + c * 8) = rk[i]; }
#pragma unroll
        for (int i = 0; i < 4; ++i) { const int q = tid + 512 * i, s = q >> 4, dc = q & 15; *(LAS v4u*)(Vs + s * 144 + dc * 8) = rv[i]; }
        if (tid < 256) { LAS float* V_ = VG + 512 * (tid >> 7); const int t_ = tid & 127;
            const float me = (tid >> 7) ? me1 : me0, g_ = gpre.x, M_ = fmaxf(me, gpre.y), b_ = gval - g_;
            V_[t_] = g_; V_[128 + t_] = M_; V_[256 + t_] = __expf(me - M_); V_[384 + t_] = __expf(-(b_ + M_)); }
#pragma unroll
        for (int i = 0; i < 4; ++i) { const int idx = tid + 512 * i, d = idx >> 4, c4 = idx & 15; *(LAS unsigned long long*)(Es + d * 72 + c4 * 4) = e0[i]; *(LAS unsigned long long*)(Es + 130 * 72 + d * 72 + c4 * 4) = e1[i]; }
        if (tid < 16) *(LAS unsigned long long*)(Es + 128 * 72 + tid * 4) = (unsigned long long)pk2(n0.x, n0.y) | ((unsigned long long)pk2(n0.z, n0.w) << 32);
        else if (tid < 32) *(LAS unsigned long long*)(Es + 130 * 72 + 128 * 72 + (tid - 16) * 4) = (unsigned long long)pk2(n1.x, n1.y) | ((unsigned long long)pk2(n1.z, n1.w) << 32);
        __syncthreads();
        f32x4 hsum[8];
#pragma unroll
        for (int ct = 0; ct < 8; ++ct) hsum[ct] = (f32x4){0.f, 0.f, 0.f, 0.f};
#pragma unroll 1
        for (int dir = 0; dir < ((PRB & 1) ? 0 : 2); ++dir) {
            const LAS float* V_ = VG + 512 * dir;
            const LAS bf16* Ed = Es + dir * (130 * 72);
            float Mr[4], ar[4], er[4];
#pragma unroll
            for (int j = 0; j < 4; ++j) { const int t = t0 + 4 * q4 + j; Mr[j] = V_[128 + t]; ar[j] = V_[256 + t] * 0.125f; er[j] = V_[384 + t]; }
            bf16x8 qa[2];
#pragma unroll
            for (int k = 0; k < 2; ++k) qa[k] = *(const LAS bf16x8*)(Qs + (t0 + c16) * 72 + 32 * k + 8 * q4);
            const int slo = dir ? (wave >> 1) : 0, shi_ = dir ? 3 : (wave >> 1);
#pragma unroll
            for (int st = 0; st < 8; ++st) if ((st >> 1) >= slo && (st >> 1) <= shi_) {
                f32x4 acc = (f32x4){0.f, 0.f, 0.f, 0.f};
#pragma unroll
                for (int k = 0; k < 2; ++k) acc = MFMA16(qa[k], *(const LAS bf16x8*)(Ks + (16 * st + c16) * 72 + 32 * k + 8 * q4), acc);
                const int s = 16 * st + c16; const float gs = V_[s];
                float w[4];
#pragma unroll
                for (int j = 0; j < 4; ++j) { const int t = t0 + 4 * q4 + j; const bool ok = dir == 0 ? (s <= t) : (s >= t); w[j] = ok ? acc[j] * 0.125f * __expf(gs - Mr[j]) : 0.f; }
                *(LAS unsigned long long*)(Sm + s * 16 + 4 * q4) = (unsigned long long)pg8::cvt_pk_bf16(w[0], w[1]) | ((unsigned long long)pg8::cvt_pk_bf16(w[2], w[3]) << 32);
            }
            bf16x8 sa[4];
            { const attn_body::lds_cptr sp = (attn_body::lds_cptr)Sm + (8 * q4 + (c16 >> 2)) * 32 + 8 * (c16 & 3);
#pragma unroll
              for (int s4 = 0; s4 < 4; ++s4) { const attn_body::s16x4 lo = attn_body::vtr(sp + 32 * s4 * 32), hi = attn_body::vtr(sp + (32 * s4 + 4) * 32);
                  sa[s4] = (bf16x8){lo[0], lo[1], lo[2], lo[3], hi[0], hi[1], hi[2], hi[3]}; } }
            f32x4 res[9];
#pragma unroll
            for (int ct = 0; ct < 9; ++ct) {
                f32x4 acc1 = (f32x4){0.f, 0.f, 0.f, 0.f}, acc2 = (f32x4){0.f, 0.f, 0.f, 0.f};
#pragma unroll
                for (int s4 = 0; s4 < 4; ++s4) if (s4 >= slo && s4 <= shi_)
                { const attn_body::lds_cptr vp = (attn_body::lds_cptr)Vs + (32 * s4 + 8 * q4 + (c16 >> 2)) * 288 + 32 * ct + 8 * (c16 & 3);
                    const attn_body::s16x4 lo = attn_body::vtr(vp), hi = attn_body::vtr(vp + 4 * 288);
                    acc1 = MFMA16(sa[s4], ((bf16x8){lo[0], lo[1], lo[2], lo[3], hi[0], hi[1], hi[2], hi[3]}), acc1); }
#pragma unroll
                for (int k = 0; k < 2; ++k) acc2 = MFMA16(qa[k], *(const LAS bf16x8*)(Ed + (16 * ct + c16) * 72 + 32 * k + 8 * q4), acc2);
#pragma unroll
                for (int j = 0; j < 4; ++j) res[ct][j] = acc1[j] + ar[j] * acc2[j];
                if (ct % 3 == 2) asm volatile("" ::: "memory");
            }
#pragma unroll
            for (int j = 0; j < 4; ++j) { const float den = shi(res[8][j], lane & 48); const float inv = __builtin_amdgcn_rcpf(fmaxf(fabsf(den), er[j]));
#pragma unroll
                for (int ct = 0; ct < 8; ++ct) hsum[ct][j] += res[ct][j] * inv; }
        }
        { const int un_ = (u + F.G < NB * 4 * nblk) ? u + F.G : u; MO_LOAD(un_, tid, rmo_n); }
        const f32x4 wa = *(const f32x4*)(mnw + h * 128 + (tid & 15) * 8), wb = *(const f32x4*)(mnw + h * 128 + (tid & 15) * 8 + 4);
        __syncthreads();
#pragma unroll
        for (int j = 0; j < 4; ++j) {
            float ss = 0.f;
#pragma unroll
            for (int ct = 0; ct < 8; ++ct) ss += hsum[ct][j] * hsum[ct][j];
            ss += WAVE_DPP(ss, 0xB1); ss += WAVE_DPP(ss, 0x4E); ss += WAVE_DPP(ss, 0x141); ss += WAVE_DPP(ss, 0x140);
            const float rinv = rsqrtf(ss * (1.f / 128.f) + EPS);
#pragma unroll
            for (int ct = 0; ct < 8; ++ct) Hs[(t0 + 4 * q4 + j) * 132 + 16 * ct + c16] = hsum[ct][j] * rinv;
        }
        __syncthreads();
#pragma unroll
        for (int i = 0; i < ((PRB & 2) ? 0 : 4); ++i) { const int q = tid + 512 * i, t = q >> 4, c = q & 15; const size_t r = (size_t)(r0 + t);
            float mo[8]; unpack8(rmo[i], mo);
            const f32x4 ha = *(const LAS f32x4*)(Hs + t * 132 + c * 8), hb = *(const LAS f32x4*)(Hs + t * 132 + c * 8 + 4);
            float o[8];
            o[0] = ha.x * wa.x * __builtin_amdgcn_rcpf(1.f + __expf(-mo[0])); o[1] = ha.y * wa.y * __builtin_amdgcn_rcpf(1.f + __expf(-mo[1]));
            o[2] = ha.z * wa.z * __builtin_amdgcn_rcpf(1.f + __expf(-mo[2])); o[3] = ha.w * wa.w * __builtin_amdgcn_rcpf(1.f + __expf(-mo[3]));
            o[4] = hb.x * wb.x * __builtin_amdgcn_rcpf(1.f + __expf(-mo[4])); o[5] = hb.y * wb.y * __builtin_amdgcn_rcpf(1.f + __expf(-mo[5]));
            o[6] = hb.z * wb.z * __builtin_amdgcn_rcpf(1.f + __expf(-mo[6])); o[7] = hb.w * wb.w * __builtin_amdgcn_rcpf(1.f + __expf(-mo[7]));
            *(GAS v4u*)(Y + r * DM + h * 128 + c * 8) = pack8(o); }
#pragma unroll
        for (int i = 0; i < 4; ++i) rmo[i] = rmo_n[i];
        __syncthreads();
    }
#undef MO_LOAD
}

__device__ __forceinline__ void phase_attn(Frame& F, CAP a, int L, char* lds_generic) {
    const attn_body::bf16* KN = (const attn_body::bf16*)(F.ws + WS_KN);
    const attn_body::bf16* P = (const attn_body::bf16*)(F.ws + WS_P); attn_body::bf16* Y = (attn_body::bf16*)(F.ws + WS_HY);
    const float* qw = ain(a, 11) + L * 64;
    float mq = 0.f, mk = 0.f;
    { f32x4 qv[16], kv[16]; const float* kw = ain(a, 12) + L * 64;
#pragma unroll
      for (int d = 0; d < 16; ++d) { qv[d] = *(const GAS f32x4*)(qw + 4 * d); kv[d] = *(const GAS f32x4*)(kw + 4 * d); }
#pragma unroll
      for (int d = 0; d < 16; ++d) { mq = fmaxf(fmaxf(mq, fmaxf(fabsf(qv[d].x), fabsf(qv[d].y))), fmaxf(fabsf(qv[d].z), fabsf(qv[d].w))); mk = fmaxf(fmaxf(mk, fmaxf(fabsf(kv[d].x), fabsf(kv[d].y))), fmaxf(fabsf(kv[d].z), fabsf(kv[d].w))); } }
    const float negB = -(8.f * mq * mk * 1.4426950408889634f * 1.03f + 0.25f);
    bool conv_pending = (L == 0);
    for (int v = F.vcu; v < 256; v += F.G)
        for (int i = 0; i < 5; ++i) {
            if (i == 4 && !(L == 0 && (v & 7) == 0)) break;
            if (conv_pending && i == (v & 3)) { conv_pending = false; convert_weights(F, a, I_SMALL, I_MOE, (LAS float*)(F.lds + 86016 + F.wave * 8448)); }
            const int bh = v >> 3, b = bh >> 3, h = bh & 7;
            int qrow0, NT, tok0;
            if (i < 4) { const int qb = ((4 * v + i) & 31); qrow0 = b * TT + TC + qb * 256; NT = TT / 64; tok0 = qb * 256; }
            else { qrow0 = b * TT; NT = TC / 64; tok0 = -1; }
            const size_t krow0 = (size_t)b * TT;
            attn_body::attn_unit<8, true, true>(P + (size_t)qrow0 * NP + CAQ + h * 64, KN + krow0 * 128 + (h >> 2) * 64, P + krow0 * NP + CAV + (h >> 2) * 64,
                                                Y + (size_t)qrow0 * DM + 512 + h * 64, NT, negB, qw, tok0, lds_generic);
        }
    if (conv_pending) convert_weights(F, a, I_SMALL, I_MOE, (LAS float*)(F.lds + 86016 + F.wave * 8448));
}

__device__ __forceinline__ void phase_norm2_route(Frame& F, CAP a) {
    LAS float* rT = (LAS float*)F.lds;
    LAS unsigned* hist = (LAS unsigned*)(F.lds + 32768);
    { float rv_[16];
#pragma unroll
      for (int i = 0; i < 16; ++i) rv_[i] = ain(a, 17)[F.tid + NTHR * i];
#pragma unroll
      for (int i = 0; i < 16; ++i) { const int idx = F.tid + NTHR * i, k = idx >> 3, e = idx & 7; rT[e * 1024 + k] = rv_[i]; } }
    const float* nw = ain(a, 7) + 1 * DM;
    const float* mods = (const float*)(F.ws + WS_MODS) + (size_t)1 * 5 * 6144;
    unsigned char* H2 = F.ws + WS_H2B; const bf16* T = (const bf16*)(F.ws + WS_P);
    int* TOKE = (int*)(F.ws + WS_ROUTE + RT_TOKE); float* TOKG = (float*)(F.ws + WS_ROUTE + RT_TOKG); int* CNT = (int*)(F.ws + WS_ROUTE + RT_CNT);
    for (int tb = blockIdx.x; tb < 256; tb += F.G) {
        if (F.tid < 8) hist[F.tid] = 0u;
        __syncthreads();
        const int tok0 = tb * 128 + F.wave * 16, b = tok0 >> 13;
        const float* mv = mods + b * 6144;
        const RowPar PR = load_par(mv + 2 * 1024, nw, mv + 3 * 1024, mv + 4 * 1024, F.lane);
        unsigned char* xblk = F.ws + WS_RESID + (size_t)tok0 * RP; const bf16* tblk = T + ((size_t)b * TT + TC + (tok0 & (TL - 1))) * DM;
        RowRaw<true> N0 = load_raw<true>(xblk, nullptr, F.lane), N1 = load_raw<true>(xblk + RP, nullptr, F.lane);
#pragma unroll 1
        for (int i = 0; i < 16; i += 2) {
            const int tok = tok0 + i;
            const RowRaw<true> W0 = N0, W1 = N1;
            if (i + 2 < 16) { N0 = load_raw<true>(xblk + (size_t)(i + 2) * RP, nullptr, F.lane); N1 = load_raw<true>(xblk + (size_t)(i + 3) * RP, nullptr, F.lane); }
            unsigned char* xrow = nullptr;
            RowVec R[2];
            R[0] = finish_row(cook<true>(W0), false, PR, xrow, F.lane); R[1] = finish_row(cook<true>(W1), false, PR, xrow, F.lane);
            store_row_fp8(H2 + (size_t)tok * DM, R[0], F.lane); store_row_fp8(H2 + (size_t)(tok + 1) * DM, R[1], F.lane);
            float lg[2][8];
#pragma unroll
            for (int e = 0; e < 8; ++e) { float s0 = 0.f, s1 = 0.f;
#pragma unroll
                for (int j = 0; j < 4; ++j) { const f32x4 w4 = *(const LAS f32x4*)(rT + e * 1024 + 256 * j + 4 * F.lane); s0 += dot4(R[0].h[j], w4); s1 += dot4(R[1].h[j], w4); }
                lg[0][e] = wave_sum(s0, F.lane); lg[1][e] = wave_sum(s1, F.lane); }
#pragma unroll
            for (int q = 0; q < 2; ++q) {
                float v0 = -INFINITY, v1 = -INFINITY; int i0 = 0, i1 = 0;
#pragma unroll
                for (int e = 0; e < 8; ++e) if (lg[q][e] > v0) { v0 = lg[q][e]; i0 = e; }
#pragma unroll
                for (int e = 0; e < 8; ++e) if (e != i0 && lg[q][e] > v1) { v1 = lg[q][e]; i1 = e; }
                if (F.lane == 0) { const float ex = __expf(v1 - v0), g0 = 1.f / (1.f + ex);
                    TOKE[tok + q] = i0 | (i1 << 8); TOKG[2 * (tok + q)] = g0; TOKG[2 * (tok + q) + 1] = ex * g0;
                    __hip_atomic_fetch_add(hist + i0, 1u, __ATOMIC_RELAXED, __HIP_MEMORY_SCOPE_WORKGROUP);
                    __hip_atomic_fetch_add(hist + i1, 1u, __ATOMIC_RELAXED, __HIP_MEMORY_SCOPE_WORKGROUP); }
            }
        }
        __syncthreads();
        if (F.tid < 8) CNT[tb * 8 + F.tid] = (int)hist[F.tid];
        __syncthreads();
    }
}
__device__ __forceinline__ void phase_moe_sort(Frame& F, CAP a) {
    LAS int* gbase = (LAS int*)F.lds;  LAS int* gtot = gbase + 16;  LAS unsigned* cur = (LAS unsigned*)(gbase + 32);  LAS int* postab = gbase + 64;
    const int* TOKE = (const int*)(F.ws + WS_ROUTE + RT_TOKE); const int* CNT = (const int*)(F.ws + WS_ROUTE + RT_CNT);
    int* INFO = (int*)(F.ws + WS_ROUTE + RT_INFO); int* TILEE = (int*)(F.ws + WS_ROUTE + RT_TILEE); int* TOKPOS = (int*)(F.ws + WS_ROUTE + RT_ROWTOK);
    const unsigned char* H2 = F.ws + WS_H2B; unsigned char* AS = F.ws + WS_ASORT;
    for (int tb = blockIdx.x; tb < 256; tb += F.G) {
        if (F.tid < 8) { gtot[F.tid] = 0; cur[F.tid] = 0u; }
        __syncthreads();
        if (F.tid < 256) {
            typedef int i32x4s __attribute__((ext_vector_type(4)));
            const i32x4s c0 = *(const GAS i32x4s*)(CNT + F.tid * 8), c1 = *(const GAS i32x4s*)(CNT + F.tid * 8 + 4);
            const int cv[8] = {c0.x, c0.y, c0.z, c0.w, c1.x, c1.y, c1.z, c1.w};
#pragma unroll
            for (int g = 0; g < 8; ++g) { __hip_atomic_fetch_add(gtot + g, cv[g], __ATOMIC_RELAXED, __HIP_MEMORY_SCOPE_WORKGROUP);
                if (F.tid < tb) __hip_atomic_fetch_add(cur + g, (unsigned)cv[g], __ATOMIC_RELAXED, __HIP_MEMORY_SCOPE_WORKGROUP); } }
        __syncthreads();
        if (F.tid == 0) { int acc = 0; for (int g = 0; g < 8; ++g) { gbase[g] = acc; acc += (gtot[g] + 255) & ~255; } }
        __syncthreads();
        if (F.tid < 8) cur[F.tid] += (unsigned)gbase[F.tid];
        __syncthreads();
        if (F.tid < 128) { const int tok = tb * 128 + F.tid, ee = TOKE[tok], i0 = ee & 255, i1 = ee >> 8;
            const int p0 = (int)__hip_atomic_fetch_add(cur + i0, 1u, __ATOMIC_RELAXED, __HIP_MEMORY_SCOPE_WORKGROUP);
            const int p1 = (int)__hip_atomic_fetch_add(cur + i1, 1u, __ATOMIC_RELAXED, __HIP_MEMORY_SCOPE_WORKGROUP);
            TOKPOS[2 * tok] = p0; TOKPOS[2 * tok + 1] = p1;
            postab[2 * F.tid] = p0; postab[2 * F.tid + 1] = p1; }
        __syncthreads();
#pragma unroll 1
        for (int c = 0; c < 16; c += 8) {
            v4u v[8];
#pragma unroll
            for (int q = 0; q < 8; ++q) v[q] = *((const GAS v4u*)(H2 + (size_t)(tb * 128 + F.wave * 16 + c + q) * DM) + F.lane);
#pragma unroll
            for (int q = 0; q < 8; ++q) { const int p0 = postab[2 * (F.wave * 16 + c + q)], p1 = postab[2 * (F.wave * 16 + c + q) + 1];
                *((GAS v4u*)(AS + (size_t)p0 * DM) + F.lane) = v[q]; *((GAS v4u*)(AS + (size_t)p1 * DM) + F.lane) = v[q]; }
        }
        if (tb == 0) {
            const int nt = (gbase[7] + ((gtot[7] + 255) & ~255)) >> 8;
            if (F.tid < nt) { const int row0 = F.tid * 256; int e = 0;
#pragma unroll 1
                for (int g = 0; g < 8; ++g) if (row0 >= gbase[g] && row0 < gbase[g] + ((gtot[g] + 255) & ~255)) e = g;
                TILEE[F.tid] = e; }
            if (F.tid == 0) INFO[0] = nt;
        }
        __syncthreads();
    }
}

struct RowOrder : pg8::StaticOrder {
    int latent_only;
    __device__ __forceinline__ bool next(int i, pg8::Unit& u) const { if (!pg8::StaticOrder::next(i, u)) return false; if (latent_only) u.pm = (u.pm >> 5) * 33 + 1 + (u.pm & 31); return true; }
};
struct MoeUpOrder : pg8::StaticOrder {
    int lo; const LAS int* tile_e;
    __device__ __forceinline__ bool next(int i, pg8::Unit& u) const { if (!pg8::StaticOrder::next(i, u)) return false; const int e = tile_e[lo + u.pm]; u.pm += lo; u.pn += e * 28; return true; }
};
struct MoeDownOrder : pg8::StaticOrder {
    int lo; const LAS int* tile_e;
    __device__ __forceinline__ bool next(int i, pg8::Unit& u) const { if (!pg8::StaticOrder::next(i, u)) return false; const int e = tile_e[lo + u.pm]; u.pn += e * 4; return true; }
};
struct EpiNull {
    static constexpr bool PERM = true, AFTER_DRAIN = false; unsigned char* O; int mode;
    __device__ __forceinline__ void operator()(const pg8::f32x4 (&acc)[2][2][4][2], const pg8::Unit& u, int wr, int wc, int fr, int fq) const {
        if (mode == 2) {
#pragma unroll
            for (int ai = 0; ai < 2; ++ai)
#pragma unroll
                for (int m = 0; m < 4; ++m) { const pg8::f32x4 g0 = acc[ai][0][m][0] + acc[ai][1][m][0], g1 = acc[ai][0][m][1] + acc[ai][1][m][1];
                    *(unsigned long long*)(O + (size_t)(((u.pm & 127) * 256) + wr * 64 + fr + ai * 128 + m * 16) * 3584 + (u.pn % 28) * 128 + wc * 32 + 8 * fq) = (unsigned long long)__float_as_uint(g0[0] + g0[1] + g0[2] + g0[3]) | ((unsigned long long)__float_as_uint(g1[0] + g1[1] + g1[2] + g1[3]) << 32); }
        } else if (mode == 1 && acc[0][0][0][0][0] == 123456.789f) O[0] = 1;
    }
};
struct SplitOrder {
    int nT, nN, nS, ksub, G, c, pm_mul, lo, e_mul; const LAS int* tile_e;
    __device__ __forceinline__ bool next(int i, pg8::Unit& u) const {
        const long L = (long)i * G + c; if (L >= (long)nT * nN * nS) return false;
        const int ks = (int)(L % nS), r = (int)(L / nS), pn = r % nN, tm = r / nN;
        u.pm = tm * pm_mul; u.pn = pn + (tile_e ? tile_e[lo + tm] * e_mul : 0); u.ko = ks * ksub; return true; }
    __device__ __forceinline__ void a_ready(const pg8::Unit&) const {}
    __device__ __forceinline__ void done(const pg8::Unit&) const {}
};
struct EpiSlab {
    static constexpr bool PERM = false, AFTER_DRAIN = false;
    float* S; size_t sstride; int ksub, pm_div; float scale;
    __device__ __forceinline__ void operator()(const pg8::f32x4 (&acc)[2][2][4][2], const pg8::Unit& u, int wr, int wc, int fr, int fq) const {
        char* base = (char*)(S + (size_t)(u.ko / ksub) * sstride + (size_t)((u.pm / pm_div) * 256) * DM + (u.pn & 3) * 256);
        const unsigned off0 = (unsigned)((wr * 64 + fr) * DM + wc * 32 + 4 * fq) * 4u;
#pragma unroll
        for (int ai = 0; ai < 2; ++ai)
#pragma unroll
            for (int m = 0; m < 4; ++m) { const unsigned ro = off0 + (unsigned)((ai * 128 + m * 16) * DM * 4);
#pragma unroll
                for (int bj = 0; bj < 2; ++bj)
#pragma unroll
                    for (int n = 0; n < 2; ++n) *(pg8::f32x4*)(base + ro + (unsigned)((bj * 128 + n * 16) * 4)) = acc[ai][bj][m][n] * scale;
                asm volatile("" ::: "memory"); }
    }
};
template <bool I8> struct EpiBf16R {
    static constexpr bool PERM = true, AFTER_DRAIN = false;
    bf16* O; int ldc; const float* rowsc; const gu32* cmax;
    __device__ __forceinline__ void operator()(const pg8::f32x4 (&acc)[2][2][4][2], const pg8::Unit& u, int wr, int wc, int fr, int fq) const {
        const int row0 = u.pm * 256 + wr * 64 + fr, col0 = u.pn * 256 + wc * 32 + 8 * fq;
        pg8::f32x4 cs[2][2];
        if constexpr (I8) {
#pragma unroll
            for (int bj = 0; bj < 2; ++bj)
#pragma unroll
                for (int n = 0; n < 2; ++n)
#pragma unroll
                    for (int e = 0; e < 4; ++e) cs[bj][n][e] = __uint_as_float(cmax[col0 + bj * 128 + 4 * n + e]) * (1.f / 127.f); }
        float rsv[2][4];
#pragma unroll
        for (int ai = 0; ai < 2; ++ai)
#pragma unroll
            for (int m = 0; m < 4; ++m) rsv[ai][m] = I8 ? rowsc[row0 + ai * 128 + m * 16] : 1.f;
        asm volatile("" ::: "memory");
#pragma unroll
        for (int ai = 0; ai < 2; ++ai)
#pragma unroll
            for (int m = 0; m < 4; ++m) { const int r = row0 + ai * 128 + m * 16; bf16* rowp = O + (size_t)r * ldc + col0; const float rs = rsv[ai][m];
#pragma unroll
                for (int bj = 0; bj < 2; ++bj) { pg8::f32x4 v0 = acc[ai][bj][m][0], v1 = acc[ai][bj][m][1];
                    if constexpr (I8) {
#pragma unroll
                        for (int e = 0; e < 4; ++e) { v0[e] = (float)__float_as_int(v0[e]) * (rs * cs[bj][0][e]); v1[e] = (float)__float_as_int(v1[e]) * (rs * cs[bj][1][e]); } }
                    v4u w; w.x = pg8::cvt_pk_bf16(v0[0], v0[1]); w.y = pg8::cvt_pk_bf16(v0[2], v0[3]); w.z = pg8::cvt_pk_bf16(v1[0], v1[1]); w.w = pg8::cvt_pk_bf16(v1[2], v1[3]);
                    *(v4u*)(rowp + bj * 128) = w; } }
    }
};
struct EpiBf16S {
    static constexpr bool PERM = true, AFTER_DRAIN = false;
    bf16* O; int lo; float scale;
    __device__ __forceinline__ void operator()(const pg8::f32x4 (&acc)[2][2][4][2], const pg8::Unit& u, int wr, int wc, int fr, int fq) const {
        const int row0 = (lo + u.pm) * 256 + wr * 64 + fr, col0 = (u.pn & 3) * 256 + wc * 32 + 8 * fq;
#pragma unroll
        for (int ai = 0; ai < 2; ++ai)
#pragma unroll
            for (int m = 0; m < 4; ++m) { bf16* rowp = O + (size_t)(row0 + ai * 128 + m * 16) * DM + col0;
#pragma unroll
                for (int bj = 0; bj < 2; ++bj) { const pg8::f32x4 v0 = acc[ai][bj][m][0] * scale, v1 = acc[ai][bj][m][1] * scale;
                    v4u w; w.x = pg8::cvt_pk_bf16(v0[0], v0[1]); w.y = pg8::cvt_pk_bf16(v0[2], v0[3]); w.z = pg8::cvt_pk_bf16(v1[0], v1[1]); w.w = pg8::cvt_pk_bf16(v1[2], v1[3]);
                    *(v4u*)(rowp + bj * 128) = w; } }
    }
};
template <bool XB> struct EpiResid {
    static constexpr bool PERM = true, AFTER_DRAIN = false;
    const void* X; unsigned char* R; const float* gate;
    __device__ __forceinline__ void operator()(const pg8::f32x4 (&acc)[2][2][4][2], const pg8::Unit& u, int wr, int wc, int fr, int fq) const {
        const int b = u.pm / 33, lt = u.pm - b * 33 - 1;
        const int row0 = b * TL + lt * 256 + wr * 64 + fr, col0 = u.pn * 256 + wc * 32 + 8 * fq;
        pg8::f32x4 g[2][2];
#pragma unroll
        for (int bj = 0; bj < 2; ++bj)
#pragma unroll
            for (int n = 0; n < 2; ++n) g[bj][n] = *(const pg8::f32x4*)(gate + b * 6144 + col0 + bj * 128 + 4 * n);
        constexpr int NBUF = XB ? 4 : 3;
        pg8::f32x4 xf[XB ? 1 : NBUF][2][2]; v4u xb[XB ? NBUF : 1][2];
#define ER_LOAD(buf, k) do { const size_t row_ = (size_t)(row0 + ((k) >> 2) * 128 + ((k) & 3) * 16); \
        if constexpr (XB) { _Pragma("unroll") for (int bj = 0; bj < 2; ++bj) xb[buf][bj] = *(const GAS v4u*)((const unsigned char*)X + row_ * RP + (size_t)(col0 + bj * 128) * 2); } \
        else { _Pragma("unroll") for (int bj = 0; bj < 2; ++bj) _Pragma("unroll") for (int n = 0; n < 2; ++n) xf[buf][bj][n] = *(const GAS pg8::f32x4*)((const float*)X + row_ * DM + col0 + bj * 128 + 4 * n); } } while (0)
#pragma unroll
        for (int k = 0; k < NBUF; ++k) ER_LOAD(k, k);
#pragma unroll
        for (int k = 0; k < 8; ++k) { const int ai = k >> 2, m = k & 3, cb = k % NBUF;
            unsigned char* rowp = R + (size_t)(row0 + ai * 128 + m * 16) * RP + (size_t)col0 * 2;
#pragma unroll
            for (int bj = 0; bj < 2; ++bj) { pg8::f32x4 x0, x1;
                if constexpr (XB) { const v4u w = xb[cb][bj]; x0 = (pg8::f32x4){bflo(w.x), bfhi(w.x), bflo(w.y), bfhi(w.y)}; x1 = (pg8::f32x4){bflo(w.z), bfhi(w.z), bflo(w.w), bfhi(w.w)}; }
                else { x0 = xf[cb][bj][0]; x1 = xf[cb][bj][1]; }
                const pg8::f32x4 v0 = x0 + g[bj][0] * acc[ai][bj][m][0], v1 = x1 + g[bj][1] * acc[ai][bj][m][1];
                v4u o; o.x = pg8::cvt_pk_bf16(v0[0], v0[1]); o.y = pg8::cvt_pk_bf16(v0[2], v0[3]); o.z = pg8::cvt_pk_bf16(v1[0], v1[1]); o.w = pg8::cvt_pk_bf16(v1[2], v1[3]);
                *(GAS v4u*)(rowp + bj * 256) = o; }
            if (k + NBUF < 8) ER_LOAD(cb, k + NBUF);
        }
#undef ER_LOAD
    }
};
template <int QM> struct EpiSwiGLU {
    static constexpr bool PERM = true, AFTER_DRAIN = false;
    unsigned char* O; int ldc; int pm_sub; int pn_mod;
    const float* rowsc; const gu32* cmax;
    static __device__ __forceinline__ float gu(float G, float U, float k1, float ic) {
        const float e = __builtin_amdgcn_exp2f(G * k1);
        return (G * U) * __builtin_amdgcn_rcpf(__builtin_fmaf(e, ic, ic));
    }
    __device__ __forceinline__ void operator()(const pg8::f32x4 (&acc)[2][2][4][2], const pg8::Unit& u, int wr, int wc, int fr, int fq) const {
        const int row0 = (u.pm - pm_sub) * 256 + wr * 64 + fr, col0 = (u.pn % pn_mod) * 128 + wc * 32 + 8 * fq;
        constexpr float si = QM == 1 ? 1.f / W_UP_SCALE : 1.f, so = QM == 1 ? ACT_SCALE : 1.f;
        pg8::f32x4 cs[2][2];
        if constexpr (QM == 2) {
#pragma unroll
            for (int bj = 0; bj < 2; ++bj)
#pragma unroll
                for (int n = 0; n < 2; ++n)
#pragma unroll
                    for (int e = 0; e < 4; ++e) cs[bj][n][e] = __uint_as_float(cmax[u.pn * 256 + bj * 128 + wc * 32 + 8 * fq + 4 * n + e]) * (1.f / 127.f); }
        float rsv[2][4];
#pragma unroll
        for (int ai = 0; ai < 2; ++ai)
#pragma unroll
            for (int m = 0; m < 4; ++m) rsv[ai][m] = QM == 2 ? rowsc[u.pm * 256 + wr * 64 + fr + ai * 128 + m * 16] : 1.f;
        asm volatile("" ::: "memory");
#pragma unroll
        for (int ai = 0; ai < 2; ++ai)
#pragma unroll
            for (int m = 0; m < 4; ++m) {
                pg8::f32x4 g0 = acc[ai][0][m][0], g1 = acc[ai][0][m][1], u0 = acc[ai][1][m][0], u1 = acc[ai][1][m][1];
                float k1 = -si * 1.4426950408889634f, ic = 1.f / (si * si * so);
                if constexpr (QM == 2) {
                    const float rs = rsv[ai][m]; k1 = -1.4426950408889634f; ic = 1.f;
#pragma unroll
                    for (int e = 0; e < 4; ++e) { g0[e] = (float)__float_as_int(g0[e]) * (rs * cs[0][0][e]); g1[e] = (float)__float_as_int(g1[e]) * (rs * cs[0][1][e]);
                        u0[e] = (float)__float_as_int(u0[e]) * (rs * cs[1][0][e]); u1[e] = (float)__float_as_int(u1[e]) * (rs * cs[1][1][e]); } }
                const size_t off = (size_t)(row0 + ai * 128 + m * 16) * ldc + col0;
                if constexpr (QM == 1) {
                    const unsigned lo = pk4_fp8(gu(g0[0], u0[0], k1, ic), gu(g0[1], u0[1], k1, ic), gu(g0[2], u0[2], k1, ic), gu(g0[3], u0[3], k1, ic));
                    const unsigned hi = pk4_fp8(gu(g1[0], u1[0], k1, ic), gu(g1[1], u1[1], k1, ic), gu(g1[2], u1[2], k1, ic), gu(g1[3], u1[3], k1, ic));
                    *(unsigned long long*)(O + off) = (unsigned long long)lo | ((unsigned long long)hi << 32);
                } else {
                    v4u w; w.x = pg8::cvt_pk_bf16(gu(g0[0], u0[0], k1, ic), gu(g0[1], u0[1], k1, ic)); w.y = pg8::cvt_pk_bf16(gu(g0[2], u0[2], k1, ic), gu(g0[3], u0[3], k1, ic));
                    w.z = pg8::cvt_pk_bf16(gu(g1[0], u1[0], k1, ic), gu(g1[1], u1[1], k1, ic)); w.w = pg8::cvt_pk_bf16(gu(g1[2], u1[2], k1, ic), gu(g1[3], u1[3], k1, ic));
                    *(v4u*)((bf16*)O + off) = w; }
            }
    }
};


#ifndef MK_PER_PHASE
#define MK_PER_PHASE 0
#endif
#ifndef EN_MASK
#define EN_MASK 0xFFFFFFFFu
#endif
#define EN(bit) (((EN_MASK) >> (bit)) & 1u)
#ifndef DUP_MASK
#define DUP_MASK 0u
#endif
#define DUP(bit) (((DUP_MASK) >> (bit)) & 1u)
__global__ void __launch_bounds__(NTHR, 2) mk_fwd(Args a_unused) {
    extern __shared__ __attribute__((aligned(16))) unsigned char lds[];
    Frame F;
    F.lds = (LAS unsigned char*)lds;
    F.MISC = (volatile LAS unsigned*)(F.lds + MISC_OFF);
    F.tid = threadIdx.x; F.lane = F.tid & 63; F.wave = __builtin_amdgcn_readfirstlane(F.tid >> 6);
    F.G = gridDim.x; { const int bx = blockIdx.x; F.vcu = (F.G % 8 == 0) ? (bx % 8) * (F.G / 8) + bx / 8 : bx; }
    F.gw = F.vcu * NWAVES + F.wave; F.NGW = F.G * NWAVES;
    { CAP a = args_ptr(); F.ws = (unsigned char*)(GAS unsigned char*)(unsigned long long)a->ws; F.ctl = (gu32*)(F.ws + WS_CTL); }
    for (int u = F.tid; u < (LDS_BYTES - MISC_OFF) / 4; u += NTHR) ((LAS unsigned*)(F.lds + MISC_OFF))[u] = 0u;
    __syncthreads();
    XcdBarrier bar; bar.bar = (unsigned*)(F.ctl + CW_BAR); bar.x = 0; bar.st = nullptr;
    if (!MK_PER_PHASE) bar = xcd_barrier_post((unsigned*)(F.ctl + CW_BAR), F.MISC + 8);
    int lo, hi; { CAP a = args_ptr(); lo = a->ph_lo; hi = a->ph_hi; }
#define IN(k) (lo <= (k) && (k) < hi)
#define a (args_ptr())
#define FRESH() do { int t_ = threadIdx.x; asm volatile("" : "+v"(t_)); F.tid = t_; F.lane = t_ & 63; F.wave = __builtin_amdgcn_readfirstlane(t_ >> 6); F.gw = F.vcu * NWAVES + F.wave; \
        unsigned long long w_ = (unsigned long long)args_ptr()->ws; asm volatile("" : "+s"(w_)); F.ws = (unsigned char*)(GAS unsigned char*)w_; F.ctl = (gu32*)(F.ws + WS_CTL); } while (0)
#define SEAM(k) do { if (IN(k) && IN((k) + 1)) { if (MK_PER_PHASE) { if (F.tid == 0) __hip_atomic_store(F.ctl + 0, 0xBADBA0u, RLX_AGENT); } else { xcd_barrier(bar); if (DUP(20)) xcd_barrier(bar); } } } while (0)
#define HY ((bf16*)(F.ws + WS_HY))
#define CTXRES ((float*)(F.ws + WS_CTXRES))
#define MODS ((const float*)(F.ws + WS_MODS))

    FRESH();
    if (EN(0) && IN(0)) phase_prologue(F, a);
    if (DUP(0) && IN(0)) { __syncthreads(); phase_prologue(F, a); }
    SEAM(0); FRESH();
#pragma unroll 1
    for (int L = 0; L < 2; ++L) {
        const int pb = 1 + 9 * L;
        FRESH();
        if (EN(1) && IN(pb + 0)) phase_norm1(F, a, L);
        if (DUP(1) && IN(pb + 0) && L == 0) { for (int rep = 0; rep < 4; ++rep) phase_norm1(F, a, L); }
        SEAM(pb + 0); FRESH();
        if (EN(2) && IN(pb + 1)) {
            pg8::Gemm g{P_I8 ? (const bf16*)(F.ws + WS_QN) : (const bf16*)HY, (const bf16*)(F.ws + WS_WIN + (size_t)L * NP * DM * PB_), MROWS, NP, DM * PB_ / 2, DM * PB_ / 2}; pg8::StaticOrder S; S.init(MROWS, NP, F.G, (int)blockIdx.x);
            EpiBf16R<P_I8 != 0> E{(bf16*)(F.ws + WS_P), NP, (const float*)(F.ws + WS_ROUTE + RT_ROWSC_H), F.ctl + CW_CMAX_IN + L * NP};
            pg8::gemm_phase<EpiBf16R<P_I8 != 0>, pg8::StaticOrder, true, true, P_I8 ? 2 : 0>(F.lds, g, S, E);
            if (DUP(2)) pg8::gemm_phase<EpiBf16R<P_I8 != 0>, pg8::StaticOrder, true, true, P_I8 ? 2 : 0>(F.lds, g, S, E);
            { const int rem_ = ((MROWS / 256) * (NP / 256)) % F.G;
              if (rem_ == 0) phase_gates(F, a, L, F.gw, F.NGW);
              else if ((int)blockIdx.x >= rem_) phase_gates(F, a, L, ((int)blockIdx.x - rem_) * NWAVES + F.wave, (F.G - rem_) * NWAVES); }
        }
        SEAM(pb + 1); FRESH();
        if (IN(pb + 2)) { if (EN(3)) phase_qknorm(F, a, L); if (DUP(3)) { for (int rep = 0; rep < 4; ++rep) phase_qknorm(F, a, L); } if (EN(4)) phase_mlstm_local(F, a, L); if (DUP(4)) { for (int rep = 0; rep < 4; ++rep) phase_mlstm_local(F, a, L); } }
        SEAM(pb + 2); FRESH();
        if (IN(pb + 3)) { if (DUP(5)) { for (int rep = 0; rep < 4; ++rep) phase_scan<true>(F); } if (EN(5)) phase_scan<false>(F); __syncthreads(); FRESH(); if (EN(6)) phase_attn(F, a, L, (char*)lds); if (DUP(6)) phase_attn(F, a, L, (char*)lds); }
        SEAM(pb + 3); FRESH();
#ifndef MO_PRB
#define MO_PRB 0
#endif
        if (DUP(7) && IN(pb + 4)) { for (int rep = 0; rep < 4; ++rep) phase_mlstm_out<MO_PRB>(F, a, L); }
        if (EN(7) && IN(pb + 4)) phase_mlstm_out<0>(F, a, L);
        SEAM(pb + 4); FRESH();
        if (EN(8) && IN(pb + 5)) {
            pg8::Gemm g{HY, (const bf16*)(F.ws + WS_WOUT) + (size_t)L * DM * DM, MLAT, DM, DM, DM}; RowOrder S; S.init(MLAT, DM, F.G, (int)blockIdx.x); S.latent_only = 1;
            pg8::EpiBf16<0> E{(bf16*)(F.ws + WS_P), DM, nullptr, 0, 0, 1.f};
            if (L == 0) {
                EpiResid<false> ER{ain(a, 0), F.ws + WS_RESID, (const float*)(F.ws + WS_MODS) + 2 * 1024};
                pg8::gemm_phase<EpiResid<false>, RowOrder, true, true>(F.lds, g, S, ER);
            } else {
                EpiResid<true> ER{F.ws + WS_RESID, F.ws + WS_RESID, (const float*)(F.ws + WS_MODS) + 5 * 6144 + 2 * 1024};
                pg8::gemm_phase<EpiResid<true>, RowOrder, true, true>(F.lds, g, S, ER);
            }
            if (L == 0) {
                int ks_ = 256; asm volatile("" : "+s"(ks_));
                pg8::Gemm g2{HY, (const bf16*)(F.ws + WS_WOUT), TC * NB, DM, ks_, DM}; SplitOrder S2{NB, 4, NS_CW, 256, F.G, (int)blockIdx.x, 33, 0, 0, nullptr};
                EpiSlab E2{(float*)(F.ws + WS_SLAB_CW), (size_t)1024 * 1024, 256, 33, 1.f};
                pg8::gemm_phase<EpiSlab, SplitOrder, true, true>(F.lds, g2, S2, E2);
            }
            if (DUP(8)) pg8::gemm_phase<pg8::EpiBf16<0>, RowOrder, true, true>(F.lds, g, S, E);
        }
        SEAM(pb + 5); FRESH();
        if (L == 0) {
            FRESH();
            if (EN(9) && IN(7)) {
#pragma unroll 1
                for (int rep = 0; rep < (DUP(9) ? 5 : 1); ++rep) phase_norm2(F, a, 0); }
            SEAM(7); FRESH();
            if (EN(10) && IN(8)) {
                pg8::Gemm g{HY, (const bf16*)(F.ws + WS_WGU), MROWS, 2 * DFF, DM * UB / 2, DM * UB / 2}; pg8::StaticOrder S; S.init(MROWS, 2 * DFF, F.G, (int)blockIdx.x);
                EpiSwiGLU<UMODE> E{F.ws + WS_ACT0, DFF, 0, 1 << 20, (const float*)(F.ws + WS_ROUTE + RT_ROWSC), F.ctl + CW_CMAX_UP};
                pg8::gemm_phase<EpiSwiGLU<UMODE>, pg8::StaticOrder, true, true, UMODE>(F.lds, g, S, E);
                if (DUP(10)) pg8::gemm_phase<EpiSwiGLU<UMODE>, pg8::StaticOrder, true, true, UMODE>(F.lds, g, S, E);
            }
            SEAM(8); FRESH();
            if (EN(11) && IN(9)) {
                constexpr bool CSPLIT = (DENSE_FP8 == 0);
                pg8::Gemm g{(const bf16*)(F.ws + WS_ACT0), (const bf16*)(F.ws + WS_WD), CSPLIT ? MLAT : MROWS, DM, DFF * DB / 2, DFF * DB / 2}; RowOrder S; S.init(CSPLIT ? MLAT : MROWS, DM, F.G, (int)blockIdx.x); S.latent_only = CSPLIT ? 1 : 0;
                EpiBf16S E{HY, 0, DENSE_FP8 ? 1.f / (W_DN_SCALE * ACT_SCALE) : 1.f};
                static_assert(CSPLIT && DENSE_FP8 == 0, "the fused residual epilogue is written for the bf16, latent-only down GEMM");
                { EpiResid<true> ER{F.ws + WS_RESID, F.ws + WS_RESID, (const float*)(F.ws + WS_MODS) + 5 * 1024};
                  pg8::gemm_phase<EpiResid<true>, RowOrder, true, true>(F.lds, g, S, ER); }
                if (CSPLIT) {
                    int ks_ = 256; asm volatile("" : "+s"(ks_));
                    pg8::Gemm g2{(const bf16*)(F.ws + WS_ACT0), (const bf16*)(F.ws + WS_WD), TC * NB, DM, ks_, DFF}; SplitOrder S2{NB, 4, 11, 256, F.G, (int)blockIdx.x, 33, 0, 0, nullptr};
                    EpiSlab E2{(float*)(F.ws + WS_SLAB_CD), (size_t)1024 * 1024, 256, 33, 1.f};
                    pg8::gemm_phase<EpiSlab, SplitOrder, true, true>(F.lds, g2, S2, E2);
                }
                if (DUP(11)) pg8::gemm_phase<EpiBf16S, RowOrder, true, true, DENSE_FP8 != 0>(F.lds, g, S, E);
            }
            SEAM(9); FRESH();
        } else {
            FRESH();
            if (EN(12) && IN(16)) phase_norm2_route(F, a);
            if (DUP(12) && IN(16)) phase_norm2_route(F, a);
            SEAM(16); FRESH();
            if (EN(13) && IN(17)) phase_moe_sort(F, a);
            if (DUP(13) && IN(17)) phase_moe_sort(F, a);
            SEAM(17); FRESH();
            const int* INFO = (const int*)(F.ws + WS_ROUTE + RT_INFO); const int* TILEE_G = (const int*)(F.ws + WS_ROUTE + RT_TILEE);
            LAS int* TILEE = (LAS int*)(F.lds + pg8::STAGE_BYTES);
#define STAGE_TILEE() do { for (int i_ = F.tid; i_ < 272; i_ += NTHR) TILEE[i_] = TILEE_G[i_]; __syncthreads(); } while (0)
#pragma unroll 1
            for (int p = 0; p < 2; ++p) {
                FRESH();
                int tlo = 0, thi = 0;
                if (IN(18 + 2 * p) || IN(19 + 2 * p)) { const int nt = INFO[0]; tlo = 128 * p; thi = p == 1 ? nt : 128; if (thi > nt) thi = nt; if (tlo > thi) tlo = thi; }
                const int ntile = thi - tlo;
                if (EN(14) && IN(18 + 2 * p)) {
                    STAGE_TILEE();
                    pg8::Gemm g{(const bf16*)(F.ws + WS_ASORT), (const bf16*)(F.ws + WS_MGU), ntile * 256, 2 * DFE, DM / 2, DM / 2}; MoeUpOrder S; S.init(ntile * 256, 2 * DFE, F.G, (int)blockIdx.x); S.lo = tlo; S.tile_e = TILEE;
                    EpiSwiGLU<1> E{F.ws + WS_ACT1, DFE, tlo, 28, nullptr, nullptr};
                    pg8::gemm_phase<EpiSwiGLU<1>, MoeUpOrder, true, true, 1>(F.lds, g, S, E);
#ifndef PROBE_EPI
                    if (DUP(14)) pg8::gemm_phase<EpiSwiGLU<1>, MoeUpOrder, true, true, 1>(F.lds, g, S, E);
#else
                    if (DUP(14)) { EpiNull EN{F.ws + WS_ACT1, PROBE_EPI}; pg8::gemm_phase<EpiNull, MoeUpOrder, true, true, 1>(F.lds, g, S, EN); pg8::gemm_phase<EpiSwiGLU<1>, MoeUpOrder, true, true, 1>(F.lds, g, S, E); }
#endif
                }
                SEAM(18 + 2 * p); FRESH();
                if (EN(15) && IN(19 + 2 * p)) {
                    STAGE_TILEE();
                    const int nreg = ntile < PASS_TILES ? ntile : PASS_TILES, nl = ntile - nreg;
                    {
                    pg8::Gemm g{(const bf16*)(F.ws + WS_ACT1), (const bf16*)(F.ws + WS_MD), nreg * 256, DM, DFE / 2, DFE / 2}; MoeDownOrder S; S.init(nreg * 256, DM, F.G, (int)blockIdx.x); S.lo = tlo; S.tile_e = TILEE;
                    EpiBf16S E{(bf16*)(F.ws + WS_EOUT), tlo, 1.f / (W_DN_SCALE * ACT_SCALE)};
                    pg8::gemm_phase<EpiBf16S, MoeDownOrder, true, true, true>(F.lds, g, S, E);
                    }
                    if (nl > 0) {
                    pg8::Gemm g2{(const bf16*)(F.ws + WS_ACT1 + (size_t)nreg * 256 * DFE), (const bf16*)(F.ws + WS_MD), nl * 256, DM, 256, DFE / 2}; SplitOrder S2{nl, 4, NS_MT, 256, F.G, (int)blockIdx.x, 1, tlo + nreg, 4, TILEE};
                    EpiSlab E2{(float*)(F.ws + WS_SLAB_MT), (size_t)MT_TILES * 256 * 1024, 256, 1, 1.f / (W_DN_SCALE * ACT_SCALE)};
                    pg8::gemm_phase<EpiSlab, SplitOrder, true, true, true>(F.lds, g2, S2, E2);
                    }
                }
                SEAM(19 + 2 * p); FRESH();
            }
        }
    }
    FRESH();
    if (EN(16) && IN(22)) phase_final(F, a);
#undef IN
#undef SEAM
#undef a
#undef FRESH
#undef HY
#undef CTXRES
#undef MODS
}

extern "C" void kernel_launch(void* const* d_in, const int* in_sizes, int n_in, void* d_out, int out_size, void* d_ws, size_t ws_size, hipStream_t stream) {
    static int grid = 0;
    if (grid == 0) {
        if (n_in != 22 || in_sizes[0] != MLAT * DM || out_size != MLAT * DM || ws_size < WS_END) { fprintf(stderr, "kernel_launch: unexpected shapes (n_in %d, in0 %d, out %d, ws %zu); nothing launched\n", n_in, n_in > 0 ? in_sizes[0] : -1, out_size, ws_size); grid = -1; return; }
        int dev = 0, cus = 0, per_cu = 0;
        if (hipGetDevice(&dev) != hipSuccess || hipDeviceGetAttribute(&cus, hipDeviceAttributeMultiprocessorCount, dev) != hipSuccess) { grid = -1; return; }
        if (hipFuncSetAttribute((const void*)mk_fwd, hipFuncAttributeMaxDynamicSharedMemorySize, LDS_BYTES) != hipSuccess) { fprintf(stderr, "kernel_launch: hipFuncSetAttribute failed\n"); grid = -1; return; }
        if (hipOccupancyMaxActiveBlocksPerMultiprocessor(&per_cu, (const void*)mk_fwd, NTHR, LDS_BYTES) != hipSuccess || per_cu < 1) { fprintf(stderr, "kernel_launch: occupancy query says %d\n", per_cu); }
        (void)hipGetLastError();
        grid = cus;
    }
    if (grid < 0) return;
    if (hipMemsetAsync((char*)d_ws + WS_CTL, 0, CTL_ZERO_BYTES, stream) != hipSuccess) return;
    Args ha{};
    for (int i = 0; i < 22; ++i) ha.in[i] = (const float*)d_in[i];
    ha.out = (float*)d_out; ha.ws = (unsigned char*)d_ws; ha.li = 0; ha.pad = 0;
#if MK_PER_PHASE
    for (int k = 0; k < N_PHASES; ++k) { ha.ph_lo = k; ha.ph_hi = k + 1; hipLaunchKernelGGL(mk_fwd, dim3(grid), dim3(NTHR), LDS_BYTES, stream, ha); }
#else
    ha.ph_lo = 0; ha.ph_hi = N_PHASES;
    hipLaunchKernelGGL(mk_fwd, dim3(grid), dim3(NTHR), LDS_BYTES, stream, ha);
#endif
    (void)hipPeekAtLastError();
}
```

```cpp
#include <hip/hip_runtime.h>
#include <hip/hip_bf16.h>
#include <cstdio>
#include <cstdint>
#include <cmath>
namespace pg8 {
#define PG8_LAS __attribute__((address_space(3)))
typedef unsigned short bf16_t;
typedef short bf16x8 __attribute__((ext_vector_type(8)));
typedef float f32x4 __attribute__((ext_vector_type(4)));
typedef unsigned u32x4 __attribute__((ext_vector_type(4)));
typedef int i32x4_t __attribute__((ext_vector_type(4)));
typedef int i32x8_t __attribute__((ext_vector_type(8)));
constexpr int BM = 256, BK = 64, HALF = 128, HTB = HALF * BK * 2  , STAGE_BYTES = 8 * HTB, NXCD = 8, WGM = 8;

__host__ __device__ __forceinline__ int lds_byte(int r, int c) { const int st = (r >> 4) * 2 + (c >> 5), rr = r & 15, cc = c & 31, ob = rr * 64 + cc * 2; return st * 1024 + (ob ^ (((ob >> 9) & 1) << 5)); }
__host__ __device__ __forceinline__ void stage_rc(int b, int& R, int& C) { const int st = b / 1024, sb = b % 1024, swz = sb ^ (((sb >> 9) & 1) << 5); R = (st >> 1) * 16 + swz / 64; C = (st & 1) * 32 + (swz % 64) / 2; }
__host__ __device__ __forceinline__ int perm32(int rho) { const int n = rho >> 4, i = rho & 15; return 8 * (i >> 2) + 4 * n + (i & 3); }

struct Unit { int pm, pn, ko; };
struct Gemm { const bf16_t* A; const bf16_t* Bt; int M, N, K, ld; };

struct StaticOrder {
    int nM, nN, nwg, G, c;
    __host__ __device__ void init(int M, int N, int G_, int c_) { nM = M / BM; nN = N / BM; nwg = nM * nN; G = G_; c = c_; }
    __host__ __device__ bool next(int i, Unit& u) const {
        const long L = (long)i * G + c; if (L >= nwg) return false;
        int wgid = (int)L; { const int q = nwg / NXCD, r = nwg % NXCD, xcd = wgid % NXCD, off = wgid / NXCD; wgid = (xcd < r ? xcd * (q + 1) : r * (q + 1) + (xcd - r) * q) + off; }
        const int nig = WGM * nN, gid = wgid / nig, fm = gid * WGM, gsz = (nM - fm) < WGM ? (nM - fm) : WGM;
        u.pm = fm + ((wgid % nig) % gsz); u.pn = (wgid % nig) / gsz; u.ko = 0; return true;
    }
    __device__ __forceinline__ void a_ready(const Unit&) const {}
    __device__ __forceinline__ void done(const Unit&) const {}
};

__device__ __forceinline__ unsigned cvt_pk_bf16(float lo, float hi) { unsigned r; asm volatile("v_cvt_pk_bf16_f32 %0, %1, %2" : "=v"(r) : "v"(lo), "v"(hi)); return r; }
typedef float f32x2 __attribute__((ext_vector_type(2)));
__device__ __forceinline__ f32x2 gelu_pk(f32x2 v) {
    const f32x2 av = __builtin_elementwise_abs(v), d = av * 0.2316418882f + 1.0f;
    f32x2 t; t.x = __builtin_amdgcn_rcpf(d.x); t.y = __builtin_amdgcn_rcpf(d.y);
    f32x2 q = t * 0.5307027145f + (-0.7265760135f); q = q * t + 0.7107068705f; q = q * t + (-0.142248368f); q = q * t + 0.127414796f; q = q * t;
    const f32x2 s = (v * v) * (-0.72134752044f);
    f32x2 e; e.x = __builtin_amdgcn_exp2f(s.x); e.y = __builtin_amdgcn_exp2f(s.y);
    const f32x2 m = v * (q * e), r = v - m;
    f32x2 o; o.x = v.x < 0.f ? m.x : r.x; o.y = v.y < 0.f ? m.y : r.y; return o;
}

template <int ACT  > struct EpiBf16 {
    static constexpr bool PERM = true, AFTER_DRAIN = false; static_assert(ACT == 0 || ACT == 1, "EpiBf16: ACT is 0 (none) or 1 (gelu_pk)");
    bf16_t* O; int ldc; const float* bias; int split_cols; size_t split_stride; float scale0;
    __device__ __forceinline__ void operator()(const f32x4 (&acc)[2][2][4][2], const Unit& u, int wr, int wc, int fr, int fq) const {
        const int row0 = u.pm * BM + wr * 64 + fr; int colt = u.pn * BM; bf16_t* base = O;
        float sc = 1.f; if (split_cols) { const int t = colt / split_cols; base += (size_t)t * split_stride; colt -= t * split_cols; if (t == 0) sc = scale0; }
        const int col0 = colt + wc * 32 + 8 * fq, bcol0 = u.pn * BM + wc * 32 + 8 * fq;
        f32x4 bv[2][2];
#pragma unroll
        for (int bj = 0; bj < 2; ++bj)
#pragma unroll
            for (int n = 0; n < 2; ++n) bv[bj][n] = bias ? *(const f32x4*)(bias + bcol0 + bj * HALF + 4 * n) : (f32x4){0.f, 0.f, 0.f, 0.f};
#pragma unroll
        for (int ai = 0; ai < 2; ++ai)
#pragma unroll
            for (int m = 0; m < 4; ++m) { bf16_t* rowp = base + (size_t)(row0 + ai * HALF + m * 16) * ldc + col0;
#pragma unroll
                for (int bj = 0; bj < 2; ++bj) { f32x4 v0 = acc[ai][bj][m][0] + bv[bj][0], v1 = acc[ai][bj][m][1] + bv[bj][1];
                    if (ACT == 1) { f32x2 a = gelu_pk((f32x2){v0[0], v0[1]}), b = gelu_pk((f32x2){v0[2], v0[3]}), c = gelu_pk((f32x2){v1[0], v1[1]}), d = gelu_pk((f32x2){v1[2], v1[3]});
                        v0 = (f32x4){a.x, a.y, b.x, b.y}; v1 = (f32x4){c.x, c.y, d.x, d.y}; }
                    v0 = v0 * sc; v1 = v1 * sc; u32x4 w; w.x = cvt_pk_bf16(v0[0], v0[1]); w.y = cvt_pk_bf16(v0[2], v0[3]); w.z = cvt_pk_bf16(v1[0], v1[1]); w.w = cvt_pk_bf16(v1[2], v1[3]);
                    *(u32x4*)(rowp + bj * HALF) = w; } }
    }
};

struct PanelStats {
    unsigned* xbuf;
    unsigned* cnt;
    unsigned* tmo;
    int ntn; float eps;
    unsigned code;
    __device__ __forceinline__ bool run(const f32x4 (&v)[2][2][4][2], const Unit& u, int wr, int wc, int fr, int fq, PG8_LAS unsigned char* lds, int wid, int lane) const {
        typedef float f32x2v __attribute__((ext_vector_type(2)));
        PG8_LAS f32x2v* P = (PG8_LAS f32x2v*)lds;
        PG8_LAS f32x2v* S = (PG8_LAS f32x2v*)(lds + 8192);
        PG8_LAS unsigned* flag = (PG8_LAS unsigned*)(lds + 8192 + 2048);
#pragma unroll
        for (int ai = 0; ai < 2; ++ai)
#pragma unroll
            for (int m = 0; m < 4; ++m) {
                float s = 0.f;
#pragma unroll
                for (int bj = 0; bj < 2; ++bj)
#pragma unroll
                    for (int n = 0; n < 2; ++n) { const f32x4 x = v[ai][bj][m][n]; s += (x[0] + x[1]) + (x[2] + x[3]); }
                s += __shfl_xor(s, 16); s += __shfl_xor(s, 32);
                const float mw = s * (1.0f / 64.0f); float q = 0.f;
#pragma unroll
                for (int bj = 0; bj < 2; ++bj)
#pragma unroll
                    for (int n = 0; n < 2; ++n) { const f32x4 d = v[ai][bj][m][n] - mw; q += (d[0] * d[0] + d[1] * d[1]) + (d[2] * d[2] + d[3] * d[3]); }
                q += __shfl_xor(q, 16); q += __shfl_xor(q, 32);
                if (fq == 0) P[(ai * HALF + wr * 64 + m * 16 + fr) * 4 + wc] = (f32x2v){mw, q};
            }
        asm volatile("s_waitcnt lgkmcnt(0)" ::: "memory"); __builtin_amdgcn_s_barrier(); asm volatile("" ::: "memory");
#if defined(BROKEN_EXCHANGE_NO_WAIT)
#warning BROKEN CONTROL BUILD: the row-statistics exchange does not wait; results are wrong by design
        if (blockIdx.x >= 64) { const long long t0_ = clock64(); while (clock64() - t0_ < 60000) __builtin_amdgcn_s_sleep(8); }
#endif
        const int row = wid * 32 + (lane & 31);
        if (lane < 32) {
            const f32x2v a = P[row * 4 + 0], b = P[row * 4 + 1], c = P[row * 4 + 2], d = P[row * 4 + 3];
            const float mt = (a.x + b.x + c.x + d.x) * 0.25f;
            const float da = a.x - mt, db = b.x - mt, dc = c.x - mt, dd = d.x - mt;
            const float m2 = (a.y + b.y) + (c.y + d.y) + 64.0f * ((da * da + db * db) + (dc * dc + dd * dd));
            unsigned long long* slot = (unsigned long long*)xbuf + ((size_t)(u.pm * BM + row) * 4 + u.pn);
            __hip_atomic_store(slot, ((unsigned long long)__float_as_uint(m2) << 32) | __float_as_uint(mt), __ATOMIC_RELAXED, __HIP_MEMORY_SCOPE_AGENT);
        }
        asm volatile("s_waitcnt vmcnt(0)" ::: "memory");
        if (lane == 0) __hip_atomic_fetch_add(cnt + 64 * u.pm, 1u, __ATOMIC_RELAXED, __HIP_MEMORY_SCOPE_AGENT);
        if (wid == 0) {
            bool dead = false; const unsigned long long t0 = __builtin_amdgcn_s_memrealtime(); const unsigned want = 8u * (unsigned)ntn;
            for (;;) {
#if defined(BROKEN_EXCHANGE_NO_WAIT)
                break;
#endif
                if ((unsigned)__builtin_amdgcn_readfirstlane(__hip_atomic_load(cnt + 64 * u.pm, __ATOMIC_RELAXED, __HIP_MEMORY_SCOPE_AGENT)) >= want) break;
                if (__builtin_amdgcn_s_memrealtime() - t0 > 2000000ull) {
                    if (lane == 0) { unsigned expect = 0u; __hip_atomic_compare_exchange_strong(tmo + 1, &expect, code | (unsigned)(u.pm & 0xff), __ATOMIC_RELAXED, __ATOMIC_RELAXED, __HIP_MEMORY_SCOPE_AGENT);
                                     __hip_atomic_store(tmo, 1u, __ATOMIC_RELAXED, __HIP_MEMORY_SCOPE_AGENT); }
                    dead = true; break; }
                __builtin_amdgcn_s_sleep(2);
            }
            __builtin_amdgcn_fence(__ATOMIC_ACQUIRE, "agent");
            if (lane == 0) flag[0] = dead ? 1u : 0u;
        }
        asm volatile("s_waitcnt vmcnt(0) lgkmcnt(0)" ::: "memory"); __builtin_amdgcn_s_barrier(); asm volatile("" ::: "memory");
        const bool bad = flag[0] != 0u;
        if (lane < 32) {
            const unsigned long long* slot = (const unsigned long long*)xbuf + (size_t)(u.pm * BM + row) * 4; float mt[4], m2[4]; float ms = 0.f;
#pragma unroll
            for (int t = 0; t < 4; ++t) { if (t < ntn) { const unsigned long long w = __hip_atomic_load(slot + t, __ATOMIC_RELAXED, __HIP_MEMORY_SCOPE_AGENT); mt[t] = __uint_as_float((unsigned)w); m2[t] = __uint_as_float((unsigned)(w >> 32)); } else { mt[t] = 0.f; m2[t] = 0.f; } ms += mt[t]; }
            const float mean = ms / (float)ntn; float q = 0.f;
#pragma unroll
            for (int t = 0; t < 4; ++t) if (t < ntn) { const float dm = mt[t] - mean; q += m2[t] + 256.0f * dm * dm; }
            S[row] = (f32x2v){mean, 1.0f / sqrtf(q / (256.0f * (float)ntn) + eps)};
        }
        asm volatile("s_waitcnt lgkmcnt(0)" ::: "memory"); __builtin_amdgcn_s_barrier(); asm volatile("" ::: "memory");
        return bad;
    }
};
struct EpiLnRes {
    static constexpr bool PERM = false, AFTER_DRAIN = true;
    const float* base; float* out; int ldc; const float* bias; PanelStats st; unsigned poison;
    __device__ __forceinline__ void fused(f32x4 (&acc)[2][2][4][2], const Unit& u, int wr, int wc, int fr, int fq, PG8_LAS unsigned char* lds, int wid, int lane) const {
        typedef float f32x2v __attribute__((ext_vector_type(2)));
        const PG8_LAS f32x2v* S = (const PG8_LAS f32x2v*)(lds + 8192);
        const int col0 = u.pn * BM + wc * 32 + 4 * fq;
#pragma unroll
        for (int bj = 0; bj < 2; ++bj)
#pragma unroll
            for (int n = 0; n < 2; ++n) { const f32x4 bv = bias ? *(const f32x4*)(bias + col0 + bj * HALF + n * 16) : (f32x4){0.f, 0.f, 0.f, 0.f};
#pragma unroll
                for (int ai = 0; ai < 2; ++ai)
#pragma unroll
                    for (int m = 0; m < 4; ++m) acc[ai][bj][m][n] += bv; }
        f32x4 pre[4][2][2];
#pragma unroll
        for (int m = 0; m < 4; ++m) { const size_t off = (size_t)(u.pm * BM + wr * 64 + m * 16 + fr) * ldc + col0;
#pragma unroll
            for (int bj = 0; bj < 2; ++bj)
#pragma unroll
                for (int n = 0; n < 2; ++n) pre[m][bj][n] = *(const f32x4*)(base + off + bj * HALF + n * 16); }
        const bool bad = st.run(acc, u, wr, wc, fr, fq, lds, wid, lane) || poison != 0u;
        const float qnan = __builtin_nanf("");
#pragma unroll
        for (int ai = 0; ai < 2; ++ai)
#pragma unroll
            for (int m = 0; m < 4; ++m) { const int r = ai * HALF + wr * 64 + m * 16 + fr; const f32x2v sr = S[r]; const size_t off = (size_t)(u.pm * BM + r) * ldc + col0;
#pragma unroll
                for (int bj = 0; bj < 2; ++bj)
#pragma unroll
                    for (int n = 0; n < 2; ++n) { const f32x4 bs = ai == 0 ? pre[m][bj][n] : *(const f32x4*)(base + off + bj * HALF + n * 16); f32x4 o = bs + (acc[ai][bj][m][n] - sr.x) * sr.y;
                        if (bad) o = (f32x4){qnan, qnan, qnan, qnan}; *(f32x4*)(out + off + bj * HALF + n * 16) = o; }
                if (m & 1) asm volatile("" ::: "memory"); }
    }
};
struct EpiLnResLn {
    static constexpr bool PERM = false, AFTER_DRAIN = true;
    const float* base; float* out; bf16_t* xn; int ldc; const float* bias; PanelStats st1, st2; unsigned poison;
    __device__ __forceinline__ void fused(f32x4 (&acc)[2][2][4][2], const Unit& u, int wr, int wc, int fr, int fq, PG8_LAS unsigned char* lds, int wid, int lane) const {
        typedef float f32x2v __attribute__((ext_vector_type(2))); typedef unsigned u32x2v __attribute__((ext_vector_type(2)));
        const PG8_LAS f32x2v* S = (const PG8_LAS f32x2v*)(lds + 8192);
        const int col0 = u.pn * BM + wc * 32 + 4 * fq;
#pragma unroll
        for (int bj = 0; bj < 2; ++bj)
#pragma unroll
            for (int n = 0; n < 2; ++n) { const f32x4 bv = bias ? *(const f32x4*)(bias + col0 + bj * HALF + n * 16) : (f32x4){0.f, 0.f, 0.f, 0.f};
#pragma unroll
                for (int ai = 0; ai < 2; ++ai)
#pragma unroll
                    for (int m = 0; m < 4; ++m) acc[ai][bj][m][n] += bv; }
        bool bad = st1.run(acc, u, wr, wc, fr, fq, lds, wid, lane) || poison != 0u;
        const float qnan = __builtin_nanf("");
#pragma unroll
        for (int ai = 0; ai < 2; ++ai)
#pragma unroll
            for (int m = 0; m < 4; ++m) { const int r = ai * HALF + wr * 64 + m * 16 + fr; const f32x2v sr = S[r]; const size_t off = (size_t)(u.pm * BM + r) * ldc + col0;
#pragma unroll
                for (int bj = 0; bj < 2; ++bj)
#pragma unroll
                    for (int n = 0; n < 2; ++n) { const f32x4 bs = *(const f32x4*)(base + off + bj * HALF + n * 16); acc[ai][bj][m][n] = bs + (acc[ai][bj][m][n] - sr.x) * sr.y; }
                asm volatile("" : "+v"(acc[ai][0][m][0]), "+v"(acc[ai][0][m][1]), "+v"(acc[ai][1][m][0]), "+v"(acc[ai][1][m][1]));
                if (m & 1) asm volatile("" ::: "memory"); }
        const bool bad1 = bad;
        bad = st2.run(acc, u, wr, wc, fr, fq, lds, wid, lane) || bad;
#pragma unroll
        for (int ai = 0; ai < 2; ++ai)
#pragma unroll
            for (int m = 0; m < 4; ++m) { const int r = ai * HALF + wr * 64 + m * 16 + fr; const f32x2v sr = S[r]; const size_t off = (size_t)(u.pm * BM + r) * ldc + col0;
#pragma unroll
                for (int bj = 0; bj < 2; ++bj)
#pragma unroll
                    for (int n = 0; n < 2; ++n) { const f32x4 x1 = acc[ai][bj][m][n]; *(f32x4*)(out + off + bj * HALF + n * 16) = bad1 ? (f32x4){qnan, qnan, qnan, qnan} : x1;
                        const f32x4 o = (x1 - sr.x) * sr.y; u32x2v w; w.x = cvt_pk_bf16(o[0], o[1]); w.y = cvt_pk_bf16(o[2], o[3]);
                        if (bad) { w.x = 0x7fc07fc0u; w.y = 0x7fc07fc0u; } *(u32x2v*)(xn + off + bj * HALF + n * 16) = w; }
                asm volatile("" ::: "memory"); }
    }
};

template <class Epi, class Sched, bool ALIGN_EPI = false, bool SP2 = false, int MODE = 0  >
__device__ __forceinline__ void gemm_phase(PG8_LAS unsigned char* lds, const Gemm g, const Sched& S, const Epi& E) {
    int tid_ = threadIdx.x; asm volatile("" : "+v"(tid_));
    const int tid = tid_, wid = __builtin_amdgcn_readfirstlane(tid >> 6), lane = tid & 63, wr = wid >> 2, wc = wid & 3, fr = lane & 15, fq = lane >> 4;
    const int K = g.ld, nt = g.K / BK;
    unsigned voffA[2], voffB[2];
#pragma unroll
    for (int i = 0; i < 2; ++i) { int R, C; stage_rc(tid * 16 + i * 8192, R, C); const int Rb = Epi::PERM ? ((R & ~31) + perm32(R & 31)) : R;
        voffA[i] = (unsigned)(R * K + C) * 2u; voffB[i] = (unsigned)(Rb * K + C) * 2u; }
    const size_t kstep = (size_t)(BK * 2);
    const size_t hstep = (size_t)HALF * K * 2;
    const size_t tstep = 2 * hstep;
    const unsigned ldsw = (unsigned)wid * 1024u;
    const int aoff = lds_byte(wr * 64 + fr, fq * 8), boff = lds_byte(wc * 32 + fr, fq * 8);
#define PG8_SA(b, h) (((b) * 2 + (h)) * HTB)
#define PG8_SB(b, h) ((4 + (b) * 2 + (h)) * HTB)
#define PG8_STAGE(bufoff, gbase, voff) do { _Pragma("unroll") for (int _i = 0; _i < 2; ++_i) \
        __builtin_amdgcn_global_load_lds((const unsigned*)((const char*)(gbase) + (voff)[_i]), (PG8_LAS unsigned*)(lds + (bufoff) + ldsw + _i * 8192), 16, 0, 0); } while (0)
#define PG8_LDA(dst, b, h) do { _Pragma("unroll") for (int m = 0; m < 4; ++m) dst[m] = PG8_CAT(*(const PG8_LAS bf16x8*)(lds + PG8_SA(b, h) + aoff + m * 2048), *(const PG8_LAS bf16x8*)(lds + PG8_SA(b, h) + aoff + m * 2048 + 1024)); } while (0)
#define PG8_LDB(dst, b, h) do { _Pragma("unroll") for (int n = 0; n < 2; ++n) dst[n] = PG8_CAT(*(const PG8_LAS bf16x8*)(lds + PG8_SB(b, h) + boff + n * 2048), *(const PG8_LAS bf16x8*)(lds + PG8_SB(b, h) + boff + n * 2048 + 1024)); } while (0)
#define PG8_CAT(lo, hi) __builtin_shufflevector(__builtin_bit_cast(i32x4_t, lo), __builtin_bit_cast(i32x4_t, hi), 0, 1, 2, 3, 4, 5, 6, 7)
#define PG8_LO(x) __builtin_bit_cast(bf16x8, __builtin_shufflevector(x, x, 0, 1, 2, 3))
#define PG8_HI(x) __builtin_bit_cast(bf16x8, __builtin_shufflevector(x, x, 4, 5, 6, 7))
#define PG8_MMA(ai, bj, At, Bt) do { __builtin_amdgcn_s_setprio(1); _Pragma("unroll") for (int m = 0; m < 4; ++m) _Pragma("unroll") for (int n = 0; n < 2; ++n) { \
        if constexpr (MODE == 1) asm volatile("v_mfma_scale_f32_16x16x128_f8f6f4 %0, %1, %2, %0, %3, %3 op_sel_hi:[0,0,0]" : "+v"(acc[ai][bj][m][n]) : "v"(Bt[n]), "v"(At[m]), "v"(sc1)); \
        else if constexpr (MODE == 2) { asm volatile("v_mfma_i32_16x16x64_i8 %0, %1, %2, %0" : "+v"(acc[ai][bj][m][n]) : "v"(PG8_LO(Bt[n])), "v"(PG8_LO(At[m]))); \
               asm volatile("v_mfma_i32_16x16x64_i8 %0, %1, %2, %0" : "+v"(acc[ai][bj][m][n]) : "v"(PG8_HI(Bt[n])), "v"(PG8_HI(At[m]))); } \
        else { acc[ai][bj][m][n] = __builtin_amdgcn_mfma_f32_16x16x32_bf16(PG8_LO(Bt[n]), PG8_LO(At[m]), acc[ai][bj][m][n], 0, 0, 0); \
               acc[ai][bj][m][n] = __builtin_amdgcn_mfma_f32_16x16x32_bf16(PG8_HI(Bt[n]), PG8_HI(At[m]), acc[ai][bj][m][n], 0, 0, 0); } } __builtin_amdgcn_s_setprio(0); } while (0)
#define PG8_WAIT_V(n) asm volatile("s_waitcnt vmcnt(" #n ")" ::: "memory")
#define PG8_WAIT_L(n) asm volatile("s_waitcnt lgkmcnt(" #n ")" ::: "memory")
#define PG8_BAR __builtin_amdgcn_s_barrier()
#define PG8_SCHED __builtin_amdgcn_sched_barrier(0)
    Unit cur, nxt; int ui = 0;
    if (!S.next(0, cur)) return;
    f32x4 acc[2][2][4][2];
#pragma unroll
    for (int a = 0; a < 2; ++a)
#pragma unroll
        for (int b = 0; b < 2; ++b)
#pragma unroll
            for (int m = 0; m < 4; ++m)
#pragma unroll
                for (int n = 0; n < 2; ++n) acc[a][b][m][n] = (f32x4){0.f, 0.f, 0.f, 0.f};
    const int sc1 = 0x7F7F7F7F;
    i32x8_t At[4], B0[2], B1[2];
    const char* cA = (const char*)g.A + (size_t)cur.pm * tstep + (size_t)cur.ko * 2; const char* cB = (const char*)g.Bt + (size_t)cur.pn * tstep + (size_t)cur.ko * 2;
    S.a_ready(cur);
    if constexpr (SP2) {
        PG8_STAGE(PG8_SB(0, 0), cB, voffB); PG8_STAGE(PG8_SB(0, 1), cB + hstep, voffB); PG8_STAGE(PG8_SA(0, 0), cA, voffA); PG8_STAGE(PG8_SA(0, 1), cA + hstep, voffA);
        if (wr == 1) PG8_BAR;
        PG8_WAIT_V(2); PG8_BAR;
        PG8_STAGE(PG8_SB(1, 0), cB + kstep, voffB); PG8_STAGE(PG8_SA(1, 0), cA + kstep, voffA); PG8_STAGE(PG8_SB(1, 1), cB + hstep + kstep, voffB);
        PG8_WAIT_V(6); PG8_BAR;
    } else {
        PG8_STAGE(PG8_SB(0, 0), cB, voffB); PG8_STAGE(PG8_SA(0, 0), cA, voffA); PG8_STAGE(PG8_SB(0, 1), cB + hstep, voffB); PG8_STAGE(PG8_SA(0, 1), cA + hstep, voffA);
        if (wr == 1) PG8_BAR;
        PG8_WAIT_V(4); PG8_BAR;
        PG8_STAGE(PG8_SB(1, 0), cB + kstep, voffB); PG8_STAGE(PG8_SA(1, 0), cA + kstep, voffA); PG8_STAGE(PG8_SB(1, 1), cB + hstep + kstep, voffB);
        PG8_WAIT_V(6); PG8_BAR;
    }
    for (;;) {
        const bool has_next = S.next(ui + 1, nxt);
        const char* nA = has_next ? (const char*)g.A + (size_t)nxt.pm * tstep + (size_t)nxt.ko * 2 : cA; const char* nB = has_next ? (const char*)g.Bt + (size_t)nxt.pn * tstep + (size_t)nxt.ko * 2 : cB;
        for (int t = 0; t < nt; t += 2) {
            const bool last = (t == nt - 2);
            const char* a1 = cA + (size_t)(t + 1) * kstep;
            const char* a2 = last ? nA : cA + (size_t)(t + 2) * kstep; const char* b2 = last ? nB : cB + (size_t)(t + 2) * kstep;
            const char* a3 = a2 + kstep; const char* b3 = b2 + kstep;
            if (last && has_next) S.a_ready(nxt);
            if constexpr (SP2) {
            PG8_LDB(B0, 0, 0); PG8_LDB(B1, 0, 1); PG8_SCHED; PG8_LDA(At, 0, 0); PG8_STAGE(PG8_SA(1, 1), a1 + hstep, voffA);
            PG8_WAIT_V(8); PG8_WAIT_L(0); PG8_BAR; PG8_MMA(0, 0, At, B0); PG8_MMA(0, 1, At, B1); PG8_BAR; PG8_SCHED;
            PG8_LDA(At, 0, 1); PG8_STAGE(PG8_SB(0, 0), b2, voffB); PG8_STAGE(PG8_SB(0, 1), b2 + hstep, voffB); PG8_STAGE(PG8_SA(0, 0), a2, voffA);
            PG8_WAIT_V(8); PG8_WAIT_L(0); PG8_BAR; PG8_MMA(1, 0, At, B0); PG8_MMA(1, 1, At, B1); PG8_BAR; PG8_SCHED;
            PG8_LDB(B0, 1, 0); PG8_LDB(B1, 1, 1); PG8_SCHED; PG8_LDA(At, 1, 0); PG8_STAGE(PG8_SA(0, 1), a2 + hstep, voffA);
            PG8_WAIT_V(8); PG8_WAIT_L(0); PG8_BAR; PG8_MMA(0, 0, At, B0); PG8_MMA(0, 1, At, B1); PG8_BAR; PG8_SCHED;
            PG8_LDA(At, 1, 1); PG8_STAGE(PG8_SB(1, 0), b3, voffB); PG8_STAGE(PG8_SB(1, 1), b3 + hstep, voffB); PG8_STAGE(PG8_SA(1, 0), a3, voffA);
            PG8_WAIT_V(8); PG8_WAIT_L(0); PG8_BAR; PG8_MMA(1, 0, At, B0); PG8_MMA(1, 1, At, B1); PG8_BAR; PG8_SCHED;
            } else {
            PG8_LDB(B0, 0, 0); PG8_SCHED; PG8_LDA(At, 0, 0); PG8_STAGE(PG8_SA(1, 1), a1 + hstep, voffA);
            PG8_WAIT_L(8); PG8_BAR; PG8_WAIT_L(0); PG8_MMA(0, 0, At, B0); PG8_BAR; PG8_SCHED;
            PG8_LDB(B1, 0, 1); PG8_STAGE(PG8_SB(0, 0), b2, voffB);
            PG8_BAR; PG8_WAIT_L(0); PG8_MMA(0, 1, At, B1); PG8_BAR;
            PG8_LDA(At, 0, 1); PG8_STAGE(PG8_SA(0, 0), a2, voffA);
            PG8_BAR; PG8_WAIT_L(0); PG8_MMA(1, 0, At, B0); PG8_BAR; PG8_SCHED;
            PG8_STAGE(PG8_SB(0, 1), b2 + hstep, voffB);
            PG8_WAIT_V(6); PG8_BAR; PG8_MMA(1, 1, At, B1); PG8_BAR;
            PG8_LDB(B0, 1, 0); PG8_SCHED; PG8_LDA(At, 1, 0); PG8_STAGE(PG8_SA(0, 1), a2 + hstep, voffA);
            PG8_WAIT_L(8); PG8_BAR; PG8_WAIT_L(0); PG8_MMA(0, 0, At, B0); PG8_BAR; PG8_SCHED;
            PG8_LDB(B1, 1, 1); PG8_STAGE(PG8_SB(1, 0), b3, voffB);
            PG8_BAR; PG8_WAIT_L(0); PG8_MMA(0, 1, At, B1); PG8_BAR;
            PG8_LDA(At, 1, 1); PG8_STAGE(PG8_SA(1, 0), a3, voffA);
            PG8_BAR; PG8_WAIT_L(0); PG8_MMA(1, 0, At, B0); PG8_BAR; PG8_SCHED;
            PG8_STAGE(PG8_SB(1, 1), b3 + hstep, voffB);
            PG8_WAIT_V(6); PG8_BAR; PG8_MMA(1, 1, At, B1); PG8_BAR;
            }
        }
        if constexpr (MODE != 0) asm volatile("s_nop 15\n\ts_nop 7" ::: "memory");
        if constexpr (ALIGN_EPI) { if (wr == 0) PG8_BAR; }
        if constexpr (!Epi::AFTER_DRAIN) { E(acc, cur, wr, wc, fr, fq); S.done(cur); }
        if (!has_next) break;
#pragma unroll
        for (int a = 0; a < 2; ++a)
#pragma unroll
            for (int b = 0; b < 2; ++b)
#pragma unroll
                for (int m = 0; m < 4; ++m)
#pragma unroll
                    for (int n = 0; n < 2; ++n) { double z0_, z1_; asm volatile("v_mov_b64 %0, 0\n\tv_mov_b64 %1, 0" : "=v"(z0_), "=v"(z1_));
                    typedef double f64x2z __attribute__((ext_vector_type(2))); acc[a][b][m][n] = __builtin_bit_cast(f32x4, (f64x2z){z0_, z1_}); }
        cur = nxt; cA = nA; cB = nB; ++ui;
        if constexpr (ALIGN_EPI) { if (wr == 1) PG8_BAR; }
    }
    PG8_WAIT_V(0);
    if constexpr (!ALIGN_EPI) { if (wr == 0) PG8_BAR; }
    PG8_BAR;
    if constexpr (Epi::AFTER_DRAIN) { E.fused(acc, cur, wr, wc, fr, fq, lds, wid, lane); S.done(cur); }
#undef PG8_SA
#undef PG8_SB
#undef PG8_STAGE
#undef PG8_LDA
#undef PG8_LDB
#undef PG8_MMA
#undef PG8_CAT
#undef PG8_LO
#undef PG8_HI
#undef PG8_WAIT_V
#undef PG8_WAIT_L
#undef PG8_BAR
#undef PG8_SCHED
}
}
namespace attn_body {
using bf16=__hip_bfloat16;
using bf16x8=__attribute__((ext_vector_type(8)))short;
using s16x4=__attribute__((ext_vector_type(4)))short;
using f32x16=__attribute__((ext_vector_type(16)))float;
using u32x4=__attribute__((ext_vector_type(4)))unsigned;
constexpr int D=64;
constexpr int NW=8,QBLK=32,QB=QBLK*NW,KVBLK=64;
constexpr int QP=512,KP=128,VP=2304,OP=1024,QPR=2304;
constexpr int ATTN_UNIT_ROWS=QB;
__device__ __forceinline__ int crow(int r,int hi){return (r&3)+8*(r>>2)+4*hi;}
#define SBAR() __builtin_amdgcn_sched_barrier(0)
__device__ __forceinline__ void cmask(f32x16&p0,f32x16&p1,int jb,int qrel,int hi){
  const float NEG=-INFINITY; int kb=64*jb+4*hi;
  #pragma unroll
  for(int r=0;r<16;++r){int kv=kb+(r&3)+8*(r>>2); if(kv>qrel)p0[r]=NEG; if(kv+32>qrel)p1[r]=NEG;}
}

constexpr int NSLOT=3, SLOTB=8192;
constexpr int LDS_K=0, LDS_V=NSLOT*SLOTB, LDS_WS=2*NSLOT*SLOTB, LDS_OST=LDS_WS+NW*64*4, LDS_BYTES=LDS_OST+NW*4096;
constexpr float C2=0.125f*1.4426950408889634f;
__device__ __forceinline__ void glds16(const void*gsrc,unsigned lds_dst){unsigned keep;
  asm volatile("s_mov_b32 %0, m0\n\ts_mov_b32 m0, %2\n\ts_nop 0\n\tglobal_load_lds_dwordx4 %1, off\n\ts_mov_b32 m0, %0":"=&s"(keep):"v"(gsrc),"s"(lds_dst):"memory");}
__device__ __forceinline__ float max3f(float a,float b,float c){float r;asm("v_max3_f32 %0, %1, %2, %3":"=v"(r):"v"(a),"v"(b),"v"(c));return r;}
__device__ __forceinline__ float max2f(float a,float b){float r;asm("v_max_f32_e32 %0, %1, %2":"=v"(r):"v"(a),"v"(b));return r;}
__device__ __forceinline__ float fadd_s(float a,float b){float r;asm("v_add_f32_e32 %0, %1, %2":"=v"(r):"v"(a),"v"(b));return r;}
__device__ __forceinline__ float fsub_s(float a,float b){float r;asm("v_sub_f32_e32 %0, %1, %2":"=v"(r):"v"(a),"v"(b));return r;}
typedef float f32x2_t __attribute__((ext_vector_type(2))); typedef __bf16 bf16x2_t __attribute__((ext_vector_type(2)));
__device__ __forceinline__ unsigned cvtpk_s(float lo,float hi){f32x2_t v={lo,hi};bf16x2_t b=__builtin_convertvector(v,bf16x2_t);return __builtin_bit_cast(unsigned,b);}
#define WAIT_BAR(N) asm volatile("s_waitcnt vmcnt(" #N ") lgkmcnt(0)\n\ts_barrier":::"memory")

__device__ __forceinline__ void qkt(f32x16&p0,f32x16&p1,const char*Kslot,const bf16x8*qr,const f32x16&negm,int r32,int hi){
  const char*kb=Kslot+hi*1024+r32*16;
  #pragma unroll
  for(int d0=0;d0<4;++d0){
    const bf16x8 b0=*reinterpret_cast<const bf16x8*>(kb+d0*2048);
    const bf16x8 b1=*reinterpret_cast<const bf16x8*>(kb+d0*2048+512);
    if(d0==0){p0=__builtin_amdgcn_mfma_f32_32x32x16_bf16(b0,qr[0],negm,0,0,0);p1=__builtin_amdgcn_mfma_f32_32x32x16_bf16(b1,qr[0],negm,0,0,0);}
    else{p0=__builtin_amdgcn_mfma_f32_32x32x16_bf16(b0,qr[d0],p0,0,0,0);p1=__builtin_amdgcn_mfma_f32_32x32x16_bf16(b1,qr[d0],p1,0,0,0);}}
}
typedef __attribute__((address_space(3))) const char* lds_cptr;
typedef short v4i16_t __attribute__((ext_vector_type(4)));
__device__ __forceinline__ void kload8(bf16x8*kf,lds_cptr kp){
  kf[0]=*(const __attribute__((address_space(3))) bf16x8*)(kp);      kf[1]=*(const __attribute__((address_space(3))) bf16x8*)(kp+512);
  kf[2]=*(const __attribute__((address_space(3))) bf16x8*)(kp+2048); kf[3]=*(const __attribute__((address_space(3))) bf16x8*)(kp+2560);
  kf[4]=*(const __attribute__((address_space(3))) bf16x8*)(kp+4096); kf[5]=*(const __attribute__((address_space(3))) bf16x8*)(kp+4608);
  kf[6]=*(const __attribute__((address_space(3))) bf16x8*)(kp+6144); kf[7]=*(const __attribute__((address_space(3))) bf16x8*)(kp+6656);
}
__device__ __forceinline__ void kload2(bf16x8*kf,lds_cptr kp,int j){ kf[2*j]=*(const __attribute__((address_space(3))) bf16x8*)(kp+j*2048); kf[2*j+1]=*(const __attribute__((address_space(3))) bf16x8*)(kp+j*2048+512); }
__device__ __forceinline__ s16x4 vtr(lds_cptr p){ return __builtin_bit_cast(s16x4,__builtin_amdgcn_ds_read_tr16_b64_v4i16((__attribute__((address_space(3))) v4i16_t*)p)); }
__device__ __forceinline__ float rowmax(const f32x16&p0,const f32x16&p1){
  float a=max3f(p0[0],p0[1],p1[0]),b=max3f(p0[2],p0[3],p1[1]);a=max3f(a,p1[2],p1[3]);
  #pragma unroll
  for(int r=4;r<16;r+=4){a=max3f(a,p0[r],p0[r+1]);b=max3f(b,p0[r+2],p0[r+3]);a=max3f(a,p1[r],p1[r+1]);b=max3f(b,p1[r+2],p1[r+3]);}
  const float m=max2f(a,b);
  auto rr=__builtin_amdgcn_permlane32_swap(__float_as_uint(m),__float_as_uint(m),false,false);
  return max2f(__uint_as_float(rr[0]),__uint_as_float(rr[1]));
}
__device__ __forceinline__ void pv(f32x16*o,int vb,bf16x8 pa0,bf16x8 pa1,bf16x8 pa2,bf16x8 pa3){
  #pragma unroll
  for(int d0=0;d0<2;++d0){s16x4 lo[4],hi[4];
    #pragma unroll
    for(int ks=0;ks<4;++ks){
      asm volatile("ds_read_b64_tr_b16 %0,%1 offset:%c2":"=&v"(lo[ks]):"v"(vb),"i"(d0*4096+ks*1024):"memory");
      asm volatile("ds_read_b64_tr_b16 %0,%1 offset:%c2":"=&v"(hi[ks]):"v"(vb),"i"(d0*4096+ks*1024+512):"memory");}
    asm volatile("s_waitcnt lgkmcnt(0)":::"memory");SBAR();
    #define PK(k) (bf16x8){lo[k][0],lo[k][1],lo[k][2],lo[k][3],hi[k][0],hi[k][1],hi[k][2],hi[k][3]}
    o[d0]=__builtin_amdgcn_mfma_f32_32x32x16_bf16(pa0,PK(0),o[d0],0,0,0);
    o[d0]=__builtin_amdgcn_mfma_f32_32x32x16_bf16(pa1,PK(1),o[d0],0,0,0);
    o[d0]=__builtin_amdgcn_mfma_f32_32x32x16_bf16(pa2,PK(2),o[d0],0,0,0);
    o[d0]=__builtin_amdgcn_mfma_f32_32x32x16_bf16(pa3,PK(3),o[d0],0,0,0);
    #undef PK
  }
}

#ifndef ATTN_STORE16
#define ATTN_STORE16(p,v) (*(u32x4*)(p)=(v))
#endif
template<int THRL,bool FIXMAX,bool QPREP> __device__ __forceinline__ void attn_unit(const bf16*Qh,const bf16*__restrict__ Kh,const bf16*__restrict__ Vh,bf16*Oh,const int NT,const float negB,const float*qw,const int tok0,char*shm){
  int tid_=threadIdx.x; asm volatile("":"+v"(tid_)); const int tid=tid_,lane=tid&63,r32=lane&31,hi=lane>>5; const int wid=__builtin_amdgcn_readfirstlane(tid>>6);
  const bf16*Qw=Qh+(long)(wid*QBLK)*(QPREP?QPR:QP);
  const unsigned lds0=(unsigned)(uintptr_t)shm;
  float*wsf=(float*)(shm+LDS_WS)+wid*64;
  const bf16*ksrc=Kh+(long)lane*KP+wid*8;
  const bf16*vsrc=Vh+(long)(16*(wid&3)+(lane>>2))*VP+(wid>>2)*32+(lane&3)*8;
  const unsigned kdst=lds0+LDS_K+wid*1024, vdst=lds0+LDS_V+wid*1024;
  #define DMA_K(t,slot) glds16(ksrc+(long)(t)*KVBLK*KP,(unsigned)__builtin_amdgcn_readfirstlane(kdst+(slot)))
  #define DMA_V(t,slot) glds16(vsrc+(long)(t)*KVBLK*VP,(unsigned)__builtin_amdgcn_readfirstlane(vdst+(slot)))
  const int vb0=(int)(lds0+LDS_V)+((lane>>4)&1)*32+(lane&3)*8+(4*hi+((lane&15)>>2))*64;
  const char*Kbase=shm+LDS_K; bf16x8 kf[8];
  const lds_cptr shm3=(lds_cptr)shm; const lds_cptr kp0=shm3+LDS_K+hi*1024+r32*16; const lds_cptr vp0=shm3+LDS_V+((lane>>4)&1)*32+(lane&3)*8+(4*hi+((lane&15)>>2))*64;
  DMA_K(0,0);DMA_V(0,0);DMA_K(1,SLOTB);
  bf16x8 qr[4];
  #pragma unroll
  for(int d0=0;d0<4;++d0)qr[d0]=*reinterpret_cast<const bf16x8*>(&Qw[(long)r32*(QPREP?QPR:QP)+d0*16+hi*8]);
  if constexpr(QPREP){
    float x[4][8]; float ss=0.f;
    #pragma unroll
    for(int d0=0;d0<4;++d0){ const u32x4 w=__builtin_bit_cast(u32x4,qr[d0]);
      x[d0][0]=__uint_as_float(w.x<<16);x[d0][1]=__uint_as_float(w.x&0xffff0000u);x[d0][2]=__uint_as_float(w.y<<16);x[d0][3]=__uint_as_float(w.y&0xffff0000u);
      x[d0][4]=__uint_as_float(w.z<<16);x[d0][5]=__uint_as_float(w.z&0xffff0000u);x[d0][6]=__uint_as_float(w.w<<16);x[d0][7]=__uint_as_float(w.w&0xffff0000u);
      #pragma unroll
      for(int e=0;e<8;++e)ss+=x[d0][e]*x[d0][e]; }
    { auto rr=__builtin_amdgcn_permlane32_swap(__float_as_uint(ss),__float_as_uint(ss),false,false); ss=__uint_as_float(rr[0])+__uint_as_float(rr[1]); }
    const float rinv=__builtin_amdgcn_rsqf(ss*(1.f/64.f)+1e-6f)*C2;
    const int tok=tok0+wid*QBLK+r32; const float prow=tok0<0?0.f:(float)(tok>>6), pcol=tok0<0?0.f:(float)(tok&63);
    #pragma unroll
    for(int d0=0;d0<4;++d0){
      const float pos=d0<2?prow:pcol;
      #pragma unroll
      for(int p=0;p<4;++p){ const int f=(d0&1)*8+hi*4+p; const float ang=pos*__builtin_amdgcn_exp2f(-(float)f*0.83048202372184058f);
        const float cs=__cosf(ang),sn=__sinf(ang);
        const float xe=x[d0][2*p]*rinv*qw[d0*16+hi*8+2*p],xo=x[d0][2*p+1]*rinv*qw[d0*16+hi*8+2*p+1];
        x[d0][2*p]=xe*cs-xo*sn; x[d0][2*p+1]=xe*sn+xo*cs; }
      u32x4 w; w.x=cvtpk_s(x[d0][0],x[d0][1]);w.y=cvtpk_s(x[d0][2],x[d0][3]);w.z=cvtpk_s(x[d0][4],x[d0][5]);w.w=cvtpk_s(x[d0][6],x[d0][7]);
      qr[d0]=__builtin_bit_cast(bf16x8,w); }
  }
  float mhat=0.f,l_reg=0.f;f32x16 o[2];o[0]=f32x16{};o[1]=f32x16{};f32x16 negm=f32x16{};
  if constexpr(FIXMAX){ int nb_=__builtin_amdgcn_readfirstlane(__float_as_int(negB)); asm volatile("":"+s"(nb_));
    const float nb=__int_as_float(nb_);
    #pragma unroll
    for(int r=0;r<16;++r)negm[r]=nb;}
  asm volatile("":"+v"(negm));
  #define CMASK(P0,P1,t) do{}while(0)
  bool resc=false;
  #define START(P0,P1) do{ resc=false; \
    if constexpr(!FIXMAX){ const float rm=rowmax(P0,P1); const float dl=rm; mhat=fadd_s(mhat,dl); \
      _Pragma("unroll") for(int r=0;r<16;++r){P0[r]=fsub_s(P0[r],dl);P1[r]=fsub_s(P1[r],dl);} \
      _Pragma("unroll") for(int r=0;r<16;++r)negm[r]=-mhat; asm volatile("":"+v"(negm)); } \
    _Pragma("unroll") for(int r=0;r<16;++r)P0[r]=__builtin_amdgcn_exp2f(P0[r]); }while(0)
  #define RESC() do{ if(resc){ asm volatile("s_waitcnt lgkmcnt(0)":::"memory"); \
      _Pragma("unroll") for(int d_=0;d_<2;++d_) _Pragma("unroll") for(int r=0;r<16;++r)o[d_][r]*=wsf[crow(r,hi)]; } }while(0)
  f32x16 pA0,pA1,pB0,pB1;
  int sl_prev=0,sl_cur=0,sl_next=SLOTB;
  #define ROT() do{sl_prev=sl_cur;sl_cur=sl_next;sl_next=(sl_next==(NSLOT-1)*SLOTB)?0:sl_next+SLOTB;}while(0)
  DMA_K(2,2*SLOTB);
  WAIT_BAR(3);
  qkt(pA0,pA1,Kbase,qr,negm,r32,hi);asm volatile("s_nop 15\n\ts_nop 7":"+v"(pA0),"+v"(pA1));CMASK(pA0,pA1,0);
  START(pA0,pA1);
  _Pragma("unroll") for(int r=0;r<16;++r)pA1[r]=__builtin_amdgcn_exp2f(pA1[r]);
  WAIT_BAR(0);
  DMA_K(3,0);DMA_V(1,SLOTB);
  ROT();
  kload8(kf,kp0+sl_cur);
  WAIT_BAR(2);
  s16x4 vlo[8],vhi[8]; u32x4 pw0,pw1,pw2,pw3;
  #define PKW(P,B) cvtpk_s(P[B],P[B+1])
  #define PAF(k) __builtin_bit_cast(bf16x8,pw##k)
  #define VFR(i) (bf16x8){vlo[i][0],vlo[i][1],vlo[i][2],vlo[i][3],vhi[i][0],vhi[i][1],vhi[i][2],vhi[i][3]}
  #define PIN(x) asm volatile("":"+v"(x))
  #define MX3(a,b,c) __builtin_fmaxf(__builtin_fmaxf((a),(b)),(c))
  #define GAPA(MF,A0,A1,A2,A3,W0,W1,PW) do{ MF; sacc+=A0; sacc+=A1; sacc+=A2; sacc+=A3; PIN(sacc); W0; W1; PIN(PW); SBAR(); }while(0)
  #define EX(v) __builtin_amdgcn_exp2f(v)
  #define GAPB(MF,X,B) do{ MF; X[B]=EX(X[B]); X[B+1]=EX(X[B+1]); X[B+2]=EX(X[B+2]); X[B+3]=EX(X[B+3]); PIN(X); SBAR(); }while(0)
  #define VRD(i) do{ vlo[i]=vtr(vp_+(((i)>>2)*4096+((i)&3)*1024)); vhi[i]=vtr(vp_+(((i)>>2)*4096+((i)&3)*1024+512)); }while(0)
  #define KRD(G,j) do{ if(G){ kload2(kf,kp0+sl_next,j); SBAR(); } }while(0)
  #define STEP(C0,C1,P0,P1,t,GK,GV,GL) do{ SBAR(); \
    const lds_cptr vp_=vp0+sl_prev; \
    VRD(0); SBAR(); float sacc=(P0[0]+P0[1]); \
    GAPA(C0=__builtin_amdgcn_mfma_f32_32x32x16_bf16(kf[0],qr[0],negm,0,0,0), P0[2],P0[3],P0[4],P0[5],     pw0[0]=PKW(P0,0), pw0[1]=PKW(P0,2), pw0); \
    VRD(4); SBAR(); GAPA(C1=__builtin_amdgcn_mfma_f32_32x32x16_bf16(kf[1],qr[0],negm,0,0,0), P0[6],P0[7],P0[8],P0[9],     pw0[2]=PKW(P0,4), pw0[3]=PKW(P0,6), pw0); \
    VRD(1); SBAR(); GAPA(C0=__builtin_amdgcn_mfma_f32_32x32x16_bf16(kf[2],qr[1],C0,0,0,0),   P0[10],P0[11],P0[12],P0[13], pw1[0]=PKW(P0,8), pw1[1]=PKW(P0,10), pw1); \
    VRD(5); SBAR(); GAPA(C1=__builtin_amdgcn_mfma_f32_32x32x16_bf16(kf[3],qr[1],C1,0,0,0),   P0[14],P0[15],P1[0],P1[1],   pw1[2]=PKW(P0,12),pw1[3]=PKW(P0,14), pw1); \
    VRD(2); SBAR(); GAPA(C0=__builtin_amdgcn_mfma_f32_32x32x16_bf16(kf[4],qr[2],C0,0,0,0),   P1[2],P1[3],P1[4],P1[5],     pw2[0]=PKW(P1,0), pw2[1]=PKW(P1,2), pw2); \
    VRD(6); SBAR(); GAPA(C1=__builtin_amdgcn_mfma_f32_32x32x16_bf16(kf[5],qr[2],C1,0,0,0),   P1[6],P1[7],P1[8],P1[9],     pw2[2]=PKW(P1,4), pw2[3]=PKW(P1,6), pw2); \
    VRD(3); SBAR(); GAPA(C0=__builtin_amdgcn_mfma_f32_32x32x16_bf16(kf[6],qr[3],C0,0,0,0),   P1[10],P1[11],P1[12],P1[13], pw3[0]=PKW(P1,8), pw3[1]=PKW(P1,10), pw3); \
    VRD(7); SBAR(); GAPA(C1=__builtin_amdgcn_mfma_f32_32x32x16_bf16(kf[7],qr[3],C1,0,0,0),   P1[14],P1[15],0.f,0.f,       pw3[2]=PKW(P1,12),pw3[3]=PKW(P1,14), pw3); \
    l_reg+=sacc; \
    if(GK){DMA_K((t)+3,sl_cur);} if(GV){DMA_V((t)+1,sl_next);} \
    CMASK(C0,C1,t); \
    if constexpr(!FIXMAX){ float a=MX3(C0[0],C0[1],C1[0]),b=MX3(C0[2],C0[3],C1[1]); a=MX3(a,C1[2],C1[3]); \
      _Pragma("unroll") for(int r=4;r<16;r+=4){a=MX3(a,C0[r],C0[r+1]);b=MX3(b,C0[r+2],C0[r+3]);a=MX3(a,C1[r],C1[r+1]);b=MX3(b,C1[r+2],C1[r+3]);} \
      float rm=__builtin_fmaxf(a,b); { auto rr=__builtin_amdgcn_permlane32_swap(__float_as_uint(rm),__float_as_uint(rm),false,false); rm=__builtin_fmaxf(__uint_as_float(rr[0]),__uint_as_float(rr[1])); } \
      resc=false; \
      if(__builtin_expect(__any(rm>(float)THRL),0)){ const float dl=__builtin_fmaxf(rm,0.f); mhat+=dl; \
        _Pragma("unroll") for(int r=0;r<16;++r){C0[r]-=dl;C1[r]-=dl;} \
        _Pragma("unroll") for(int r=0;r<16;++r)negm[r]=-mhat; asm volatile("":"+v"(negm)); \
        const float f=__builtin_amdgcn_exp2f(-dl); l_reg*=f; if(hi==0)wsf[r32]=f; resc=true; } } \
    SBAR(); \
    GAPB(o[0]=__builtin_amdgcn_mfma_f32_32x32x16_bf16(PAF(0),VFR(0),o[0],0,0,0), C0,0); \
    GAPB(o[1]=__builtin_amdgcn_mfma_f32_32x32x16_bf16(PAF(0),VFR(4),o[1],0,0,0), C0,4); \
    KRD(GL,0); GAPB(o[0]=__builtin_amdgcn_mfma_f32_32x32x16_bf16(PAF(1),VFR(1),o[0],0,0,0), C0,8); \
    KRD(GL,1); GAPB(o[1]=__builtin_amdgcn_mfma_f32_32x32x16_bf16(PAF(1),VFR(5),o[1],0,0,0), C0,12); \
    KRD(GL,2); GAPB(o[0]=__builtin_amdgcn_mfma_f32_32x32x16_bf16(PAF(2),VFR(2),o[0],0,0,0), C1,0); \
    KRD(GL,3); GAPB(o[1]=__builtin_amdgcn_mfma_f32_32x32x16_bf16(PAF(2),VFR(6),o[1],0,0,0), C1,4); \
    GAPB(o[0]=__builtin_amdgcn_mfma_f32_32x32x16_bf16(PAF(3),VFR(3),o[0],0,0,0), C1,8); \
    GAPB(o[1]=__builtin_amdgcn_mfma_f32_32x32x16_bf16(PAF(3),VFR(7),o[1],0,0,0), C1,12); \
    }while(0)
  int t=1;
  #undef CMASK
  #define CMASK(P0,P1,t) do{}while(0)
  for(;t+5<NT;t+=2){
    STEP(pB0,pB1,pA0,pA1,t,true,true,true);     WAIT_BAR(2); RESC(); ROT();
    STEP(pA0,pA1,pB0,pB1,t+1,true,true,true);   WAIT_BAR(2); RESC(); ROT();
  }
  #undef CMASK
  #define CMASK(P0,P1,t) do{}while(0)
  #define ENDW(tt) do{ if((tt)+3<NT){WAIT_BAR(2);} else if((tt)+2<NT){WAIT_BAR(1);} else {WAIT_BAR(0);} }while(0)
  for(;t+1<NT;t+=2){
    STEP(pB0,pB1,pA0,pA1,t,(t+3<NT),(t+1<NT),(t+1<NT));       ENDW(t);   RESC(); ROT();
    STEP(pA0,pA1,pB0,pB1,t+1,(t+4<NT),(t+2<NT),(t+2<NT));     ENDW(t+1); RESC(); ROT();
  }
  STEP(pB0,pB1,pA0,pA1,NT-1,false,false,false); RESC();
  { float sacc=pB0[0]+pB0[1]; _Pragma("unroll") for(int r=2;r<16;++r)sacc+=pB0[r]; _Pragma("unroll") for(int r=0;r<16;++r)sacc+=pB1[r]; l_reg+=sacc;
    pw0=(u32x4){PKW(pB0,0),PKW(pB0,2),PKW(pB0,4),PKW(pB0,6)};pw1=(u32x4){PKW(pB0,8),PKW(pB0,10),PKW(pB0,12),PKW(pB0,14)};pw2=(u32x4){PKW(pB1,0),PKW(pB1,2),PKW(pB1,4),PKW(pB1,6)};pw3=(u32x4){PKW(pB1,8),PKW(pB1,10),PKW(pB1,12),PKW(pB1,14)};
    SBAR(); pv(o,vb0+sl_cur,PAF(0),PAF(1),PAF(2),PAF(3)); }
  #undef PKW
  #undef PAF
  #undef VFR
  #undef PIN
  #undef MX3
  #undef GAPA
  #undef GAPB
  #undef EX
  #undef VRD
  #undef KRD
  #undef STEP
  #undef ENDW
  {auto rr=__builtin_amdgcn_permlane32_swap(__float_as_uint(l_reg),__float_as_uint(l_reg),false,false);l_reg=__uint_as_float(rr[0])+__uint_as_float(rr[1]);}
  if(hi==0)wsf[32+r32]=l_reg;asm volatile("s_waitcnt lgkmcnt(0)":::"memory");
  float rli[16];
  #pragma unroll
  for(int r=0;r<16;++r)rli[r]=__builtin_amdgcn_rcpf(wsf[32+crow(r,hi)]);
  bf16*Ow=Oh+(long)(wid*QBLK)*OP;
  { bf16*stg=(bf16*)(shm+LDS_OST)+wid*2048;
    #pragma unroll
    for(int r=0;r<16;++r){const int orow=crow(r,hi);
      #pragma unroll
      for(int d0=0;d0<2;++d0)stg[orow*64+d0*32+r32]=__float2bfloat16(o[d0][r]*rli[r]);}
    asm volatile("s_waitcnt lgkmcnt(0)":::"memory");
    #pragma unroll
    for(int i=0;i<4;++i){const int row=i*8+(lane>>3),ch=lane&7; const u32x4 v=*(const u32x4*)(stg+row*64+ch*8); ATTN_STORE16(Ow+(long)row*OP+ch*8,v);} }
  asm volatile("s_waitcnt lgkmcnt(0)\n\ts_barrier":::"memory");
  #undef DMA_K
  #undef DMA_V
  #undef CMASK
  #undef START
  #undef RESC
  #undef ROT
}
constexpr int ATTN_LDS_BYTES=LDS_BYTES;
#undef SBAR
#undef WAIT_BAR
}
#define GAS __attribute__((address_space(1)))
#define LAS __attribute__((address_space(3)))
typedef unsigned short bf16;
typedef unsigned v4u __attribute__((ext_vector_type(4)));
typedef float f32x4 __attribute__((ext_vector_type(4)));
typedef short bf16x8 __attribute__((ext_vector_type(8)));
typedef GAS unsigned gu32;
typedef GAS unsigned long long gu64;
#define RLX_AGENT __ATOMIC_RELAXED, __HIP_MEMORY_SCOPE_AGENT
#define LDS_WAIT() asm volatile("s_waitcnt lgkmcnt(0)" ::: "memory")
#define VM_WAIT() asm volatile("s_waitcnt vmcnt(0)" ::: "memory")
__device__ __forceinline__ unsigned long long rt() { return __builtin_amdgcn_s_memrealtime(); }
__device__ __forceinline__ unsigned f2bf(float f) { unsigned u = __builtin_bit_cast(unsigned, f); return (u + 0x7fffu + ((u >> 16) & 1u)) >> 16; }
__device__ __forceinline__ unsigned pk2(float lo, float hi) { return f2bf(lo) | (f2bf(hi) << 16); }

#define XB_TMO      128
#define XB_XCNT(j)  (256  + 64 * (j))
#define XB_XSUB(j)  (1280 + 64 * (j))
#define XB_XGEN(j)  (2304 + 64 * (j))
#define XB_TOP      3328
#define XB_TOPGEN   3392
#define XCD_BAR_WORDS 3456
#define XB_SPIN_CAP (1u << 18)

__device__ __forceinline__ unsigned xb_ld(unsigned* p)              { return __hip_atomic_load(p, __ATOMIC_RELAXED, __HIP_MEMORY_SCOPE_AGENT); }
__device__ __forceinline__ unsigned xb_add(unsigned* p, unsigned v) { return __hip_atomic_fetch_add(p, v, __ATOMIC_RELAXED, __HIP_MEMORY_SCOPE_AGENT); }
__device__ __forceinline__ unsigned xb_xcc_id() { return (unsigned)__builtin_amdgcn_s_getreg((3 << 11) | 20) & 0xFu; }
#define XB_SPIN(cond, bar) do { unsigned _sp = 0; while (cond) { __builtin_amdgcn_s_sleep(1); \
    if ((++_sp & 255u) == 0u) { if (xb_ld(&(bar)[XB_TMO])) break; if (_sp > XB_SPIN_CAP) { atomicAdd(&(bar)[XB_TMO], 1u); break; } } } } while (0)

struct XcdBarrier {
    unsigned* bar; unsigned x;
    volatile LAS unsigned* st;
};

__device__ __forceinline__ XcdBarrier xcd_barrier_post(unsigned* bar, volatile LAS unsigned* st) {
    XcdBarrier b; b.bar = bar; b.x = xb_xcc_id(); b.st = st;
    if (threadIdx.x == 0) (void)xb_add(&bar[XB_XCNT(b.x)], 1u);
    return b;
}
__device__ __forceinline__ void xcd_barrier_complete(unsigned* bar, unsigned x, unsigned& nloc, unsigned& nx) {
    const unsigned G = gridDim.x * gridDim.y * gridDim.z;
    unsigned sum, cnt, mine, sp = 0u;
    for (;;) {
        sum = 0u; cnt = 0u; mine = 0u;
#pragma unroll
        for (unsigned j = 0; j < 16; ++j) { const unsigned c = xb_ld(&bar[XB_XCNT(j)]); sum += c; cnt += (c > 0u) ? 1u : 0u; mine = (j == x) ? c : mine; }
        if (sum == G) break;
        __builtin_amdgcn_s_sleep(1);
        if ((++sp & 255u) == 0u) { if (xb_ld(&bar[XB_TMO])) break; if (sp > XB_SPIN_CAP) { atomicAdd(&bar[XB_TMO], 1u); break; } }
    }
    nloc = mine > 0u ? mine : 1u; nx = cnt > 0u ? cnt : 1u;
}

__device__ __forceinline__ void xcd_barrier(const XcdBarrier& b) {
    asm volatile("s_waitcnt vmcnt(0)" ::: "memory");
    __syncthreads();
    if (threadIdx.x == 0) {
        unsigned* bar = b.bar;
        __builtin_amdgcn_s_waitcnt(0);
        unsigned nloc = b.st[0], nx = b.st[1];
        if (nloc == 0u) { xcd_barrier_complete(bar, b.x, nloc, nx); b.st[0] = nloc; b.st[1] = nx; }
        const unsigned old = xb_add(&bar[XB_XSUB(b.x)], 1u);
        const unsigned gen = old / nloc;
        if (old + 1u == (gen + 1u) * nloc) {
            __builtin_amdgcn_fence(__ATOMIC_RELEASE, "agent");
            asm volatile("s_waitcnt vmcnt(0)" ::: "memory");
            const unsigned og = xb_add(&bar[XB_TOP], 1u);
            const unsigned tg = og / nx;
            if (og + 1u == (tg + 1u) * nx) xb_add(&bar[XB_TOPGEN], 1u);
            else XB_SPIN(xb_ld(&bar[XB_TOPGEN]) == tg, bar);
            __builtin_amdgcn_fence(__ATOMIC_ACQUIRE, "agent");
            xb_add(&bar[XB_XGEN(b.x)], 1u);
            asm volatile("s_waitcnt vmcnt(0)" ::: "memory");
        } else {
            XB_SPIN(xb_ld(&bar[XB_XGEN(b.x)]) == gen, bar);
            __builtin_amdgcn_fence(__ATOMIC_ACQUIRE, "agent");
            asm volatile("s_waitcnt vmcnt(0)" ::: "memory");
        }
    }
    __syncthreads();
}

constexpr int NWAVES = 8, NTHR = 512;
constexpr int DM = 1024, NB = 4, TL = 8192, TC = 256, TT = TL + TC, MROWS = NB * TT  , MLAT = NB * TL  ;
constexpr int NP = 2304, DIN = 2320;
constexpr int CQ = 0, CK = 256, CV = 512, CO = 1024, CAQ = 1536, CAK = 2048, CAV = 2176;
constexpr int DFF = 2816, DFE = 3584, NEXP = 8;
constexpr int NBLK = TT / 128;
constexpr int NSEQ = NB * 4 * 2;
constexpr float EPS = 1e-6f;
constexpr int N_PHASES = 23;
constexpr int PASS_TILES = 128, ACT1_TILES = 136;

constexpr size_t MiB = 1u << 20;
constexpr size_t WS_CTL = 0, CTL_ZERO_BYTES = 1 * MiB;
constexpr size_t WS_MODS = 1 * MiB;
constexpr size_t WS_ROUTE = 2 * MiB;
constexpr size_t RT_TOKE = 0, RT_TOKG = 128 * 1024, RT_CNT = 384 * 1024, RT_INFO = 400 * 1024, RT_TILEE = 404 * 1024, RT_ROWTOK = 512 * 1024, RT_ROWG = 800 * 1024;
constexpr size_t WS_CTXRES = 4 * MiB;
constexpr size_t WS_GATES = 8 * MiB;
constexpr size_t WS_CSTN = 11 * MiB, WS_CSTM = 11 * MiB + 768 * 1024, WS_CSTE = 11 * MiB + 896 * 1024;
constexpr float W_UP_SCALE = 32.f, W_DN_SCALE = 64.f, ACT_SCALE = 4.f;
#ifndef P_I8
#define P_I8 1
#endif
#ifndef DENSE_I8
#define DENSE_I8 1
#endif
#ifndef DENSE_FP8
#define DENSE_FP8 0
#endif
constexpr int DB = DENSE_FP8 ? 1 : 2;
constexpr int UB = (DENSE_FP8 || DENSE_I8) ? 1 : 2;
constexpr int UMODE = DENSE_I8 ? 2 : (DENSE_FP8 ? 1 : 0);
constexpr int PB_ = P_I8 ? 1 : 2;
constexpr int CW_CMAX_IN = 8192, CW_CMAX_UP = 8192 + 2 * NP;
constexpr size_t RT_ROWSC_H = 1400 * 1024;
constexpr int CW_WMAX = 64;
constexpr size_t RT_ROWSC = 1200 * 1024;
constexpr size_t WS_MGU = 12 * MiB, WS_MD = 68 * MiB;
constexpr size_t WS_WIN = 96 * MiB, WS_WOUT = 105 * MiB, WS_WGU = 109 * MiB, WS_WD = 120 * MiB;
constexpr size_t WS_HY = 126 * MiB;
constexpr size_t WS_P = 192 * MiB;
constexpr size_t WS_QN = WS_P + (size_t)MROWS * NP * 2;
constexpr size_t WS_KN = WS_QN + (size_t)MROWS * 512 * 2;
constexpr size_t WS_GPRE = WS_QN;
constexpr size_t WS_CSTC = 382 * MiB;
constexpr size_t WS_ACT0 = 192 * MiB;
constexpr size_t WS_H2B = 382 * MiB;
constexpr size_t WS_ASORT = 126 * MiB;
constexpr size_t WS_EOUT = 192 * MiB;
constexpr size_t WS_ACT1 = 324 * MiB;
constexpr size_t WS_RESID = 508 * MiB;
constexpr size_t WS_END = 572 * MiB;
constexpr size_t RP = 2048;
constexpr size_t WS_SLAB_CW = WS_QN, WS_SLAB_CD = WS_CSTC;
constexpr int NS_CW = 4, NS_CD = DENSE_FP8 ? 0 : 11;
constexpr size_t WS_SLAB_MT = WS_MGU;
constexpr int NS_MT = 7, MT_TILES = 8;
static_assert(WS_KN + (size_t)MROWS * 128 * 2 <= WS_CSTC && WS_CSTC + (size_t)NSEQ * NBLK * 8192 * 4 <= WS_RESID, "ws map");
static_assert(WS_ACT0 + (size_t)MROWS * DFF * DB <= WS_CSTC && WS_ASORT + (size_t)264 * 256 * DM <= WS_EOUT && WS_EOUT + (size_t)264 * 256 * DM * 2 <= WS_ACT1 && WS_ACT1 + (size_t)ACT1_TILES * 256 * DFE <= WS_RESID && WS_H2B + (size_t)MLAT * DM <= WS_RESID, "ws map 2");
static_assert(WS_MGU + (size_t)NEXP * 2 * DFE * DM <= WS_MD && WS_MD + (size_t)NEXP * DM * DFE <= WS_WIN && WS_WIN + (size_t)2 * NP * DM * 2 <= WS_WOUT && WS_WOUT + (size_t)2 * DM * DM * 2 <= WS_WGU && WS_WGU + (size_t)2 * DFF * DM * UB <= WS_WD && WS_WD + (size_t)DM * DFF * DB <= WS_HY && (size_t)NS_MT * MT_TILES * 256 * 1024 * 4 <= WS_MD - WS_MGU, "ws map 3");
constexpr int CW_BAR = 4096;

constexpr int LDS_BYTES = 155648;
constexpr int MISC_OFF = 154624;

struct Args { const float* in[22]; float* out; unsigned char* ws; int ph_lo, ph_hi, li, pad; };
typedef const __attribute__((address_space(4))) Args* CAP;
__device__ __forceinline__ const float* ain(CAP a, int k) { return (const float*)(const GAS float*)(unsigned long long)a->in[k]; }
__device__ __forceinline__ float* aout(CAP a) { return (float*)(GAS float*)(unsigned long long)a->out; }
__device__ __forceinline__ CAP args_ptr() { unsigned long long p = (unsigned long long)__builtin_amdgcn_kernarg_segment_ptr(); asm volatile("" : "+s"(p)); return (CAP)p; }

struct Frame {
    LAS unsigned char* lds; volatile LAS unsigned* MISC; gu32* ctl; unsigned char* ws;
    int tid, lane, wave, vcu, G, gw, NGW;
};

__device__ __forceinline__ float shx(float v, int o, int lane) { return __int_as_float(__builtin_amdgcn_ds_bpermute((lane ^ o) << 2, __float_as_int(v))); }
__device__ __forceinline__ float shu(float v, int o, int lane) { return __int_as_float(__builtin_amdgcn_ds_bpermute(((lane - o) & 63) << 2, __float_as_int(v))); }
__device__ __forceinline__ float shi(float v, int src) { return __int_as_float(__builtin_amdgcn_ds_bpermute(src << 2, __float_as_int(v))); }
#define WAVE_DPP(v, ctrl) __int_as_float(__builtin_amdgcn_update_dpp(0, __float_as_int(v), ctrl, 0xf, 0xf, true))
__device__ __forceinline__ float wave_sum(float v, int lane) {
    (void)lane;
    v += WAVE_DPP(v, 0xB1); v += WAVE_DPP(v, 0x4E); v += WAVE_DPP(v, 0x141); v += WAVE_DPP(v, 0x140);
    { auto rr = __builtin_amdgcn_permlane16_swap(__float_as_uint(v), __float_as_uint(v), false, false); v = __uint_as_float(rr[0]) + __uint_as_float(rr[1]); }
    { auto rr = __builtin_amdgcn_permlane32_swap(__float_as_uint(v), __float_as_uint(v), false, false); v = __uint_as_float(rr[0]) + __uint_as_float(rr[1]); }
    return v;
}
__device__ __forceinline__ float wave_max(float v, int lane) {
    (void)lane;
    v = fmaxf(v, WAVE_DPP(v, 0xB1)); v = fmaxf(v, WAVE_DPP(v, 0x4E)); v = fmaxf(v, WAVE_DPP(v, 0x141)); v = fmaxf(v, WAVE_DPP(v, 0x140));
    { auto rr = __builtin_amdgcn_permlane16_swap(__float_as_uint(v), __float_as_uint(v), false, false); v = fmaxf(__uint_as_float(rr[0]), __uint_as_float(rr[1])); }
    { auto rr = __builtin_amdgcn_permlane32_swap(__float_as_uint(v), __float_as_uint(v), false, false); v = fmaxf(__uint_as_float(rr[0]), __uint_as_float(rr[1])); }
    return v;
}
#define SCAN_DPP(idv, v, ctrl, rmask) __int_as_float(__builtin_amdgcn_update_dpp(__float_as_int(idv), __float_as_int(v), ctrl, rmask, 0xf, false))
__device__ __forceinline__ float wave_incl_scan_add(float v, int lane) {
    (void)lane;
    v += SCAN_DPP(0.f, v, 0x111, 0xf); v += SCAN_DPP(0.f, v, 0x112, 0xf); v += SCAN_DPP(0.f, v, 0x114, 0xf); v += SCAN_DPP(0.f, v, 0x118, 0xf);
    v += SCAN_DPP(0.f, v, 0x142, 0xa); v += SCAN_DPP(0.f, v, 0x143, 0xc);
    return v;
}
__device__ __forceinline__ float wave_incl_scan_max(float v, int lane) {
    (void)lane; const float ninf = -INFINITY;
    v = fmaxf(v, SCAN_DPP(ninf, v, 0x111, 0xf)); v = fmaxf(v, SCAN_DPP(ninf, v, 0x112, 0xf)); v = fmaxf(v, SCAN_DPP(ninf, v, 0x114, 0xf)); v = fmaxf(v, SCAN_DPP(ninf, v, 0x118, 0xf));
    v = fmaxf(v, SCAN_DPP(ninf, v, 0x142, 0xa)); v = fmaxf(v, SCAN_DPP(ninf, v, 0x143, 0xc));
    return v;
}
__device__ __forceinline__ float bf2f(unsigned short b) { return __uint_as_float((unsigned)b << 16); }
__device__ __forceinline__ float bflo(unsigned w) { return __uint_as_float(w << 16); }
__device__ __forceinline__ float bfhi(unsigned w) { return __uint_as_float(w & 0xffff0000u); }
__device__ __forceinline__ float logsig(float x) { return fminf(x, 0.f) - __logf(1.f + __expf(-fabsf(x))); }
__device__ __forceinline__ float siluf(float x) { return x / (1.f + __expf(-x)); }
__device__ __forceinline__ float dot4(f32x4 a, f32x4 b) { return (a.x * b.x + a.y * b.y) + (a.z * b.z + a.w * b.w); }
#define MFMA16(a, b, c) __builtin_amdgcn_mfma_f32_16x16x32_bf16((a), (b), (c), 0, 0, 0)
__device__ __forceinline__ unsigned pk4_i8(float a, float b, float c, float d) {
    const int qa = (int)__builtin_amdgcn_fmed3f(__builtin_rintf(a), -127.f, 127.f), qb = (int)__builtin_amdgcn_fmed3f(__builtin_rintf(b), -127.f, 127.f), qc = (int)__builtin_amdgcn_fmed3f(__builtin_rintf(c), -127.f, 127.f), qd = (int)__builtin_amdgcn_fmed3f(__builtin_rintf(d), -127.f, 127.f);
    return (unsigned)(qa & 255) | ((unsigned)(qb & 255) << 8) | ((unsigned)(qc & 255) << 16) | ((unsigned)(qd & 255) << 24); }
__device__ __forceinline__ float c448(float x) { return __builtin_amdgcn_fmed3f(x, -448.f, 448.f); }
__device__ __forceinline__ unsigned pk4_fp8(float a, float b, float c, float d) {
    int p = 0; p = __builtin_amdgcn_cvt_pk_fp8_f32(c448(a), c448(b), p, false); p = __builtin_amdgcn_cvt_pk_fp8_f32(c448(c), c448(d), p, true); return (unsigned)p; }

struct TrDesc { const float* src; unsigned char* dst; int ldw, ldt; float sc8; int mode; const gu32* cmax; };
constexpr int I0 = 2 * 16 * 72, I1 = 2 * 16 * 32, I2 = 16 * 176, I3 = 44 * 32, I4 = 8 * 16 * 224, I5 = 8 * 56 * 32;
constexpr int I_SMALL = I0 + I1 + I2 + I3, I_MOE = I4 + I5;
__device__ __forceinline__ TrDesc tr_desc(Frame& F, CAP a, int it) {
    TrDesc d; int r = it;
    if (r < I0) { const int L = r / 1152, rem = r % 1152, kb = rem / 72, nb = rem % 72, c0 = 32 * nb;
        d.ldw = DIN; d.src = ain(a, 8) + (size_t)L * DM * DIN + (size_t)(64 * kb) * DIN + (c0 < 1536 ? c0 : c0 + 16); d.ldt = DM * PB_; d.dst = F.ws + WS_WIN + ((size_t)L * NP * DM + (size_t)c0 * DM + 64 * kb) * PB_; d.mode = P_I8 ? 2 : 0; d.sc8 = 0.f; d.cmax = F.ctl + CW_CMAX_IN + L * NP + c0; return d; }
    r -= I0;
    if (r < I1) { const int L = r / 512, rem = r % 512, kb = rem / 32, nb = rem % 32;
        d.ldw = DM; d.src = ain(a, 13) + (size_t)L * DM * DM + (size_t)(64 * kb) * DM + 32 * nb; d.ldt = DM * 2; d.dst = F.ws + WS_WOUT + ((size_t)L * DM * DM + (size_t)(32 * nb) * DM + 64 * kb) * 2; d.sc8 = 0.f; d.mode = 0; return d; }
    r -= I1;
    if (r < I2) { const int kb = r / 176, nb = r % 176, r0 = 32 * nb, pn = r0 >> 8, wi = r0 & 255;
        d.ldw = DFF; d.src = (wi < 128 ? ain(a, 14) : ain(a, 15)) + (size_t)(64 * kb) * DFF + 128 * pn + (wi & 127); d.ldt = DM * UB; d.dst = F.ws + WS_WGU + ((size_t)r0 * DM + 64 * kb) * UB; d.mode = UMODE; d.sc8 = DENSE_FP8 ? W_UP_SCALE : 0.f; d.cmax = F.ctl + CW_CMAX_UP + r0; return d; }
    r -= I2;
    if (r < I3) { const int kb = r / 32, nb = r % 32;
        d.ldw = DM; d.src = ain(a, 16) + (size_t)(64 * kb) * DM + 32 * nb; d.ldt = DFF * DB; d.dst = F.ws + WS_WD + ((size_t)(32 * nb) * DFF + 64 * kb) * DB; d.sc8 = DENSE_FP8 ? W_DN_SCALE : 0.f; d.mode = DENSE_FP8 ? 1 : 0; return d; }
    r -= I3;
    if (r < I4) { const int e = r / 3584, rem = r % 3584, kb = rem / 224, nb = rem % 224, r0 = 32 * nb, pn = r0 >> 8, wi = r0 & 255;
        d.ldw = DFE; d.src = (wi < 128 ? ain(a, 18) : ain(a, 19)) + (size_t)e * DM * DFE + (size_t)(64 * kb) * DFE + 128 * pn + (wi & 127); d.ldt = DM; d.dst = F.ws + WS_MGU + (size_t)e * 2 * DFE * DM + (size_t)r0 * DM + 64 * kb; d.sc8 = W_UP_SCALE; d.mode = 1; return d; }
    r -= I4;
    { const int e = r / 1792, rem = r % 1792, kb = rem / 32, nb = rem % 32;
        d.ldw = DM; d.src = ain(a, 20) + (size_t)e * DFE * DM + (size_t)(64 * kb) * DM + 32 * nb; d.ldt = DFE; d.dst = F.ws + WS_MD + (size_t)e * DM * DFE + (size_t)(32 * nb) * DFE + 64 * kb; d.sc8 = W_DN_SCALE; d.mode = 1; return d; }
}
struct TrRegs { f32x4 v[8]; unsigned cm[4]; };
__device__ __forceinline__ TrRegs tr_load(const TrDesc& d, int lane) {
    TrRegs R;
#pragma unroll
    for (int i = 0; i < 8; ++i) R.v[i] = __builtin_nontemporal_load((const GAS f32x4*)(d.src + (size_t)(8 * i + (lane >> 3)) * d.ldw + 4 * (lane & 7)));
#pragma unroll
    for (int j = 0; j < 4; ++j) R.cm[j] = d.mode == 2 ? d.cmax[(lane >> 3) + 8 * j] : 0u;
    return R;
}
__device__ __forceinline__ void tr_finish(const TrDesc& d, const TrRegs& R, LAS float* scr, int lane) {
#pragma unroll
    for (int i = 0; i < 8; ++i) { LAS float* p = scr + (8 * i + (lane >> 3)) * 33 + 4 * (lane & 7); p[0] = R.v[i].x; p[1] = R.v[i].y; p[2] = R.v[i].z; p[3] = R.v[i].w; }
    LDS_WAIT(); asm volatile("" ::: "memory");
    const int c = lane & 7;
#pragma unroll
    for (int j = 0; j < 4; ++j) { const int n = (lane >> 3) + 8 * j; const LAS float* s = scr + (8 * c) * 33 + n;
        if (d.mode == 0) { v4u o; o.x = pk2(s[0 * 33], s[1 * 33]); o.y = pk2(s[2 * 33], s[3 * 33]); o.z = pk2(s[4 * 33], s[5 * 33]); o.w = pk2(s[6 * 33], s[7 * 33]);
            *(GAS v4u*)(d.dst + (size_t)n * d.ldt + 16 * c) = o; }
        else if (d.mode == 2) { const float sc8 = 127.f / fmaxf(__uint_as_float(R.cm[j]), 1e-30f); const unsigned lo = pk4_i8(s[0 * 33] * sc8, s[1 * 33] * sc8, s[2 * 33] * sc8, s[3 * 33] * sc8), hi = pk4_i8(s[4 * 33] * sc8, s[5 * 33] * sc8, s[6 * 33] * sc8, s[7 * 33] * sc8);
            *(GAS unsigned long long*)(d.dst + (size_t)n * d.ldt + 8 * c) = (unsigned long long)lo | ((unsigned long long)hi << 32); }
        else { const float sc8 = d.sc8; const unsigned lo = pk4_fp8(s[0 * 33] * sc8, s[1 * 33] * sc8, s[2 * 33] * sc8, s[3 * 33] * sc8), hi = pk4_fp8(s[4 * 33] * sc8, s[5 * 33] * sc8, s[6 * 33] * sc8, s[7 * 33] * sc8);
            *(GAS unsigned long long*)(d.dst + (size_t)n * d.ldt + 8 * c) = (unsigned long long)lo | ((unsigned long long)hi << 32); } }
    LDS_WAIT(); asm volatile("" ::: "memory");
}
__device__ __forceinline__ void convert_weights_sub(Frame& F, CAP a, int first, int count, int wrank, int nw, LAS float* scr) {
    int it = first + wrank; const int end = first + count;
    if (it >= end) return;
    TrDesc d = tr_desc(F, a, it); TrRegs R = tr_load(d, F.lane);
    for (;;) {
        const int nx = it + nw; const bool more = nx < end;
        TrDesc dn = d; TrRegs Rn = R;
        if (more) { dn = tr_desc(F, a, nx); Rn = tr_load(dn, F.lane); }
        tr_finish(d, R, scr, F.lane);
        if (!more) break;
        d = dn; R = Rn; it = nx;
    }
}
__device__ __forceinline__ void convert_weights(Frame& F, CAP a, int first, int count, LAS float* scr) { convert_weights_sub(F, a, first, count, F.gw, F.NGW, scr); }
constexpr int T_D = 168 * 8 * 5;
static_assert(T_D <= I_MOE, "tail conversion range");
__device__ __forceinline__ void tail_convert(Frame& F, CAP a, int n_units, int lo, int n_items) {
    const int rem = n_units % F.G; const bool all = rem == 0;
    if (!all && (int)blockIdx.x < rem) return;
    const int rank = all ? (int)blockIdx.x : (int)blockIdx.x - rem, nwg = all ? F.G : F.G - rem;
    convert_weights_sub(F, a, I_SMALL + lo, n_items, rank * NWAVES + F.wave, nwg * NWAVES, (LAS float*)(F.lds + F.wave * 8448));
}
__device__ __forceinline__ void phase_prologue(Frame& F, CAP a) {
    {
        LAS float* sc = (LAS float*)F.lds;
        LAS float* red = (LAS float*)(F.lds + 20480);
        float* mods = (float*)(F.ws + WS_MODS);
        for (int u = blockIdx.x; u < 192; u += F.G) {
            const int L = u / 96, cb = u % 96;
            { float xv[10];
#pragma unroll
              for (int i = 0; i < 10; ++i) { const int idx = F.tid + NTHR * i, v = idx >> 10, k = idx & 1023; xv[i] = v < 4 ? ain(a, 1)[v * 1024 + k] : ain(a, 3)[k]; }
#pragma unroll
              for (int i = 0; i < 10; ++i) sc[F.tid + NTHR * i] = siluf(xv[i]); }
            __syncthreads();
            float acc[5] = {0.f, 0.f, 0.f, 0.f, 0.f};
            const float* wp = ain(a, 4) + ((size_t)L * 1024 + 128 * F.wave) * 6144 + cb * 64 + F.lane;
#pragma unroll 1
            for (int k0 = 0; k0 < 128; k0 += 64) { float wv[64];
#pragma unroll
                for (int q = 0; q < 64; ++q) wv[q] = *(const GAS float*)(wp + (size_t)(k0 + q) * 6144);
#pragma unroll
                for (int q = 0; q < 64; ++q) {
#pragma unroll
                    for (int v = 0; v < 5; ++v) acc[v] += wv[q] * sc[v * 1024 + 128 * F.wave + k0 + q]; } }
#pragma unroll
            for (int v = 0; v < 5; ++v) red[(F.wave * 5 + v) * 64 + F.lane] = acc[v];
            __syncthreads();
            if (F.tid < 320) { const int v = F.tid >> 6, cc = F.tid & 63; float sum = ain(a, 5)[L * 6144 + cb * 64 + cc];
#pragma unroll
                for (int w = 0; w < 8; ++w) sum += red[(w * 5 + v) * 64 + cc];
                mods[(size_t)(L * 5 + v) * 6144 + cb * 64 + cc] = sum; }
            __syncthreads();
        }
    }
    {
        constexpr int NB_IN = P_I8 ? 2 * 16 * (NP / 64) : 0, NB_UP = DENSE_I8 ? 16 * (2 * DFF / 64) : 0;
        for (int blk = F.gw; blk < NB_IN + NB_UP; blk += F.NGW) {
            const float* src; int ldw; gu32* cm;
            if (blk < NB_IN) { const int L = blk / (16 * (NP / 64)), rem = blk % (16 * (NP / 64)), kb = rem / (NP / 64), c0 = 64 * (rem % (NP / 64));
                ldw = DIN; src = ain(a, 8) + (size_t)L * DM * DIN + (size_t)(64 * kb) * DIN + (c0 < 1536 ? c0 : c0 + 16); cm = F.ctl + CW_CMAX_IN + L * NP + c0; }
            else { const int r = blk - NB_IN, kb = r / (2 * DFF / 64), r0 = 64 * (r % (2 * DFF / 64)), pn = r0 >> 8, wi = r0 & 255;
                ldw = DFF; src = (wi < 128 ? ain(a, 14) : ain(a, 15)) + (size_t)(64 * kb) * DFF + 128 * pn + (wi & 127); cm = F.ctl + CW_CMAX_UP + r0; }
            unsigned mx = 0u;
#pragma unroll 1
            for (int k0 = 0; k0 < 64; k0 += 32) { unsigned wv[32];
#pragma unroll
                for (int q = 0; q < 32; ++q) wv[q] = __float_as_uint(*(const GAS float*)(src + (size_t)(k0 + q) * ldw + F.lane));
#pragma unroll
                for (int q = 0; q < 32; ++q) { const unsigned av = wv[q] & 0x7fffffffu; mx = mx > av ? mx : av; } }
            __hip_atomic_fetch_max(cm + F.lane, mx, RLX_AGENT);
        }
    }
    {
        LAS float* scr = (LAS float*)(F.lds + F.wave * 16384);
        if (!P_I8) convert_weights(F, a, 0, I0, scr);
        convert_weights(F, a, I0, I1, scr);
        if (!DENSE_I8) convert_weights(F, a, I0 + I1, I2, scr);
        convert_weights(F, a, I0 + I1 + I2, I3, scr);
    }
}

struct RowVec { f32x4 h[4]; };
__device__ __forceinline__ f32x4 bf4(unsigned long long w) { return (f32x4){bflo((unsigned)w), bfhi((unsigned)w), bflo((unsigned)(w >> 32)), bfhi((unsigned)(w >> 32))}; }
struct RowIn { f32x4 x[4]; f32x4 t[4]; };
template <bool XB> __device__ __forceinline__ RowIn load_row(const void* src, const bf16* T, int lane) {
    RowIn I;
    if constexpr (XB) { const GAS unsigned long long* xr = (const GAS unsigned long long*)src + lane;
#pragma unroll
        for (int j = 0; j < 4; ++j) I.x[j] = bf4(xr[64 * j]); }
    else { const GAS f32x4* xr = (const GAS f32x4*)src + lane;
#pragma unroll
        for (int j = 0; j < 4; ++j) I.x[j] = xr[64 * j]; }
    if (T) { const GAS unsigned long long* tr = (const GAS unsigned long long*)T + lane;
#pragma unroll
        for (int j = 0; j < 4; ++j) I.t[j] = bf4(tr[64 * j]); }
    else {
#pragma unroll
        for (int j = 0; j < 4; ++j) I.t[j] = (f32x4){0.f, 0.f, 0.f, 0.f}; }
    return I;
}
template <bool XB> __device__ __forceinline__ RowIn load_row_slabs(const void* src, const float* S, int ns, size_t sstride, int lane) {
    RowIn I = load_row<XB>(src, nullptr, lane);
#pragma unroll 1
    for (int q = 0; q < ns; ++q) { const GAS f32x4* sr = (const GAS f32x4*)(S + (size_t)q * sstride) + lane;
#pragma unroll
        for (int j = 0; j < 4; ++j) I.t[j] += sr[64 * j]; }
    return I;
}
template <bool XB> struct RowRaw { f32x4 xf[XB ? 1 : 4]; unsigned long long xb[XB ? 4 : 1]; unsigned long long t[4]; };
template <bool XB> __device__ __forceinline__ RowRaw<XB> load_raw(const void* src, const bf16* T, int lane) {
    RowRaw<XB> I;
    if constexpr (XB) { const GAS unsigned long long* xr = (const GAS unsigned long long*)src + lane;
#pragma unroll
        for (int j = 0; j < 4; ++j) I.xb[j] = xr[64 * j]; }
    else { const GAS f32x4* xr = (const GAS f32x4*)src + lane;
#pragma unroll
        for (int j = 0; j < 4; ++j) I.xf[j] = xr[64 * j]; }
    if (T) { const GAS unsigned long long* tr = (const GAS unsigned long long*)T + lane;
#pragma unroll
        for (int j = 0; j < 4; ++j) I.t[j] = tr[64 * j]; }
    else {
#pragma unroll
        for (int j = 0; j < 4; ++j) I.t[j] = 0ull; }
    return I;
}
template <bool XB> __device__ __forceinline__ RowIn cook(const RowRaw<XB>& W) {
    RowIn I;
#pragma unroll
    for (int j = 0; j < 4; ++j) { if constexpr (XB) I.x[j] = bf4(W.xb[j]); else I.x[j] = W.xf[j]; I.t[j] = bf4(W.t[j]); }
    return I;
}
struct RowPar { f32x4 g[4], w[4], sh[4]; };
__device__ __forceinline__ RowPar load_par(const float* gate, const float* nw, const float* shift, const float* scale, int lane) {
    RowPar P;
#pragma unroll
    for (int j = 0; j < 4; ++j) { const int c = 256 * j + 4 * lane;
        P.g[j] = gate ? *(const f32x4*)(gate + c) : (f32x4){0.f, 0.f, 0.f, 0.f};
        const f32x4 w = *(const f32x4*)(nw + c), sc = *(const f32x4*)(scale + c); P.w[j] = w * (sc + 1.f); P.sh[j] = *(const f32x4*)(shift + c); }
    return P;
}
__device__ __forceinline__ RowVec finish_row(const RowIn& I, bool upd, const RowPar& P, void* dst, int lane) {
    f32x4 x[4]; float ss = 0.f;
    if (upd) { GAS unsigned long long* xw = (GAS unsigned long long*)dst + lane;
#pragma unroll
        for (int j = 0; j < 4; ++j) { x[j] = I.x[j] + P.g[j] * I.t[j]; xw[64 * j] = (unsigned long long)pk2(x[j].x, x[j].y) | ((unsigned long long)pk2(x[j].z, x[j].w) << 32); } }
    else {
#pragma unroll
        for (int j = 0; j < 4; ++j) x[j] = I.x[j]; }
#pragma unroll
    for (int j = 0; j < 4; ++j) ss += dot4(x[j], x[j]);
    const float rinv = rsqrtf(wave_sum(ss, lane) * (1.f / DM) + EPS);
    RowVec R;
#pragma unroll
    for (int j = 0; j < 4; ++j) R.h[j] = (x[j] * rinv) * P.w[j] + P.sh[j];
    return R;
}
__device__ __forceinline__ void store_row_bf16(bf16* dst, const RowVec& R, int lane) {
    GAS unsigned long long* o8 = (GAS unsigned long long*)dst + lane;
#pragma unroll
    for (int j = 0; j < 4; ++j) o8[64 * j] = (unsigned long long)pk2(R.h[j].x, R.h[j].y) | ((unsigned long long)pk2(R.h[j].z, R.h[j].w) << 32);
}
__device__ __forceinline__ void store_row_fp8(unsigned char* dst, const RowVec& R, int lane) {
    GAS unsigned* o4 = (GAS unsigned*)dst + lane;
#pragma unroll
    for (int j = 0; j < 4; ++j) o4[64 * j] = pk4_fp8(R.h[j].x, R.h[j].y, R.h[j].z, R.h[j].w);
}
__device__ __forceinline__ void store_row_i8(unsigned char* dst, float* rs, const RowVec& R, int lane) {
    float m = 0.f;
#pragma unroll
    for (int j = 0; j < 4; ++j) m = fmaxf(fmaxf(m, fmaxf(fabsf(R.h[j].x), fabsf(R.h[j].y))), fmaxf(fabsf(R.h[j].z), fabsf(R.h[j].w)));
    m = fmaxf(wave_max(m, lane), 1e-30f);
    const float inv = 127.f / m;
    GAS unsigned* o4 = (GAS unsigned*)dst + lane;
#pragma unroll
    for (int j = 0; j < 4; ++j) o4[64 * j] = pk4_i8(R.h[j].x * inv, R.h[j].y * inv, R.h[j].z * inv, R.h[j].w * inv);
    if (lane == 0) *rs = m * (1.f / 127.f);
}
__device__ __forceinline__ const float* input_row(CAP a, int b, int tp) {
    if (tp < TC) return ain(a, 2) + (size_t)(b * TC + tp) * DM;
    return ain(a, 0) + (size_t)(b * TL + tp - TC) * DM;
}
__device__ __forceinline__ unsigned char* resid_ptr(const Frame& F, CAP a, int b, int tp) {
    if (tp < TC) return F.ws + WS_CTXRES + (size_t)(b * TC + tp) * RP;
    return F.ws + WS_RESID + (size_t)(b * TL + tp - TC) * RP;
}
__device__ __forceinline__ void phase_norm1(Frame& F, CAP a, int L) {
    const float* nw = ain(a, 6) + L * DM;
    const float* mods = (const float*)(F.ws + WS_MODS) + (size_t)L * 5 * 6144;
    const float* gts = (const float*)(F.ws + WS_MODS) + 5 * 1024;
    bf16* H = (bf16*)(F.ws + WS_HY);
    unsigned char* H8 = F.ws + WS_QN; float* RS = (float*)(F.ws + WS_ROUTE + RT_ROWSC_H);
    static_assert(P_I8 == 1, "phase_norm1 writes int8 rows");
    if (P_I8 && L == 0) convert_weights(F, a, 0, I0, (LAS float*)(F.lds + F.wave * 16384));
    if (DENSE_I8 && L == 0) convert_weights(F, a, I0 + I1, I2, (LAS float*)(F.lds + F.wave * 16384));
    if (2 * F.gw < NB * TC) {
        const RowPar Pc = load_par(L ? gts + 4 * 6144 : nullptr, nw, mods + 4 * 6144, mods + 4 * 6144 + 1024, F.lane);
        for (int rc = 2 * F.gw; rc < NB * TC; rc += 2 * F.NGW) {
            const int b = rc / TC, tp = rc - b * TC, r = b * TT + tp;
            RowVec R0, R1;
            if (L == 0) { const float* src = ain(a, 2) + (size_t)rc * DM;
                const RowIn I0 = load_row<false>(src, nullptr, F.lane), I1 = load_row<false>(src + DM, nullptr, F.lane);
                R0 = finish_row(I0, false, Pc, nullptr, F.lane); R1 = finish_row(I1, false, Pc, nullptr, F.lane); }
            else { unsigned char* xr = F.ws + WS_CTXRES + (size_t)rc * RP; const float* S = (const float*)(F.ws + WS_SLAB_CD) + (size_t)rc * DM;
                const RowIn I0 = load_row_slabs<true>(xr, S, NS_CD, (size_t)1024 * 1024, F.lane), I1 = load_row_slabs<true>(xr + RP, S + DM, NS_CD, (size_t)1024 * 1024, F.lane);
                R0 = finish_row(I0, true, Pc, xr, F.lane); R1 = finish_row(I1, true, Pc, xr + RP, F.lane); }
            store_row_i8(H8 + (size_t)r * DM, RS + r, R0, F.lane); store_row_i8(H8 + (size_t)(r + 1) * DM, RS + r + 1, R1, F.lane);
        }
    }
    const int b = F.gw & 3, wpb = F.NGW >> 2;
    const RowPar P = load_par(L ? gts + b * 6144 : nullptr, nw, mods + b * 6144, mods + b * 6144 + 1024, F.lane);
    const float* xin = ain(a, 0) + (size_t)b * TL * DM; unsigned char* xres = F.ws + WS_RESID + (size_t)b * TL * RP;
    const bf16* T2 = H + ((size_t)b * TT + TC) * DM;
    int t = 2 * (F.gw >> 2);
    if (L == 0) {
        RowRaw<false> N0, N1;
        if (t < TL) { N0 = load_raw<false>(xin + (size_t)t * DM, nullptr, F.lane); N1 = load_raw<false>(xin + (size_t)(t + 1) * DM, nullptr, F.lane); }
#pragma unroll 1
        for (; t < TL; t += 2 * wpb) {
            const RowRaw<false> W0 = N0, W1 = N1; const int tn = t + 2 * wpb;
            if (tn < TL) { N0 = load_raw<false>(xin + (size_t)tn * DM, nullptr, F.lane); N1 = load_raw<false>(xin + (size_t)(tn + 1) * DM, nullptr, F.lane); }
            const int r = b * TT + TC + t;
            const RowVec R0 = finish_row(cook<false>(W0), false, P, nullptr, F.lane), R1 = finish_row(cook<false>(W1), false, P, nullptr, F.lane);
            store_row_i8(H8 + (size_t)r * DM, RS + r, R0, F.lane); store_row_i8(H8 + (size_t)(r + 1) * DM, RS + r + 1, R1, F.lane);
        }
    } else {
        RowRaw<true> N0, N1;
        if (t < TL) { N0 = load_raw<true>(xres + (size_t)t * RP, nullptr, F.lane); N1 = load_raw<true>(xres + (size_t)(t + 1) * RP, nullptr, F.lane); }
#pragma unroll 1
        for (; t < TL; t += 2 * wpb) {
            const RowRaw<true> W0 = N0, W1 = N1; const int tn = t + 2 * wpb;
            if (tn < TL) { N0 = load_raw<true>(xres + (size_t)tn * RP, nullptr, F.lane); N1 = load_raw<true>(xres + (size_t)(tn + 1) * RP, nullptr, F.lane); }
            const int r = b * TT + TC + t; unsigned char* xr = xres + (size_t)t * RP;
            const RowVec R0 = finish_row(cook<true>(W0), false, P, xr, F.lane), R1 = finish_row(cook<true>(W1), false, P, xr + RP, F.lane);
            store_row_i8(H8 + (size_t)r * DM, RS + r, R0, F.lane); store_row_i8(H8 + (size_t)(r + 1) * DM, RS + r + 1, R1, F.lane);
        }
    }
}
__device__ __forceinline__ void phase_gates(Frame& F, CAP a, int L, int wrank, int nwv) {
    LAS bf16* WgT = (LAS bf16*)F.lds;
    const float* win = ain(a, 8) + (size_t)L * DM * DIN;
    { float wv_[32];
#pragma unroll
      for (int i = 0; i < 32; ++i) { const int idx = F.tid + NTHR * i, k = idx >> 4, g = idx & 15; wv_[i] = *(const GAS float*)(win + (size_t)k * DIN + 1536 + g); }
#pragma unroll
      for (int i = 0; i < 32; ++i) { const int idx = F.tid + NTHR * i, k = idx >> 4, g = idx & 15; WgT[g * 1032 + k] = (bf16)f2bf(wv_[i]); } }
    __syncthreads();
    const bf16* H = (const bf16*)(F.ws + WS_HY); const unsigned char* H8 = F.ws + WS_QN; const float* RS = (const float*)(F.ws + WS_ROUTE + RT_ROWSC_H); float* Gt = (float*)(F.ws + WS_GATES);
    const int c16 = F.lane & 15, q4 = F.lane >> 4;
    const float gbias = ain(a, 9)[L * 16 + c16];
    for (int grp = wrank; grp < MROWS / 16; grp += nwv) {
        f32x4 acc = (f32x4){0.f, 0.f, 0.f, 0.f};
        unsigned long long rawa[32];
        float rsg[4];
        if (P_I8) {
#pragma unroll
            for (int kk = 0; kk < 32; ++kk) rawa[kk] = *(const GAS unsigned long long*)(H8 + (size_t)(grp * 16 + c16) * DM + 8 * q4 + 32 * kk);
#pragma unroll
            for (int j = 0; j < 4; ++j) rsg[j] = RS[grp * 16 + 4 * q4 + j]; }
#pragma unroll
        for (int k0 = 0; k0 < 1024; k0 += 256) {
            bf16x8 av[8];
            if (P_I8) {
#pragma unroll
                for (int kk = 0; kk < 8; ++kk) { const unsigned long long rw = rawa[(k0 >> 5) + kk]; const int lo = (int)(unsigned)rw, hi = (int)(unsigned)(rw >> 32);
                    v4u w; w.x = pk2((float)(signed char)(lo), (float)(signed char)(lo >> 8)); w.y = pk2((float)(signed char)(lo >> 16), (float)(signed char)(lo >> 24));
                    w.z = pk2((float)(signed char)(hi), (float)(signed char)(hi >> 8)); w.w = pk2((float)(signed char)(hi >> 16), (float)(signed char)(hi >> 24)); av[kk] = __builtin_bit_cast(bf16x8, w); }
            } else { const bf16* arow = H + (size_t)(grp * 16 + c16) * DM + 8 * q4;
#pragma unroll
                for (int kk = 0; kk < 8; ++kk) av[kk] = *(const GAS bf16x8*)(arow + k0 + 32 * kk); }
#pragma unroll
            for (int kk = 0; kk < 8; ++kk) acc = MFMA16(av[kk], *(const LAS bf16x8*)(WgT + c16 * 1032 + k0 + 32 * kk + 8 * q4), acc);
        }
        if (P_I8) {
#pragma unroll
            for (int j = 0; j < 4; ++j) acc[j] *= rsg[j]; }
#pragma unroll
        for (int j = 0; j < 4; ++j) { float v = acc[j] + gbias; if ((c16 >> 2) & 1) v = logsig(v); Gt[(size_t)(grp * 16 + 4 * q4 + j) * 16 + c16] = v; }
    }
    __syncthreads();
}
__device__ __forceinline__ void phase_norm2(Frame& F, CAP a, int L) {
    const float* nw = ain(a, 7) + L * DM;
    const float* mods = (const float*)(F.ws + WS_MODS) + (size_t)L * 5 * 6144;
    unsigned char* H8 = F.ws + WS_HY; const bf16* T = (const bf16*)(F.ws + WS_P);
    float* RS = (float*)(F.ws + WS_ROUTE + RT_ROWSC);
    static_assert(DENSE_I8 == 1, "phase_norm2 writes int8 rows");
    if (2 * F.gw < NB * TC) {
        const float* mv = mods + 4 * 6144;
        const RowPar Pc = load_par(mv + 2 * 1024, nw, mv + 3 * 1024, mv + 4 * 1024, F.lane);
        for (int rc = 2 * F.gw; rc < NB * TC; rc += 2 * F.NGW) {
            const int b = rc / TC, tp = rc - b * TC, r = b * TT + tp;
            const float* src = ain(a, 2) + (size_t)rc * DM; unsigned char* dst = F.ws + WS_CTXRES + (size_t)rc * RP;
            const float* S = (const float*)(F.ws + WS_SLAB_CW) + (size_t)rc * DM;
            const RowIn I0 = load_row_slabs<false>(src, S, NS_CW, (size_t)1024 * 1024, F.lane), I1 = load_row_slabs<false>(src + DM, S + DM, NS_CW, (size_t)1024 * 1024, F.lane);
            const RowVec R0 = finish_row(I0, true, Pc, dst, F.lane), R1 = finish_row(I1, true, Pc, dst + RP, F.lane);
            store_row_i8(H8 + (size_t)r * DM, RS + r, R0, F.lane); store_row_i8(H8 + (size_t)(r + 1) * DM, RS + r + 1, R1, F.lane);
        }
    }
    const int b = F.gw & 3, wpb = F.NGW >> 2;
    const float* mv = mods + b * 6144;
    const RowPar P = load_par(mv + 2 * 1024, nw, mv + 3 * 1024, mv + 4 * 1024, F.lane);
    const float* xin = ain(a, 0) + (size_t)b * TL * DM; unsigned char* xres = F.ws + WS_RESID + (size_t)b * TL * RP;
    const bf16* Tb = T + ((size_t)b * TT + TC) * DM;
    int t = 2 * (F.gw >> 2);
    RowRaw<true> N0, N1;
    if (t < TL) { N0 = load_raw<true>(xres + (size_t)t * RP, nullptr, F.lane); N1 = load_raw<true>(xres + (size_t)(t + 1) * RP, nullptr, F.lane); }
#pragma unroll 1
    for (; t < TL; t += 2 * wpb) {
        const RowRaw<true> W0 = N0, W1 = N1; const int tn = t + 2 * wpb;
        if (tn < TL) { N0 = load_raw<true>(xres + (size_t)tn * RP, nullptr, F.lane); N1 = load_raw<true>(xres + (size_t)(tn + 1) * RP, nullptr, F.lane); }
        const int r = b * TT + TC + t;
        const RowVec R0 = finish_row(cook<true>(W0), false, P, nullptr, F.lane), R1 = finish_row(cook<true>(W1), false, P, nullptr, F.lane);
        store_row_i8(H8 + (size_t)r * DM, RS + r, R0, F.lane); store_row_i8(H8 + (size_t)(r + 1) * DM, RS + r + 1, R1, F.lane);
    }
}
struct FinRaw { unsigned long long x[4], e0[4], e1[4]; };
__device__ __forceinline__ FinRaw fin_load(const unsigned char* xrow, const bf16* AS, int p0, int p1, int lane) {
    FinRaw R; const GAS unsigned long long* xr = (const GAS unsigned long long*)xrow + lane;
    const GAS unsigned long long* e0 = (const GAS unsigned long long*)(AS + (size_t)p0 * DM) + lane; const GAS unsigned long long* e1 = (const GAS unsigned long long*)(AS + (size_t)p1 * DM) + lane;
#pragma unroll
    for (int j = 0; j < 4; ++j) R.x[j] = xr[64 * j];
    if (p0 < 65536) {
#pragma unroll
        for (int j = 0; j < 4; ++j) R.e0[j] = e0[64 * j]; }
    else {
#pragma unroll
        for (int j = 0; j < 4; ++j) R.e0[j] = 0ull; }
    if (p1 < 65536) {
#pragma unroll
        for (int j = 0; j < 4; ++j) R.e1[j] = e1[64 * j]; }
    else {
#pragma unroll
        for (int j = 0; j < 4; ++j) R.e1[j] = 0ull; }
    return R;
}
__device__ __forceinline__ void fin_row(const FinRaw& W, int p0, int p1, float g0, float g1, const f32x4 (&G)[4], const f32x4 (&Wn)[4], const float* MT, float* orow, int lane) {
    f32x4 v0[4], v1[4], x[4]; float ss = 0.f;
#pragma unroll
    for (int j = 0; j < 4; ++j) { v0[j] = bf4(W.e0[j]); v1[j] = bf4(W.e1[j]); }
    if (p0 >= 65536) {
#pragma unroll 1
        for (int s_ = 0; s_ < NS_MT; ++s_) { const GAS f32x4* sr = (const GAS f32x4*)(MT + ((size_t)s_ * MT_TILES * 256 + (p0 - 65536)) * DM) + lane;
#pragma unroll
            for (int j = 0; j < 4; ++j) v0[j] += sr[64 * j]; } }
    if (p1 >= 65536) {
#pragma unroll 1
        for (int s_ = 0; s_ < NS_MT; ++s_) { const GAS f32x4* sr = (const GAS f32x4*)(MT + ((size_t)s_ * MT_TILES * 256 + (p1 - 65536)) * DM) + lane;
#pragma unroll
            for (int j = 0; j < 4; ++j) v1[j] += sr[64 * j]; } }
#pragma unroll
    for (int j = 0; j < 4; ++j) { x[j] = bf4(W.x[j]) + G[j] * (v0[j] * g0 + v1[j] * g1); ss += dot4(x[j], x[j]); }
    const float rinv = rsqrtf(wave_sum(ss, lane) * (1.f / DM) + EPS);
    GAS f32x4* xw = (GAS f32x4*)orow + lane;
#pragma unroll
    for (int j = 0; j < 4; ++j) xw[64 * j] = x[j] * rinv * Wn[j];
}
__device__ __forceinline__ void phase_final(Frame& F, CAP a) {
    const float* nw = ain(a, 21);
    const int b = F.gw & 3, wpb = F.NGW >> 2;
    const float* gv = (const float*)(F.ws + WS_MODS) + (size_t)5 * 6144 + 5 * 1024 + b * 6144;
    f32x4 G[4], Wn[4];
#pragma unroll
    for (int j = 0; j < 4; ++j) { G[j] = *(const f32x4*)(gv + 256 * j + 4 * F.lane); Wn[j] = *(const f32x4*)(nw + 256 * j + 4 * F.lane); }
    const int* TOKPOS = (const int*)(F.ws + WS_ROUTE + RT_ROWTOK) + (size_t)2 * b * TL; const float* TOKG = (const float*)(F.ws + WS_ROUTE + RT_TOKG) + (size_t)2 * b * TL;
    const bf16* AS = (const bf16*)(F.ws + WS_EOUT); const float* MT = (const float*)(F.ws + WS_SLAB_MT);
    float* out = aout(a) + (size_t)b * TL * DM; const unsigned char* xres = F.ws + WS_RESID + (size_t)b * TL * RP;
    typedef int i32x4v __attribute__((ext_vector_type(4)));
    int t = 2 * (F.gw >> 2);
    if (t >= TL) return;
    i32x4v pc = *(const GAS i32x4v*)(TOKPOS + 2 * t); f32x4 gc = *(const GAS f32x4*)(TOKG + 2 * t);
    int q0 = __builtin_amdgcn_readfirstlane(pc.x), q1 = __builtin_amdgcn_readfirstlane(pc.y), q2 = __builtin_amdgcn_readfirstlane(pc.z), q3 = __builtin_amdgcn_readfirstlane(pc.w);
    FinRaw N0 = fin_load(xres + (size_t)t * RP, AS, q0, q1, F.lane), N1 = fin_load(xres + (size_t)(t + 1) * RP, AS, q2, q3, F.lane);
    i32x4v pn = pc; f32x4 gn = gc;
    if (t + 2 * wpb < TL) { pn = *(const GAS i32x4v*)(TOKPOS + 2 * (t + 2 * wpb)); gn = *(const GAS f32x4*)(TOKG + 2 * (t + 2 * wpb)); }
#pragma unroll 1
    for (; t < TL; t += 2 * wpb) {
        const FinRaw W0 = N0, W1 = N1; const int c0 = q0, c1 = q1, c2 = q2, c3 = q3; const f32x4 gw_ = gc;
        const int tn = t + 2 * wpb;
        if (tn < TL) {
            q0 = __builtin_amdgcn_readfirstlane(pn.x); q1 = __builtin_amdgcn_readfirstlane(pn.y); q2 = __builtin_amdgcn_readfirstlane(pn.z); q3 = __builtin_amdgcn_readfirstlane(pn.w); gc = gn;
            N0 = fin_load(xres + (size_t)tn * RP, AS, q0, q1, F.lane); N1 = fin_load(xres + (size_t)(tn + 1) * RP, AS, q2, q3, F.lane);
            if (tn + 2 * wpb < TL) { pn = *(const GAS i32x4v*)(TOKPOS + 2 * (tn + 2 * wpb)); gn = *(const GAS f32x4*)(TOKG + 2 * (tn + 2 * wpb)); }
        }
        fin_row(W0, c0, c1, gw_.x, gw_.y, G, Wn, MT, out + (size_t)t * DM, F.lane);
        fin_row(W1, c2, c3, gw_.z, gw_.w, G, Wn, MT, out + (size_t)(t + 1) * DM, F.lane);
    }
}

__device__ __forceinline__ void unpack8(v4u raw, float (&x)[8]) {
    x[0] = bflo(raw.x); x[1] = bfhi(raw.x); x[2] = bflo(raw.y); x[3] = bfhi(raw.y); x[4] = bflo(raw.z); x[5] = bfhi(raw.z); x[6] = bflo(raw.w); x[7] = bfhi(raw.w);
}
__device__ __forceinline__ v4u pack8(const float (&x)[8]) { v4u o; o.x = pk2(x[0], x[1]); o.y = pk2(x[2], x[3]); o.z = pk2(x[4], x[5]); o.w = pk2(x[6], x[7]); return o; }
__device__ __forceinline__ void phase_qknorm(Frame& F, CAP a, int L) {
    const bf16* P = (const bf16*)(F.ws + WS_P); bf16* KN = (bf16*)(F.ws + WS_KN);
    const int l16 = F.lane & 15, l8 = F.lane & 7, rsub = F.lane >> 4;
    float kwv[8], invf[4];
#pragma unroll
    for (int e = 0; e < 8; ++e) kwv[e] = ain(a, 12)[L * 64 + 8 * l8 + e];
#pragma unroll
    for (int p = 0; p < 4; ++p) invf[p] = __builtin_amdgcn_exp2f(-(float)((4 * l8 + p) & 15) * 0.83048202372184058f);
    const bool use_row = l8 < 4;
    for (int r0 = 16 * F.gw; r0 < MROWS; r0 += 16 * F.NGW) {
        v4u rk[4];
#pragma unroll
        for (int q = 0; q < 4; ++q) rk[q] = *(const GAS v4u*)(P + (size_t)(r0 + 4 * q + rsub) * NP + CAK + 8 * l16);
#pragma unroll
        for (int q = 0; q < 4; ++q) {
            const int r = r0 + 4 * q + rsub, b = r / TT, tp = r - b * TT, t = tp - TC;
            const float pos = tp >= TC ? (float)(use_row ? (t >> 6) : (t & 63)) : 0.f;
            float x[8]; unpack8(rk[q], x);
            float ss = 0.f;
#pragma unroll
            for (int e = 0; e < 8; ++e) ss += x[e] * x[e];
            ss += shx(ss, 1, F.lane); ss += shx(ss, 2, F.lane); ss += shx(ss, 4, F.lane);
            const float rinv = rsqrtf(ss * (1.f / 64.f) + EPS);
#pragma unroll
            for (int p = 0; p < 4; ++p) { const float ang = pos * invf[p], cs = __cosf(ang), sn = __sinf(ang);
                const float xe = x[2 * p] * rinv * kwv[2 * p], xo = x[2 * p + 1] * rinv * kwv[2 * p + 1]; x[2 * p] = xe * cs - xo * sn; x[2 * p + 1] = xe * sn + xo * cs; }
            *(GAS v4u*)(KN + (size_t)r * 128 + 8 * l16) = pack8(x);
        }
    }
}

__device__ __forceinline__ int scan_ci(int tb, int dir) { return dir == 0 ? tb : (tb < 2 ? 1 - tb : 67 - tb); }

__device__ __forceinline__ void phase_mlstm_local(Frame& F, CAP a, int L) {
    LAS bf16* Vs = (LAS bf16*)(F.lds);
    LAS bf16* KF = (LAS bf16*)(F.lds + 36864);
    LAS bf16* KB = (LAS bf16*)(F.lds + 55296);
    LAS float* GL = (LAS float*)(F.lds + 73728);
    LAS float* WV = (LAS float*)(F.lds + 75776);
    const bf16* P = (const bf16*)(F.ws + WS_P); const float* Gt = (const float*)(F.ws + WS_GATES);
    bf16* CSTC = (bf16*)(F.ws + WS_CSTC); float* CSTN = (float*)(F.ws + WS_CSTN); float* CSTM = (float*)(F.ws + WS_CSTM);
    const int lane = F.lane, tid = F.tid, wave = F.wave, q4 = lane >> 4, c16 = lane & 15;
    for (int u = blockIdx.x; u < NB * 4 * NBLK; u += F.G) {
        const int tb = u % NBLK, bh = u / NBLK, b = bh >> 2, h = bh & 3;
        const int r0 = b * TT + 128 * tb;
        v4u rv[4], rk[2];
#pragma unroll
        for (int i = 0; i < 4; ++i) { const int q = tid + 512 * i, s = q >> 4, dc = q & 15; rv[i] = *(const GAS v4u*)(P + (size_t)(r0 + s) * NP + CV + h * 128 + dc * 8); }
#pragma unroll
        for (int i = 0; i < 2; ++i) { const int q = tid + 512 * i, s = q >> 3, kc = q & 7; rk[i] = *(const GAS v4u*)(P + (size_t)(r0 + s) * NP + CK + h * 64 + kc * 8); }
        { const int g = tid >> 7, i = tid & 127; GL[g * 128 + i] = Gt[(size_t)(r0 + i) * 16 + g * 4 + h]; }
        __syncthreads();
        if (wave < 2) {
            const int dir = wave;
            const float lf0 = GL[(1 + 2 * dir) * 128 + 2 * lane], lf1 = GL[(1 + 2 * dir) * 128 + 2 * lane + 1];
            const float ig0 = GL[(2 * dir) * 128 + 2 * lane], ig1 = GL[(2 * dir) * 128 + 2 * lane + 1];
            const float s = lf0 + lf1, inc = wave_incl_scan_add(s, lane), tot = shi(inc, 63), exc = inc - s;
            float wl0, wl1;
            if (dir == 0) { wl0 = (tot - (exc + lf0)) + ig0; wl1 = (tot - inc) + ig1; }
            else          { wl0 = exc + ig0;                 wl1 = (exc + lf0) + ig1; }
            const float ml = wave_max(fmaxf(wl0, wl1), lane);
            WV[dir * 128 + 2 * lane] = __expf(wl0 - ml); WV[dir * 128 + 2 * lane + 1] = __expf(wl1 - ml);
            if (lane == 0) { const int sidx = (bh * 2 + dir) * NBLK + scan_ci(tb, dir); CSTM[sidx * 2] = ml; CSTM[sidx * 2 + 1] = tot; }
        }
        else if (wave < 4) {
            const int dir = wave - 2;
            const int ta = dir ? 127 - 2 * lane : 2 * lane, tc = dir ? 126 - 2 * lane : 2 * lane + 1;
            const float lf0 = GL[(1 + 2 * dir) * 128 + ta], lf1 = GL[(1 + 2 * dir) * 128 + tc], ig0 = GL[(2 * dir) * 128 + ta], ig1 = GL[(2 * dir) * 128 + tc];
            const float s = lf0 + lf1, inc = wave_incl_scan_add(s, lane), exc = inc - s;
            const float b0 = exc + lf0, b1 = inc, g0 = ig0 - b0, g1 = ig1 - b1;
            const float mx1 = fmaxf(g0, g1), pm = wave_incl_scan_max(mx1, lane);
            float pe = shu(pm, 1, lane); if (lane == 0) pe = -INFINITY;
            typedef float f32x2g __attribute__((ext_vector_type(2)));
            GAS f32x2g* gp = (GAS f32x2g*)(F.ws + WS_GPRE) + (size_t)((bh * 2 + dir) * NBLK + tb) * 128;
            gp[ta] = (f32x2g){g0, fmaxf(pe, g0)}; gp[tc] = (f32x2g){g1, pm};
        }
#pragma unroll
        for (int i = 0; i < 4; ++i) { const int q = tid + 512 * i, s = q >> 4, dc = q & 15; *(LAS v4u*)(Vs + s * 144 + dc * 8) = rv[i]; }
        { const int s = tid >> 2, part = tid & 3; *(LAS unsigned long long*)(Vs + s * 144 + 128 + 4 * part) = part == 0 ? 0x3F80ull : 0ull; }
        __syncthreads();
#pragma unroll
        for (int i = 0; i < 2; ++i) { const int q = tid + 512 * i, s = q >> 3, kc = q & 7;
            float kv[8], o[8]; unpack8(rk[i], kv);
            const float wf = WV[s], wb = WV[128 + s];
#pragma unroll
            for (int e = 0; e < 8; ++e) o[e] = kv[e] * wf;
            *(LAS v4u*)(KF + s * 72 + kc * 8) = pack8(o);
#pragma unroll
            for (int e = 0; e < 8; ++e) o[e] = kv[e] * wb;
            *(LAS v4u*)(KB + s * 72 + kc * 8) = pack8(o); }
        __syncthreads();
        {
            const attn_body::lds_cptr vbase = (attn_body::lds_cptr)Vs + (8 * q4 + (c16 >> 2)) * 288 + 8 * (c16 & 3);
            bf16x8 vf[4], v1[4];
#pragma unroll
            for (int s4 = 0; s4 < 4; ++s4) { const attn_body::s16x4 lo = attn_body::vtr(vbase + 32 * s4 * 288 + 32 * wave), hi = attn_body::vtr(vbase + (32 * s4 + 4) * 288 + 32 * wave);
                vf[s4] = (bf16x8){lo[0], lo[1], lo[2], lo[3], hi[0], hi[1], hi[2], hi[3]};
                const attn_body::s16x4 lo1 = attn_body::vtr(vbase + 32 * s4 * 288 + 32 * 8), hi1 = attn_body::vtr(vbase + (32 * s4 + 4) * 288 + 32 * 8);
                v1[s4] = (bf16x8){lo1[0], lo1[1], lo1[2], lo1[3], hi1[0], hi1[1], hi1[2], hi1[3]}; }
#pragma unroll
            for (int dir = 0; dir < 2; ++dir) {
                const attn_body::lds_cptr kbase = (attn_body::lds_cptr)(dir ? KB : KF) + (8 * q4 + (c16 >> 2)) * 144 + 8 * (c16 & 3);
                const int sidx = (bh * 2 + dir) * NBLK + scan_ci(tb, dir);
                bf16* cdst = CSTC + (size_t)sidx * 8192;
#pragma unroll
                for (int kt = 0; kt < 4; ++kt) {
                    f32x4 acc = (f32x4){0.f, 0.f, 0.f, 0.f}, accn = acc;
                    const bool mine = (kt == (wave & 3)) && (dir == (wave >> 2));
#pragma unroll
                    for (int s4 = 0; s4 < 4; ++s4) { const attn_body::s16x4 lo = attn_body::vtr(kbase + 32 * s4 * 144 + 32 * kt), hi = attn_body::vtr(kbase + (32 * s4 + 4) * 144 + 32 * kt);
                        const bf16x8 kf = (bf16x8){lo[0], lo[1], lo[2], lo[3], hi[0], hi[1], hi[2], hi[3]};
                        acc = MFMA16(kf, vf[s4], acc);
                        if (mine) accn = MFMA16(kf, v1[s4], accn); }
                    *(GAS unsigned long long*)(cdst + (16 * wave + c16) * 64 + 16 * kt + 4 * q4) = (unsigned long long)pk2(acc[0], acc[1]) | ((unsigned long long)pk2(acc[2], acc[3]) << 32);
                    if (mine && c16 == 0) *(GAS f32x4*)(CSTN + (size_t)sidx * 64 + 16 * kt + 4 * q4) = accn;
                }
            }
        }
        __syncthreads();
    }
}

template <bool PROBE> __device__ __forceinline__ void phase_scan(Frame& F) {
    unsigned* CSTC = (unsigned*)(F.ws + WS_CSTC); float* CSTN = (float*)(F.ws + WS_CSTN); const float* CSTM = (const float*)(F.ws + WS_CSTM); float* CSTE = (float*)(F.ws + WS_CSTE);
    const int tid = F.tid;
    for (int u = blockIdx.x; u < NSEQ * 8; u += F.G) {
        const int seq = u >> 3, js = u & 7; const bool nown = (js == 0 && tid < 64);
        float C0 = 0.f, C1 = 0.f, n = 0.f, m = 0.f;
        unsigned* cb = CSTC + (size_t)seq * NBLK * 4096 + js * 512 + tid;
        constexpr int SB = 11;
        unsigned cl[2][SB]; float ml[2][SB], g[2][SB], nl[2][SB];
#define SCAN_LOAD(buf, c0) do { _Pragma("unroll") for (int i = 0; i < SB; ++i) { const size_t si = (size_t)seq * NBLK + (c0) + i; cl[buf][i] = cb[(size_t)((c0) + i) * 4096]; \
            ml[buf][i] = CSTM[si * 2]; g[buf][i] = CSTM[si * 2 + 1]; nl[buf][i] = nown ? CSTN[si * 64 + tid] : 0.f; } } while (0)
#define SCAN_STEP(buf, c0) do { _Pragma("unroll") for (int i = 0; i < SB; ++i) { const size_t si = (size_t)seq * NBLK + (c0) + i; \
            const float mnew = fmaxf(g[buf][i] + m, ml[buf][i]), aa = __expf(g[buf][i] + m - mnew), sv = __expf(ml[buf][i] - mnew); \
            cb[(size_t)((c0) + i) * 4096] = PROBE ? cl[buf][i] : pk2(C0, C1); \
            if (nown) CSTN[si * 64 + tid] = PROBE ? nl[buf][i] : n; \
            if (!PROBE && js == 0 && tid == 0) CSTE[si] = m; \
            C0 = aa * C0 + sv * bflo(cl[buf][i]); C1 = aa * C1 + sv * bfhi(cl[buf][i]); n = aa * n + sv * nl[buf][i]; m = mnew; } } while (0)
        SCAN_LOAD(0, 0);
#pragma unroll
        for (int k = 0; k < NBLK / SB; ++k) {
            if (k + 1 < NBLK / SB) { if ((k & 1) == 0) SCAN_LOAD(1, (k + 1) * SB); else SCAN_LOAD(0, (k + 1) * SB); }
            if ((k & 1) == 0) SCAN_STEP(0, k * SB); else SCAN_STEP(1, k * SB);
        }
#undef SCAN_LOAD
#undef SCAN_STEP
    }
}

template <int PRB  > __device__ __forceinline__ void phase_mlstm_out(Frame& F, CAP a, int L) {
    LAS bf16* Qs = (LAS bf16*)(F.lds);
    LAS bf16* Ks = (LAS bf16*)(F.lds + 18432);
    LAS bf16* Vs = (LAS bf16*)(F.lds + 36864);
    LAS bf16* Es = (LAS bf16*)(F.lds + 73728);
    LAS bf16* Sm = (LAS bf16*)(F.lds + 111168) + F.wave * (128 * 16);
    LAS float* GL = (LAS float*)(F.lds + 143936);
    LAS float* VG = (LAS float*)(F.lds + 145984);
    LAS float* Hs = (LAS float*)(F.lds + 36864);
    const bf16* P = (const bf16*)(F.ws + WS_P); const float* Gt = (const float*)(F.ws + WS_GATES);
    const bf16* CSTC = (const bf16*)(F.ws + WS_CSTC); const float* CSTN = (const float*)(F.ws + WS_CSTN); const float* CSTE = (const float*)(F.ws + WS_CSTE);
    bf16* Y = (bf16*)(F.ws + WS_HY);
    const float* mnw = ain(a, 10) + L * 512;
    const int wave = F.wave, t0 = 16 * wave;
    const int nblk = (L == 0) ? NBLK : NBLK - 2;
#define MO_LOAD(uu, tid, RMO) do { \
        const int bh_ = (uu) / nblk, tb_ = (uu) % nblk + (NBLK - nblk), b_ = bh_ >> 2, h_ = bh_ & 3, r0_ = b_ * TT + 128 * tb_; \
        const int s0_ = (bh_ * 2 + 0) * NBLK + scan_ci(tb_, 0), s1_ = (bh_ * 2 + 1) * NBLK + scan_ci(tb_, 1); \
        _Pragma("unroll") for (int i = 0; i < 2; ++i) { const int q = (tid) + 512 * i, s = q >> 3, c = q & 7; \
            rq[i] = *(const GAS v4u*)(P + (size_t)(r0_ + s) * NP + CQ + h_ * 64 + c * 8); rk[i] = *(const GAS v4u*)(P + (size_t)(r0_ + s) * NP + CK + h_ * 64 + c * 8); } \
        _Pragma("unroll") for (int i = 0; i < 4; ++i) { const int q = (tid) + 512 * i, s = q >> 4, dc = q & 15; rv[i] = *(const GAS v4u*)(P + (size_t)(r0_ + s) * NP + CV + h_ * 128 + dc * 8); } \
        gval = 0.f; gpre = (f32x2m){0.f, 0.f}; \
        if ((tid) < 256) { gval = Gt[(size_t)(r0_ + ((tid) & 127)) * 16 + (2 * ((tid) >> 7)) * 4 + h_]; gpre = *((const GAS f32x2m*)(F.ws + WS_GPRE) + (size_t)((bh_ * 2 + ((tid) >> 7)) * NBLK + tb_) * 128 + ((tid) & 127)); } \
        _Pragma("unroll") for (int i = 0; i < 4; ++i) { const int q = (tid) + 512 * i; RMO[i] = *(const GAS v4u*)(P + (size_t)(r0_ + (q >> 4)) * NP + CO + h_ * 128 + (q & 15) * 8); } \
        _Pragma("unroll") for (int i = 0; i < 4; ++i) { const int idx = (tid) + 512 * i; e0[i] = *(const GAS unsigned long long*)(CSTC + (size_t)s0_ * 8192 + idx * 4); e1[i] = *(const GAS unsigned long long*)(CSTC + (size_t)s1_ * 8192 + idx * 4); } \
        n0 = (f32x4){0.f, 0.f, 0.f, 0.f}; n1 = n0; \
        if ((tid) < 16) n0 = *(const GAS f32x4*)(CSTN + (size_t)s0_ * 64 + (tid) * 4); else if ((tid) < 32) n1 = *(const GAS f32x4*)(CSTN + (size_t)s1_ * 64 + ((tid) - 16) * 4); \
        me0 = CSTE[s0_]; me1 = CSTE[s1_]; } while (0)
    typedef float f32x2m __attribute__((ext_vector_type(2)));
    v4u rq[2], rk[2], rv[4], rmo[4], rmo_n[4]; unsigned long long e0[4], e1[4]; f32x4 n0, n1; float gval, me0, me1; f32x2m gpre;
    if ((int)blockIdx.x < NB * 4 * nblk) { int t0_ = F.tid; asm volatile("" : "+v"(t0_)); MO_LOAD((int)blockIdx.x, t0_, rmo); }
    for (int u = blockIdx.x; u < NB * 4 * nblk; u += F.G) {
        int tid_ = F.tid; asm volatile("" : "+v"(tid_));
        const int tid = tid_, lane = tid & 63, q4 = lane >> 4, c16 = lane & 15;
        const int bh = u / nblk, tb = u % nblk + (NBLK - nblk), b = bh >> 2, h = bh & 3;
        const int r0 = b * TT + 128 * tb;
        const int sidx0 = (bh * 2 + 0) * NBLK + scan_ci(tb, 0), sidx1 = (bh * 2 + 1) * NBLK + scan_ci(tb, 1);
        { const int s = tid >> 2, part = tid & 3; *(LAS unsigned long long*)(Vs + s * 144 + 128 + 4 * part) = part == 0 ? 0x3F80ull : 0ull; }
#pragma unroll
        for (int i = 0; i < 2; ++i) { const int q = tid + 512 * i, s = q >> 3, c = q & 7; *(LAS v4u*)(Qs + s * 72 + c * 8) = rq[i]; *(LAS v4u*)(Ks + s * 72 + c * 8) = rk[i]; }
#pragma unroll
        for (int i = 0; i < 4; ++i) { const int q = tid + 512 * i, s = q >> 4, dc = q & 15; *(LAS v4u*)(Vs + s * 144 + dc * 8) = rv[i]; }
        if (tid < 256) { LAS float* V_ = VG + 512 * (tid >> 7); const int t_ = tid & 127;
            const float me = (tid >> 7) ? me1 : me0, g_ = gpre.x, M_ = fmaxf(me, gpre.y), b_ = gval - g_;
            V_[t_] = g_; V_[128 + t_] = M_; V_[256 + t_] = __expf(me - M_); V_[384 + t_] = __expf(-(b_ + M_)); }
#pragma unroll
        for (int i = 0; i < 4; ++i) { const int idx = tid + 512 * i, d = idx >> 4, c4 = idx & 15; *(LAS unsigned long long*)(Es + d * 72 + c4 * 4) = e0[i]; *(LAS unsigned long long*)(Es + 130 * 72 + d * 72 + c4 * 4) = e1[i]; }
        if (tid < 16) *(LAS unsigned long long*)(Es + 128 * 72 + tid * 4) = (unsigned long long)pk2(n0.x, n0.y) | ((unsigned long long)pk2(n0.z, n0.w) << 32);
        else if (tid < 32) *(LAS unsigned long long*)(Es + 130 * 72 + 128 * 72 + (tid - 16) * 4) = (unsigned long long)pk2(n1.x, n1.y) | ((unsigned long long)pk2(n1.z, n1.w) << 32);
        __syncthreads();
        f32x4 hsum[8];
#pragma unroll
        for (int ct = 0; ct < 8; ++ct) hsum[ct] = (f32x4){0.f, 0.f, 0.f, 0.f};
#pragma unroll 1
        for (int dir = 0; dir < ((PRB & 1) ? 0 : 2); ++dir) {
            const LAS float* V_ = VG + 512 * dir;
            const LAS bf16* Ed = Es + dir * (130 * 72);
            float Mr[4], ar[4], er[4];
#pragma unroll
            for (int j = 0; j < 4; ++j) { const int t = t0 + 4 * q4 + j; Mr[j] = V_[128 + t]; ar[j] = V_[256 + t] * 0.125f; er[j] = V_[384 + t]; }
            bf16x8 qa[2];
#pragma unroll
            for (int k = 0; k < 2; ++k) qa[k] = *(const LAS bf16x8*)(Qs + (t0 + c16) * 72 + 32 * k + 8 * q4);
            const int slo = dir ? (wave >> 1) : 0, shi_ = dir ? 3 : (wave >> 1);
#pragma unroll
            for (int st = 0; st < 8; ++st) if ((st >> 1) >= slo && (st >> 1) <= shi_) {
                f32x4 acc = (f32x4){0.f, 0.f, 0.f, 0.f};
#pragma unroll
                for (int k = 0; k < 2; ++k) acc = MFMA16(qa[k], *(const LAS bf16x8*)(Ks + (16 * st + c16) * 72 + 32 * k + 8 * q4), acc);
                const int s = 16 * st + c16; const float gs = V_[s];
                float w[4];
#pragma unroll
                for (int j = 0; j < 4; ++j) { const int t = t0 + 4 * q4 + j; const bool ok = dir == 0 ? (s <= t) : (s >= t); w[j] = ok ? acc[j] * 0.125f * __expf(gs - Mr[j]) : 0.f; }
                *(LAS unsigned long long*)(Sm + s * 16 + 4 * q4) = (unsigned long long)pg8::cvt_pk_bf16(w[0], w[1]) | ((unsigned long long)pg8::cvt_pk_bf16(w[2], w[3]) << 32);
            }
            bf16x8 sa[4];
            { const attn_body::lds_cptr sp = (attn_body::lds_cptr)Sm + (8 * q4 + (c16 >> 2)) * 32 + 8 * (c16 & 3);
#pragma unroll
              for (int s4 = 0; s4 < 4; ++s4) { const attn_body::s16x4 lo = attn_body::vtr(sp + 32 * s4 * 32), hi = attn_body::vtr(sp + (32 * s4 + 4) * 32);
                  sa[s4] = (bf16x8){lo[0], lo[1], lo[2], lo[3], hi[0], hi[1], hi[2], hi[3]}; } }
            f32x4 res[9];
#pragma unroll
            for (int ct = 0; ct < 9; ++ct) {
                f32x4 acc1 = (f32x4){0.f, 0.f, 0.f, 0.f}, acc2 = (f32x4){0.f, 0.f, 0.f, 0.f};
#pragma unroll
                for (int s4 = 0; s4 < 4; ++s4) if (s4 >= slo && s4 <= shi_)
                { const attn_body::lds_cptr vp = (attn_body::lds_cptr)Vs + (32 * s4 + 8 * q4 + (c16 >> 2)) * 288 + 32 * ct + 8 * (c16 & 3);
                    const attn_body::s16x4 lo = attn_body::vtr(vp), hi = attn_body::vtr(vp + 4 * 288);
                    acc1 = MFMA16(sa[s4], ((bf16x8){lo[0], lo[1], lo[2], lo[3], hi[0], hi[1], hi[2], hi[3]}), acc1); }
#pragma unroll
                for (int k = 0; k < 2; ++k) acc2 = MFMA16(qa[k], *(const LAS bf16x8*)(Ed + (16 * ct + c16) * 72 + 32 * k + 8 * q4), acc2);
#pragma unroll
                for (int j = 0; j < 4; ++j) res[ct][j] = acc1[j] + ar[j] * acc2[j];
                if (ct % 3 == 2) asm volatile("" ::: "memory");
            }
#pragma unroll
            for (int j = 0; j < 4; ++j) { const float den = shi(res[8][j], lane & 48); const float inv = __builtin_amdgcn_rcpf(fmaxf(fabsf(den), er[j]));
#pragma unroll
                for (int ct = 0; ct < 8; ++ct) hsum[ct][j] += res[ct][j] * inv; }
        }
        { const int un_ = (u + F.G < NB * 4 * nblk) ? u + F.G : u; MO_LOAD(un_, tid, rmo_n); }
        const f32x4 wa = *(const f32x4*)(mnw + h * 128 + (tid & 15) * 8), wb = *(const f32x4*)(mnw + h * 128 + (tid & 15) * 8 + 4);
        __syncthreads();
#pragma unroll
        for (int j = 0; j < 4; ++j) {
            float ss = 0.f;
#pragma unroll
            for (int ct = 0; ct < 8; ++ct) ss += hsum[ct][j] * hsum[ct][j];
            ss += WAVE_DPP(ss, 0xB1); ss += WAVE_DPP(ss, 0x4E); ss += WAVE_DPP(ss, 0x141); ss += WAVE_DPP(ss, 0x140);
            const float rinv = rsqrtf(ss * (1.f / 128.f) + EPS);
#pragma unroll
            for (int ct = 0; ct < 8; ++ct) Hs[(t0 + 4 * q4 + j) * 132 + 16 * ct + c16] = hsum[ct][j] * rinv;
        }
        __syncthreads();
#pragma unroll
        for (int i = 0; i < ((PRB & 2) ? 0 : 4); ++i) { const int q = tid + 512 * i, t = q >> 4, c = q & 15; const size_t r = (size_t)(r0 + t);
            float mo[8]; unpack8(rmo[i], mo);
            const f32x4 ha = *(const LAS f32x4*)(Hs + t * 132 + c * 8), hb = *(const LAS f32x4*)(Hs + t * 132 + c * 8 + 4);
            float o[8];
            o[0] = ha.x * wa.x * __builtin_amdgcn_rcpf(1.f + __expf(-mo[0])); o[1] = ha.y * wa.y * __builtin_amdgcn_rcpf(1.f + __expf(-mo[1]));
            o[2] = ha.z * wa.z * __builtin_amdgcn_rcpf(1.f + __expf(-mo[2])); o[3] = ha.w * wa.w * __builtin_amdgcn_rcpf(1.f + __expf(-mo[3]));
            o[4] = hb.x * wb.x * __builtin_amdgcn_rcpf(1.f + __expf(-mo[4])); o[5] = hb.y * wb.y * __builtin_amdgcn_rcpf(1.f + __expf(-mo[5]));
            o[6] = hb.z * wb.z * __builtin_amdgcn_rcpf(1.f + __expf(-mo[6])); o[7] = hb.w * wb.w * __builtin_amdgcn_rcpf(1.f + __expf(-mo[7]));
            *(GAS v4u*)(Y + r * DM + h * 128 + c * 8) = pack8(o); }
#pragma unroll
        for (int i = 0; i < 4; ++i) rmo[i] = rmo_n[i];
        __syncthreads();
    }
#undef MO_LOAD
}

__device__ __forceinline__ void phase_attn(Frame& F, CAP a, int L, char* lds_generic) {
    const attn_body::bf16* KN = (const attn_body::bf16*)(F.ws + WS_KN);
    const attn_body::bf16* P = (const attn_body::bf16*)(F.ws + WS_P); attn_body::bf16* Y = (attn_body::bf16*)(F.ws + WS_HY);
    const float* qw = ain(a, 11) + L * 64;
    float mq = 0.f, mk = 0.f;
    { f32x4 qv[16], kv[16]; const float* kw = ain(a, 12) + L * 64;
#pragma unroll
      for (int d = 0; d < 16; ++d) { qv[d] = *(const GAS f32x4*)(qw + 4 * d); kv[d] = *(const GAS f32x4*)(kw + 4 * d); }
#pragma unroll
      for (int d = 0; d < 16; ++d) { mq = fmaxf(fmaxf(mq, fmaxf(fabsf(qv[d].x), fabsf(qv[d].y))), fmaxf(fabsf(qv[d].z), fabsf(qv[d].w))); mk = fmaxf(fmaxf(mk, fmaxf(fabsf(kv[d].x), fabsf(kv[d].y))), fmaxf(fabsf(kv[d].z), fabsf(kv[d].w))); } }
    const float negB = -(8.f * mq * mk * 1.4426950408889634f * 1.03f + 0.25f);
    bool conv_pending = (L == 0);
    for (int v = F.vcu; v < 256; v += F.G)
        for (int i = 0; i < 5; ++i) {
            if (i == 4 && !(L == 0 && (v & 7) == 0)) break;
            if (conv_pending && i == (v & 3)) { conv_pending = false; convert_weights(F, a, I_SMALL + T_D, I_MOE - T_D, (LAS float*)(F.lds + 86016 + F.wave * 8448)); }
            const int bh = v >> 3, b = bh >> 3, h = bh & 7;
            int qrow0, NT, tok0;
            if (i < 4) { const int qb = ((4 * v + i) & 31); qrow0 = b * TT + TC + qb * 256; NT = TT / 64; tok0 = qb * 256; }
            else { qrow0 = b * TT; NT = TC / 64; tok0 = -1; }
            const size_t krow0 = (size_t)b * TT;
            attn_body::attn_unit<8, true, true>(P + (size_t)qrow0 * NP + CAQ + h * 64, KN + krow0 * 128 + (h >> 2) * 64, P + krow0 * NP + CAV + (h >> 2) * 64,
                                                Y + (size_t)qrow0 * DM + 512 + h * 64, NT, negB, qw, tok0, lds_generic);
        }
    if (conv_pending) convert_weights(F, a, I_SMALL + T_D, I_MOE - T_D, (LAS float*)(F.lds + 86016 + F.wave * 8448));
}

__device__ __forceinline__ void phase_norm2_route(Frame& F, CAP a) {
    LAS float* rT = (LAS float*)F.lds;
    LAS unsigned* hist = (LAS unsigned*)(F.lds + 32768);
    { float rv_[16];
#pragma unroll
      for (int i = 0; i < 16; ++i) rv_[i] = ain(a, 17)[F.tid + NTHR * i];
#pragma unroll
      for (int i = 0; i < 16; ++i) { const int idx = F.tid + NTHR * i, k = idx >> 3, e = idx & 7; rT[e * 1024 + k] = rv_[i]; } }
    const float* nw = ain(a, 7) + 1 * DM;
    const float* mods = (const float*)(F.ws + WS_MODS) + (size_t)1 * 5 * 6144;
    unsigned char* H2 = F.ws + WS_H2B; const bf16* T = (const bf16*)(F.ws + WS_P);
    int* TOKE = (int*)(F.ws + WS_ROUTE + RT_TOKE); float* TOKG = (float*)(F.ws + WS_ROUTE + RT_TOKG); int* CNT = (int*)(F.ws + WS_ROUTE + RT_CNT);
    for (int tb = blockIdx.x; tb < 256; tb += F.G) {
        if (F.tid < 8) hist[F.tid] = 0u;
        __syncthreads();
        const int tok0 = tb * 128 + F.wave * 16, b = tok0 >> 13;
        const float* mv = mods + b * 6144;
        const RowPar PR = load_par(mv + 2 * 1024, nw, mv + 3 * 1024, mv + 4 * 1024, F.lane);
        unsigned char* xblk = F.ws + WS_RESID + (size_t)tok0 * RP; const bf16* tblk = T + ((size_t)b * TT + TC + (tok0 & (TL - 1))) * DM;
        RowRaw<true> N0 = load_raw<true>(xblk, nullptr, F.lane), N1 = load_raw<true>(xblk + RP, nullptr, F.lane);
#pragma unroll 1
        for (int i = 0; i < 16; i += 2) {
            const int tok = tok0 + i;
            const RowRaw<true> W0 = N0, W1 = N1;
            if (i + 2 < 16) { N0 = load_raw<true>(xblk + (size_t)(i + 2) * RP, nullptr, F.lane); N1 = load_raw<true>(xblk + (size_t)(i + 3) * RP, nullptr, F.lane); }
            unsigned char* xrow = nullptr;
            RowVec R[2];
            R[0] = finish_row(cook<true>(W0), false, PR, xrow, F.lane); R[1] = finish_row(cook<true>(W1), false, PR, xrow, F.lane);
            store_row_fp8(H2 + (size_t)tok * DM, R[0], F.lane); store_row_fp8(H2 + (size_t)(tok + 1) * DM, R[1], F.lane);
            float lg[2][8];
#pragma unroll
            for (int e = 0; e < 8; ++e) { float s0 = 0.f, s1 = 0.f;
#pragma unroll
                for (int j = 0; j < 4; ++j) { const f32x4 w4 = *(const LAS f32x4*)(rT + e * 1024 + 256 * j + 4 * F.lane); s0 += dot4(R[0].h[j], w4); s1 += dot4(R[1].h[j], w4); }
                lg[0][e] = wave_sum(s0, F.lane); lg[1][e] = wave_sum(s1, F.lane); }
#pragma unroll
            for (int q = 0; q < 2; ++q) {
                float v0 = -INFINITY, v1 = -INFINITY; int i0 = 0, i1 = 0;
#pragma unroll
                for (int e = 0; e < 8; ++e) if (lg[q][e] > v0) { v0 = lg[q][e]; i0 = e; }
#pragma unroll
                for (int e = 0; e < 8; ++e) if (e != i0 && lg[q][e] > v1) { v1 = lg[q][e]; i1 = e; }
                if (F.lane == 0) { const float ex = __expf(v1 - v0), g0 = 1.f / (1.f + ex);
                    TOKE[tok + q] = i0 | (i1 << 8); TOKG[2 * (tok + q)] = g0; TOKG[2 * (tok + q) + 1] = ex * g0;
                    __hip_atomic_fetch_add(hist + i0, 1u, __ATOMIC_RELAXED, __HIP_MEMORY_SCOPE_WORKGROUP);
                    __hip_atomic_fetch_add(hist + i1, 1u, __ATOMIC_RELAXED, __HIP_MEMORY_SCOPE_WORKGROUP); }
            }
        }
        __syncthreads();
        if (F.tid < 8) CNT[tb * 8 + F.tid] = (int)hist[F.tid];
        __syncthreads();
    }
}
__device__ __forceinline__ void phase_moe_sort(Frame& F, CAP a) {
    LAS int* gbase = (LAS int*)F.lds;  LAS int* gtot = gbase + 16;  LAS unsigned* cur = (LAS unsigned*)(gbase + 32);  LAS int* postab = gbase + 64;
    const int* TOKE = (const int*)(F.ws + WS_ROUTE + RT_TOKE); const int* CNT = (const int*)(F.ws + WS_ROUTE + RT_CNT);
    int* INFO = (int*)(F.ws + WS_ROUTE + RT_INFO); int* TILEE = (int*)(F.ws + WS_ROUTE + RT_TILEE); int* TOKPOS = (int*)(F.ws + WS_ROUTE + RT_ROWTOK);
    const unsigned char* H2 = F.ws + WS_H2B; unsigned char* AS = F.ws + WS_ASORT;
    for (int tb = blockIdx.x; tb < 256; tb += F.G) {
        if (F.tid < 8) { gtot[F.tid] = 0; cur[F.tid] = 0u; }
        __syncthreads();
        if (F.tid < 256) {
            typedef int i32x4s __attribute__((ext_vector_type(4)));
            const i32x4s c0 = *(const GAS i32x4s*)(CNT + F.tid * 8), c1 = *(const GAS i32x4s*)(CNT + F.tid * 8 + 4);
            const int cv[8] = {c0.x, c0.y, c0.z, c0.w, c1.x, c1.y, c1.z, c1.w};
#pragma unroll
            for (int g = 0; g < 8; ++g) { __hip_atomic_fetch_add(gtot + g, cv[g], __ATOMIC_RELAXED, __HIP_MEMORY_SCOPE_WORKGROUP);
                if (F.tid < tb) __hip_atomic_fetch_add(cur + g, (unsigned)cv[g], __ATOMIC_RELAXED, __HIP_MEMORY_SCOPE_WORKGROUP); } }
        __syncthreads();
        if (F.tid == 0) { int acc = 0; for (int g = 0; g < 8; ++g) { gbase[g] = acc; acc += (gtot[g] + 255) & ~255; } }
        __syncthreads();
        if (F.tid < 8) cur[F.tid] += (unsigned)gbase[F.tid];
        __syncthreads();
        if (F.tid < 128) { const int tok = tb * 128 + F.tid, ee = TOKE[tok], i0 = ee & 255, i1 = ee >> 8;
            const int p0 = (int)__hip_atomic_fetch_add(cur + i0, 1u, __ATOMIC_RELAXED, __HIP_MEMORY_SCOPE_WORKGROUP);
            const int p1 = (int)__hip_atomic_fetch_add(cur + i1, 1u, __ATOMIC_RELAXED, __HIP_MEMORY_SCOPE_WORKGROUP);
            TOKPOS[2 * tok] = p0; TOKPOS[2 * tok + 1] = p1;
            postab[2 * F.tid] = p0; postab[2 * F.tid + 1] = p1; }
        __syncthreads();
#pragma unroll 1
        for (int c = 0; c < 16; c += 8) {
            v4u v[8];
#pragma unroll
            for (int q = 0; q < 8; ++q) v[q] = *((const GAS v4u*)(H2 + (size_t)(tb * 128 + F.wave * 16 + c + q) * DM) + F.lane);
#pragma unroll
            for (int q = 0; q < 8; ++q) { const int p0 = postab[2 * (F.wave * 16 + c + q)], p1 = postab[2 * (F.wave * 16 + c + q) + 1];
                *((GAS v4u*)(AS + (size_t)p0 * DM) + F.lane) = v[q]; *((GAS v4u*)(AS + (size_t)p1 * DM) + F.lane) = v[q]; }
        }
        if (tb == 0) {
            const int nt = (gbase[7] + ((gtot[7] + 255) & ~255)) >> 8;
            if (F.tid < nt) { const int row0 = F.tid * 256; int e = 0;
#pragma unroll 1
                for (int g = 0; g < 8; ++g) if (row0 >= gbase[g] && row0 < gbase[g] + ((gtot[g] + 255) & ~255)) e = g;
                TILEE[F.tid] = e; }
            if (F.tid == 0) INFO[0] = nt;
        }
        __syncthreads();
    }
}

struct RowOrder : pg8::StaticOrder {
    int latent_only;
    __device__ __forceinline__ bool next(int i, pg8::Unit& u) const { if (!pg8::StaticOrder::next(i, u)) return false; if (latent_only) u.pm = (u.pm >> 5) * 33 + 1 + (u.pm & 31); return true; }
};
struct MoeUpOrder : pg8::StaticOrder {
    int lo; const LAS int* tile_e;
    __device__ __forceinline__ bool next(int i, pg8::Unit& u) const { if (!pg8::StaticOrder::next(i, u)) return false; const int e = tile_e[lo + u.pm]; u.pm += lo; u.pn += e * 28; return true; }
};
struct MoeDownOrder : pg8::StaticOrder {
    int lo; const LAS int* tile_e;
    __device__ __forceinline__ bool next(int i, pg8::Unit& u) const { if (!pg8::StaticOrder::next(i, u)) return false; const int e = tile_e[lo + u.pm]; u.pn += e * 4; return true; }
};
struct EpiNull {
    static constexpr bool PERM = true, AFTER_DRAIN = false; unsigned char* O; int mode;
    __device__ __forceinline__ void operator()(const pg8::f32x4 (&acc)[2][2][4][2], const pg8::Unit& u, int wr, int wc, int fr, int fq) const {
        if (mode == 2) {
#pragma unroll
            for (int ai = 0; ai < 2; ++ai)
#pragma unroll
                for (int m = 0; m < 4; ++m) { const pg8::f32x4 g0 = acc[ai][0][m][0] + acc[ai][1][m][0], g1 = acc[ai][0][m][1] + acc[ai][1][m][1];
                    *(unsigned long long*)(O + (size_t)(((u.pm & 127) * 256) + wr * 64 + fr + ai * 128 + m * 16) * 3584 + (u.pn % 28) * 128 + wc * 32 + 8 * fq) = (unsigned long long)__float_as_uint(g0[0] + g0[1] + g0[2] + g0[3]) | ((unsigned long long)__float_as_uint(g1[0] + g1[1] + g1[2] + g1[3]) << 32); }
        } else if (mode == 1 && acc[0][0][0][0][0] == 123456.789f) O[0] = 1;
    }
};
struct SplitOrder {
    int nT, nN, nS, ksub, G, c, pm_mul, lo, e_mul; const LAS int* tile_e;
    __device__ __forceinline__ bool next(int i, pg8::Unit& u) const {
        const long L = (long)i * G + c; if (L >= (long)nT * nN * nS) return false;
        const int ks = (int)(L % nS), r = (int)(L / nS), pn = r % nN, tm = r / nN;
        u.pm = tm * pm_mul; u.pn = pn + (tile_e ? tile_e[lo + tm] * e_mul : 0); u.ko = ks * ksub; return true; }
    __device__ __forceinline__ void a_ready(const pg8::Unit&) const {}
    __device__ __forceinline__ void done(const pg8::Unit&) const {}
};
struct EpiSlab {
    static constexpr bool PERM = false, AFTER_DRAIN = false;
    float* S; size_t sstride; int ksub, pm_div; float scale;
    __device__ __forceinline__ void operator()(const pg8::f32x4 (&acc)[2][2][4][2], const pg8::Unit& u, int wr, int wc, int fr, int fq) const {
        char* base = (char*)(S + (size_t)(u.ko / ksub) * sstride + (size_t)((u.pm / pm_div) * 256) * DM + (u.pn & 3) * 256);
        const unsigned off0 = (unsigned)((wr * 64 + fr) * DM + wc * 32 + 4 * fq) * 4u;
#pragma unroll
        for (int ai = 0; ai < 2; ++ai)
#pragma unroll
            for (int m = 0; m < 4; ++m) { const unsigned ro = off0 + (unsigned)((ai * 128 + m * 16) * DM * 4);
#pragma unroll
                for (int bj = 0; bj < 2; ++bj)
#pragma unroll
                    for (int n = 0; n < 2; ++n) *(pg8::f32x4*)(base + ro + (unsigned)((bj * 128 + n * 16) * 4)) = acc[ai][bj][m][n] * scale;
                asm volatile("" ::: "memory"); }
    }
};
template <bool I8> struct EpiBf16R {
    static constexpr bool PERM = true, AFTER_DRAIN = false;
    bf16* O; int ldc; const float* rowsc; const gu32* cmax;
    __device__ __forceinline__ void operator()(const pg8::f32x4 (&acc)[2][2][4][2], const pg8::Unit& u, int wr, int wc, int fr, int fq) const {
        const int row0 = u.pm * 256 + wr * 64 + fr, col0 = u.pn * 256 + wc * 32 + 8 * fq;
        pg8::f32x4 cs[2][2];
        if constexpr (I8) {
#pragma unroll
            for (int bj = 0; bj < 2; ++bj)
#pragma unroll
                for (int n = 0; n < 2; ++n)
#pragma unroll
                    for (int e = 0; e < 4; ++e) cs[bj][n][e] = __uint_as_float(cmax[col0 + bj * 128 + 4 * n + e]) * (1.f / 127.f); }
        float rsv[2][4];
#pragma unroll
        for (int ai = 0; ai < 2; ++ai)
#pragma unroll
            for (int m = 0; m < 4; ++m) rsv[ai][m] = I8 ? rowsc[row0 + ai * 128 + m * 16] : 1.f;
        asm volatile("" ::: "memory");
#pragma unroll
        for (int ai = 0; ai < 2; ++ai)
#pragma unroll
            for (int m = 0; m < 4; ++m) { const int r = row0 + ai * 128 + m * 16; bf16* rowp = O + (size_t)r * ldc + col0; const float rs = rsv[ai][m];
#pragma unroll
                for (int bj = 0; bj < 2; ++bj) { pg8::f32x4 v0 = acc[ai][bj][m][0], v1 = acc[ai][bj][m][1];
                    if constexpr (I8) {
#pragma unroll
                        for (int e = 0; e < 4; ++e) { v0[e] = (float)__float_as_int(v0[e]) * (rs * cs[bj][0][e]); v1[e] = (float)__float_as_int(v1[e]) * (rs * cs[bj][1][e]); } }
                    v4u w; w.x = pg8::cvt_pk_bf16(v0[0], v0[1]); w.y = pg8::cvt_pk_bf16(v0[2], v0[3]); w.z = pg8::cvt_pk_bf16(v1[0], v1[1]); w.w = pg8::cvt_pk_bf16(v1[2], v1[3]);
                    *(v4u*)(rowp + bj * 128) = w; } }
    }
};
struct EpiBf16S {
    static constexpr bool PERM = true, AFTER_DRAIN = false;
    bf16* O; int lo; float scale;
    __device__ __forceinline__ void operator()(const pg8::f32x4 (&acc)[2][2][4][2], const pg8::Unit& u, int wr, int wc, int fr, int fq) const {
        const int row0 = (lo + u.pm) * 256 + wr * 64 + fr, col0 = (u.pn & 3) * 256 + wc * 32 + 8 * fq;
#pragma unroll
        for (int ai = 0; ai < 2; ++ai)
#pragma unroll
            for (int m = 0; m < 4; ++m) { bf16* rowp = O + (size_t)(row0 + ai * 128 + m * 16) * DM + col0;
#pragma unroll
                for (int bj = 0; bj < 2; ++bj) { const pg8::f32x4 v0 = acc[ai][bj][m][0] * scale, v1 = acc[ai][bj][m][1] * scale;
                    v4u w; w.x = pg8::cvt_pk_bf16(v0[0], v0[1]); w.y = pg8::cvt_pk_bf16(v0[2], v0[3]); w.z = pg8::cvt_pk_bf16(v1[0], v1[1]); w.w = pg8::cvt_pk_bf16(v1[2], v1[3]);
                    *(v4u*)(rowp + bj * 128) = w; } }
    }
};
template <bool XB> struct EpiResid {
    static constexpr bool PERM = true, AFTER_DRAIN = false;
    const void* X; unsigned char* R; const float* gate;
    __device__ __forceinline__ void operator()(const pg8::f32x4 (&acc)[2][2][4][2], const pg8::Unit& u, int wr, int wc, int fr, int fq) const {
        const int b = u.pm / 33, lt = u.pm - b * 33 - 1;
        const int row0 = b * TL + lt * 256 + wr * 64 + fr, col0 = u.pn * 256 + wc * 32 + 8 * fq;
        pg8::f32x4 g[2][2];
#pragma unroll
        for (int bj = 0; bj < 2; ++bj)
#pragma unroll
            for (int n = 0; n < 2; ++n) g[bj][n] = *(const pg8::f32x4*)(gate + b * 6144 + col0 + bj * 128 + 4 * n);
        constexpr int NBUF = XB ? 4 : 3;
        pg8::f32x4 xf[XB ? 1 : NBUF][2][2]; v4u xb[XB ? NBUF : 1][2];
#define ER_LOAD(buf, k) do { const size_t row_ = (size_t)(row0 + ((k) >> 2) * 128 + ((k) & 3) * 16); \
        if constexpr (XB) { _Pragma("unroll") for (int bj = 0; bj < 2; ++bj) xb[buf][bj] = *(const GAS v4u*)((const unsigned char*)X + row_ * RP + (size_t)(col0 + bj * 128) * 2); } \
        else { _Pragma("unroll") for (int bj = 0; bj < 2; ++bj) _Pragma("unroll") for (int n = 0; n < 2; ++n) xf[buf][bj][n] = *(const GAS pg8::f32x4*)((const float*)X + row_ * DM + col0 + bj * 128 + 4 * n); } } while (0)
#pragma unroll
        for (int k = 0; k < NBUF; ++k) ER_LOAD(k, k);
#pragma unroll
        for (int k = 0; k < 8; ++k) { const int ai = k >> 2, m = k & 3, cb = k % NBUF;
            unsigned char* rowp = R + (size_t)(row0 + ai * 128 + m * 16) * RP + (size_t)col0 * 2;
#pragma unroll
            for (int bj = 0; bj < 2; ++bj) { pg8::f32x4 x0, x1;
                if constexpr (XB) { const v4u w = xb[cb][bj]; x0 = (pg8::f32x4){bflo(w.x), bfhi(w.x), bflo(w.y), bfhi(w.y)}; x1 = (pg8::f32x4){bflo(w.z), bfhi(w.z), bflo(w.w), bfhi(w.w)}; }
                else { x0 = xf[cb][bj][0]; x1 = xf[cb][bj][1]; }
                const pg8::f32x4 v0 = x0 + g[bj][0] * acc[ai][bj][m][0], v1 = x1 + g[bj][1] * acc[ai][bj][m][1];
                v4u o; o.x = pg8::cvt_pk_bf16(v0[0], v0[1]); o.y = pg8::cvt_pk_bf16(v0[2], v0[3]); o.z = pg8::cvt_pk_bf16(v1[0], v1[1]); o.w = pg8::cvt_pk_bf16(v1[2], v1[3]);
                *(GAS v4u*)(rowp + bj * 256) = o; }
            if (k + NBUF < 8) ER_LOAD(cb, k + NBUF);
        }
#undef ER_LOAD
    }
};
template <int QM> struct EpiSwiGLU {
    static constexpr bool PERM = true, AFTER_DRAIN = false;
    unsigned char* O; int ldc; int pm_sub; int pn_mod;
    const float* rowsc; const gu32* cmax;
    static __device__ __forceinline__ float gu(float G, float U, float k1, float ic) {
        const float e = __builtin_amdgcn_exp2f(G * k1);
        return (G * U) * __builtin_amdgcn_rcpf(__builtin_fmaf(e, ic, ic));
    }
    __device__ __forceinline__ void operator()(const pg8::f32x4 (&acc)[2][2][4][2], const pg8::Unit& u, int wr, int wc, int fr, int fq) const {
        const int row0 = (u.pm - pm_sub) * 256 + wr * 64 + fr, col0 = (u.pn % pn_mod) * 128 + wc * 32 + 8 * fq;
        constexpr float si = QM == 1 ? 1.f / W_UP_SCALE : 1.f, so = QM == 1 ? ACT_SCALE : 1.f;
        pg8::f32x4 cs[2][2];
        if constexpr (QM == 2) {
#pragma unroll
            for (int bj = 0; bj < 2; ++bj)
#pragma unroll
                for (int n = 0; n < 2; ++n)
#pragma unroll
                    for (int e = 0; e < 4; ++e) cs[bj][n][e] = __uint_as_float(cmax[u.pn * 256 + bj * 128 + wc * 32 + 8 * fq + 4 * n + e]) * (1.f / 127.f); }
        float rsv[2][4];
#pragma unroll
        for (int ai = 0; ai < 2; ++ai)
#pragma unroll
            for (int m = 0; m < 4; ++m) rsv[ai][m] = QM == 2 ? rowsc[u.pm * 256 + wr * 64 + fr + ai * 128 + m * 16] : 1.f;
        asm volatile("" ::: "memory");
#pragma unroll
        for (int ai = 0; ai < 2; ++ai)
#pragma unroll
            for (int m = 0; m < 4; ++m) {
                pg8::f32x4 g0 = acc[ai][0][m][0], g1 = acc[ai][0][m][1], u0 = acc[ai][1][m][0], u1 = acc[ai][1][m][1];
                float k1 = -si * 1.4426950408889634f, ic = 1.f / (si * si * so);
                if constexpr (QM == 2) {
                    const float rs = rsv[ai][m]; k1 = -1.4426950408889634f; ic = 1.f;
#pragma unroll
                    for (int e = 0; e < 4; ++e) { g0[e] = (float)__float_as_int(g0[e]) * (rs * cs[0][0][e]); g1[e] = (float)__float_as_int(g1[e]) * (rs * cs[0][1][e]);
                        u0[e] = (float)__float_as_int(u0[e]) * (rs * cs[1][0][e]); u1[e] = (float)__float_as_int(u1[e]) * (rs * cs[1][1][e]); } }
                const size_t off = (size_t)(row0 + ai * 128 + m * 16) * ldc + col0;
                if constexpr (QM == 1) {
                    const unsigned lo = pk4_fp8(gu(g0[0], u0[0], k1, ic), gu(g0[1], u0[1], k1, ic), gu(g0[2], u0[2], k1, ic), gu(g0[3], u0[3], k1, ic));
                    const unsigned hi = pk4_fp8(gu(g1[0], u1[0], k1, ic), gu(g1[1], u1[1], k1, ic), gu(g1[2], u1[2], k1, ic), gu(g1[3], u1[3], k1, ic));
                    *(unsigned long long*)(O + off) = (unsigned long long)lo | ((unsigned long long)hi << 32);
                } else {
                    v4u w; w.x = pg8::cvt_pk_bf16(gu(g0[0], u0[0], k1, ic), gu(g0[1], u0[1], k1, ic)); w.y = pg8::cvt_pk_bf16(gu(g0[2], u0[2], k1, ic), gu(g0[3], u0[3], k1, ic));
                    w.z = pg8::cvt_pk_bf16(gu(g1[0], u1[0], k1, ic), gu(g1[1], u1[1], k1, ic)); w.w = pg8::cvt_pk_bf16(gu(g1[2], u1[2], k1, ic), gu(g1[3], u1[3], k1, ic));
                    *(v4u*)((bf16*)O + off) = w; }
            }
    }
};


#ifndef MK_PER_PHASE
#define MK_PER_PHASE 0
#endif
#ifndef EN_MASK
#define EN_MASK 0xFFFFFFFFu
#endif
#define EN(bit) (((EN_MASK) >> (bit)) & 1u)
#ifndef DUP_MASK
#define DUP_MASK 0u
#endif
#define DUP(bit) (((DUP_MASK) >> (bit)) & 1u)
__global__ void __launch_bounds__(NTHR, 2) mk_fwd(Args a_unused) {
    extern __shared__ __attribute__((aligned(16))) unsigned char lds[];
    Frame F;
    F.lds = (LAS unsigned char*)lds;
    F.MISC = (volatile LAS unsigned*)(F.lds + MISC_OFF);
    F.tid = threadIdx.x; F.lane = F.tid & 63; F.wave = __builtin_amdgcn_readfirstlane(F.tid >> 6);
    F.G = gridDim.x; { const int bx = blockIdx.x; F.vcu = (F.G % 8 == 0) ? (bx % 8) * (F.G / 8) + bx / 8 : bx; }
    F.gw = F.vcu * NWAVES + F.wave; F.NGW = F.G * NWAVES;
    { CAP a = args_ptr(); F.ws = (unsigned char*)(GAS unsigned char*)(unsigned long long)a->ws; F.ctl = (gu32*)(F.ws + WS_CTL); }
    for (int u = F.tid; u < (LDS_BYTES - MISC_OFF) / 4; u += NTHR) ((LAS unsigned*)(F.lds + MISC_OFF))[u] = 0u;
    __syncthreads();
    XcdBarrier bar; bar.bar = (unsigned*)(F.ctl + CW_BAR); bar.x = 0; bar.st = nullptr;
    if (!MK_PER_PHASE) bar = xcd_barrier_post((unsigned*)(F.ctl + CW_BAR), F.MISC + 8);
    int lo, hi; { CAP a = args_ptr(); lo = a->ph_lo; hi = a->ph_hi; }
#define IN(k) (lo <= (k) && (k) < hi)
#define a (args_ptr())
#define FRESH() do { int t_ = threadIdx.x; asm volatile("" : "+v"(t_)); F.tid = t_; F.lane = t_ & 63; F.wave = __builtin_amdgcn_readfirstlane(t_ >> 6); F.gw = F.vcu * NWAVES + F.wave; \
        unsigned long long w_ = (unsigned long long)args_ptr()->ws; asm volatile("" : "+s"(w_)); F.ws = (unsigned char*)(GAS unsigned char*)w_; F.ctl = (gu32*)(F.ws + WS_CTL); } while (0)
#define SEAM(k) do { if (IN(k) && IN((k) + 1)) { if (MK_PER_PHASE) { if (F.tid == 0) __hip_atomic_store(F.ctl + 0, 0xBADBA0u, RLX_AGENT); } else { xcd_barrier(bar); if (DUP(20)) xcd_barrier(bar); } } } while (0)
#define HY ((bf16*)(F.ws + WS_HY))
#define CTXRES ((float*)(F.ws + WS_CTXRES))
#define MODS ((const float*)(F.ws + WS_MODS))

    FRESH();
    if (EN(0) && IN(0)) phase_prologue(F, a);
    if (DUP(0) && IN(0)) { __syncthreads(); phase_prologue(F, a); }
    SEAM(0); FRESH();
#pragma unroll 1
    for (int L = 0; L < 2; ++L) {
        const int pb = 1 + 9 * L;
        FRESH();
        if (EN(1) && IN(pb + 0)) phase_norm1(F, a, L);
        if (DUP(1) && IN(pb + 0) && L == 0) { for (int rep = 0; rep < 4; ++rep) phase_norm1(F, a, L); }
        SEAM(pb + 0); FRESH();
        if (EN(2) && IN(pb + 1)) {
            pg8::Gemm g{P_I8 ? (const bf16*)(F.ws + WS_QN) : (const bf16*)HY, (const bf16*)(F.ws + WS_WIN + (size_t)L * NP * DM * PB_), MROWS, NP, DM * PB_ / 2, DM * PB_ / 2}; pg8::StaticOrder S; S.init(MROWS, NP, F.G, (int)blockIdx.x);
            EpiBf16R<P_I8 != 0> E{(bf16*)(F.ws + WS_P), NP, (const float*)(F.ws + WS_ROUTE + RT_ROWSC_H), F.ctl + CW_CMAX_IN + L * NP};
            pg8::gemm_phase<EpiBf16R<P_I8 != 0>, pg8::StaticOrder, true, true, P_I8 ? 2 : 0>(F.lds, g, S, E);
            if (DUP(2)) pg8::gemm_phase<EpiBf16R<P_I8 != 0>, pg8::StaticOrder, true, true, P_I8 ? 2 : 0>(F.lds, g, S, E);
            { const int rem_ = ((MROWS / 256) * (NP / 256)) % F.G;
              if (rem_ == 0) phase_gates(F, a, L, F.gw, F.NGW);
              else if ((int)blockIdx.x >= rem_) phase_gates(F, a, L, ((int)blockIdx.x - rem_) * NWAVES + F.wave, (F.G - rem_) * NWAVES); }
        }
        SEAM(pb + 1); FRESH();
        if (IN(pb + 2)) { if (EN(3)) phase_qknorm(F, a, L); if (DUP(3)) { for (int rep = 0; rep < 4; ++rep) phase_qknorm(F, a, L); } if (EN(4)) phase_mlstm_local(F, a, L); if (DUP(4)) { for (int rep = 0; rep < 4; ++rep) phase_mlstm_local(F, a, L); } }
        SEAM(pb + 2); FRESH();
        if (IN(pb + 3)) { if (DUP(5)) { for (int rep = 0; rep < 4; ++rep) phase_scan<true>(F); } if (EN(5)) phase_scan<false>(F); __syncthreads(); FRESH(); if (EN(6)) phase_attn(F, a, L, (char*)lds); if (DUP(6)) phase_attn(F, a, L, (char*)lds); }
        SEAM(pb + 3); FRESH();
#ifndef MO_PRB
#define MO_PRB 0
#endif
        if (DUP(7) && IN(pb + 4)) { for (int rep = 0; rep < 4; ++rep) phase_mlstm_out<MO_PRB>(F, a, L); }
        if (EN(7) && IN(pb + 4)) phase_mlstm_out<0>(F, a, L);
        SEAM(pb + 4); FRESH();
        if (EN(8) && IN(pb + 5)) {
            pg8::Gemm g{HY, (const bf16*)(F.ws + WS_WOUT) + (size_t)L * DM * DM, MLAT, DM, DM, DM}; RowOrder S; S.init(MLAT, DM, F.G, (int)blockIdx.x); S.latent_only = 1;
            pg8::EpiBf16<0> E{(bf16*)(F.ws + WS_P), DM, nullptr, 0, 0, 1.f};
            if (L == 0) {
                EpiResid<false> ER{ain(a, 0), F.ws + WS_RESID, (const float*)(F.ws + WS_MODS) + 2 * 1024};
                pg8::gemm_phase<EpiResid<false>, RowOrder, true, true>(F.lds, g, S, ER);
            } else {
                EpiResid<true> ER{F.ws + WS_RESID, F.ws + WS_RESID, (const float*)(F.ws + WS_MODS) + 5 * 6144 + 2 * 1024};
                pg8::gemm_phase<EpiResid<true>, RowOrder, true, true>(F.lds, g, S, ER);
            }
            if (L == 0) {
                int ks_ = 256; asm volatile("" : "+s"(ks_));
                pg8::Gemm g2{HY, (const bf16*)(F.ws + WS_WOUT), TC * NB, DM, ks_, DM}; SplitOrder S2{NB, 4, NS_CW, 256, F.G, (int)blockIdx.x, 33, 0, 0, nullptr};
                EpiSlab E2{(float*)(F.ws + WS_SLAB_CW), (size_t)1024 * 1024, 256, 33, 1.f};
                pg8::gemm_phase<EpiSlab, SplitOrder, true, true>(F.lds, g2, S2, E2);
            }
            if (DUP(8)) pg8::gemm_phase<pg8::EpiBf16<0>, RowOrder, true, true>(F.lds, g, S, E);
        }
        SEAM(pb + 5); FRESH();
        if (L == 0) {
            FRESH();
            if (EN(9) && IN(7)) {
#pragma unroll 1
                for (int rep = 0; rep < (DUP(9) ? 5 : 1); ++rep) phase_norm2(F, a, 0); }
            SEAM(7); FRESH();
            if (EN(10) && IN(8)) {
                pg8::Gemm g{HY, (const bf16*)(F.ws + WS_WGU), MROWS, 2 * DFF, DM * UB / 2, DM * UB / 2}; pg8::StaticOrder S; S.init(MROWS, 2 * DFF, F.G, (int)blockIdx.x);
                EpiSwiGLU<UMODE> E{F.ws + WS_ACT0, DFF, 0, 1 << 20, (const float*)(F.ws + WS_ROUTE + RT_ROWSC), F.ctl + CW_CMAX_UP};
                pg8::gemm_phase<EpiSwiGLU<UMODE>, pg8::StaticOrder, true, true, UMODE>(F.lds, g, S, E);
                tail_convert(F, a, (MROWS / 256) * (2 * DFF / 256), 0, T_D);
                if (DUP(10)) pg8::gemm_phase<EpiSwiGLU<UMODE>, pg8::StaticOrder, true, true, UMODE>(F.lds, g, S, E);
            }
            SEAM(8); FRESH();
            if (EN(11) && IN(9)) {
                constexpr bool CSPLIT = (DENSE_FP8 == 0);
                pg8::Gemm g{(const bf16*)(F.ws + WS_ACT0), (const bf16*)(F.ws + WS_WD), CSPLIT ? MLAT : MROWS, DM, DFF * DB / 2, DFF * DB / 2}; RowOrder S; S.init(CSPLIT ? MLAT : MROWS, DM, F.G, (int)blockIdx.x); S.latent_only = CSPLIT ? 1 : 0;
                EpiBf16S E{HY, 0, DENSE_FP8 ? 1.f / (W_DN_SCALE * ACT_SCALE) : 1.f};
                static_assert(CSPLIT && DENSE_FP8 == 0, "the fused residual epilogue is written for the bf16, latent-only down GEMM");
                { EpiResid<true> ER{F.ws + WS_RESID, F.ws + WS_RESID, (const float*)(F.ws + WS_MODS) + 5 * 1024};
                  pg8::gemm_phase<EpiResid<true>, RowOrder, true, true>(F.lds, g, S, ER); }
                if (CSPLIT) {
                    int ks_ = 256; asm volatile("" : "+s"(ks_));
                    pg8::Gemm g2{(const bf16*)(F.ws + WS_ACT0), (const bf16*)(F.ws + WS_WD), TC * NB, DM, ks_, DFF}; SplitOrder S2{NB, 4, 11, 256, F.G, (int)blockIdx.x, 33, 0, 0, nullptr};
                    EpiSlab E2{(float*)(F.ws + WS_SLAB_CD), (size_t)1024 * 1024, 256, 33, 1.f};
                    pg8::gemm_phase<EpiSlab, SplitOrder, true, true>(F.lds, g2, S2, E2);
                }
                if (DUP(11)) pg8::gemm_phase<EpiBf16S, RowOrder, true, true, DENSE_FP8 != 0>(F.lds, g, S, E);
            }
            SEAM(9); FRESH();
        } else {
            FRESH();
            if (EN(12) && IN(16)) phase_norm2_route(F, a);
            if (DUP(12) && IN(16)) phase_norm2_route(F, a);
            SEAM(16); FRESH();
            if (EN(13) && IN(17)) phase_moe_sort(F, a);
            if (DUP(13) && IN(17)) phase_moe_sort(F, a);
            SEAM(17); FRESH();
            const int* INFO = (const int*)(F.ws + WS_ROUTE + RT_INFO); const int* TILEE_G = (const int*)(F.ws + WS_ROUTE + RT_TILEE);
            LAS int* TILEE = (LAS int*)(F.lds + pg8::STAGE_BYTES);
#define STAGE_TILEE() do { for (int i_ = F.tid; i_ < 272; i_ += NTHR) TILEE[i_] = TILEE_G[i_]; __syncthreads(); } while (0)
#pragma unroll 1
            for (int p = 0; p < 2; ++p) {
                FRESH();
                int tlo = 0, thi = 0;
                if (IN(18 + 2 * p) || IN(19 + 2 * p)) { const int nt = INFO[0]; tlo = 128 * p; thi = p == 1 ? nt : 128; if (thi > nt) thi = nt; if (tlo > thi) tlo = thi; }
                const int ntile = thi - tlo;
                if (EN(14) && IN(18 + 2 * p)) {
                    STAGE_TILEE();
                    pg8::Gemm g{(const bf16*)(F.ws + WS_ASORT), (const bf16*)(F.ws + WS_MGU), ntile * 256, 2 * DFE, DM / 2, DM / 2}; MoeUpOrder S; S.init(ntile * 256, 2 * DFE, F.G, (int)blockIdx.x); S.lo = tlo; S.tile_e = TILEE;
                    EpiSwiGLU<1> E{F.ws + WS_ACT1, DFE, tlo, 28, nullptr, nullptr};
                    pg8::gemm_phase<EpiSwiGLU<1>, MoeUpOrder, true, true, 1>(F.lds, g, S, E);
#ifndef PROBE_EPI
                    if (DUP(14)) pg8::gemm_phase<EpiSwiGLU<1>, MoeUpOrder, true, true, 1>(F.lds, g, S, E);
#else
                    if (DUP(14)) { EpiNull EN{F.ws + WS_ACT1, PROBE_EPI}; pg8::gemm_phase<EpiNull, MoeUpOrder, true, true, 1>(F.lds, g, S, EN); pg8::gemm_phase<EpiSwiGLU<1>, MoeUpOrder, true, true, 1>(F.lds, g, S, E); }
#endif
                }
                SEAM(18 + 2 * p); FRESH();
                if (EN(15) && IN(19 + 2 * p)) {
                    STAGE_TILEE();
                    const int nreg = ntile < PASS_TILES ? ntile : PASS_TILES, nl = ntile - nreg;
                    {
                    pg8::Gemm g{(const bf16*)(F.ws + WS_ACT1), (const bf16*)(F.ws + WS_MD), nreg * 256, DM, DFE / 2, DFE / 2}; MoeDownOrder S; S.init(nreg * 256, DM, F.G, (int)blockIdx.x); S.lo = tlo; S.tile_e = TILEE;
                    EpiBf16S E{(bf16*)(F.ws + WS_EOUT), tlo, 1.f / (W_DN_SCALE * ACT_SCALE)};
                    pg8::gemm_phase<EpiBf16S, MoeDownOrder, true, true, true>(F.lds, g, S, E);
                    }
                    if (nl > 0) {
                    pg8::Gemm g2{(const bf16*)(F.ws + WS_ACT1 + (size_t)nreg * 256 * DFE), (const bf16*)(F.ws + WS_MD), nl * 256, DM, 256, DFE / 2}; SplitOrder S2{nl, 4, NS_MT, 256, F.G, (int)blockIdx.x, 1, tlo + nreg, 4, TILEE};
                    EpiSlab E2{(float*)(F.ws + WS_SLAB_MT), (size_t)MT_TILES * 256 * 1024, 256, 1, 1.f / (W_DN_SCALE * ACT_SCALE)};
                    pg8::gemm_phase<EpiSlab, SplitOrder, true, true, true>(F.lds, g2, S2, E2);
                    }
                }
                SEAM(19 + 2 * p); FRESH();
            }
        }
    }
    FRESH();
    if (EN(16) && IN(22)) phase_final(F, a);
#undef IN
#undef SEAM
#undef a
#undef FRESH
#undef HY
#undef CTXRES
#undef MODS
}

extern "C" void kernel_launch(void* const* d_in, const int* in_sizes, int n_in, void* d_out, int out_size, void* d_ws, size_t ws_size, hipStream_t stream) {
    static int grid = 0;
    if (grid == 0) {
        if (n_in != 22 || in_sizes[0] != MLAT * DM || out_size != MLAT * DM || ws_size < WS_END) { fprintf(stderr, "kernel_launch: unexpected shapes (n_in %d, in0 %d, out %d, ws %zu); nothing launched\n", n_in, n_in > 0 ? in_sizes[0] : -1, out_size, ws_size); grid = -1; return; }
        int dev = 0, cus = 0, per_cu = 0;
        if (hipGetDevice(&dev) != hipSuccess || hipDeviceGetAttribute(&cus, hipDeviceAttributeMultiprocessorCount, dev) != hipSuccess) { grid = -1; return; }
        if (hipFuncSetAttribute((const void*)mk_fwd, hipFuncAttributeMaxDynamicSharedMemorySize, LDS_BYTES) != hipSuccess) { fprintf(stderr, "kernel_launch: hipFuncSetAttribute failed\n"); grid = -1; return; }
        if (hipOccupancyMaxActiveBlocksPerMultiprocessor(&per_cu, (const void*)mk_fwd, NTHR, LDS_BYTES) != hipSuccess || per_cu < 1) { fprintf(stderr, "kernel_launch: occupancy query says %d\n", per_cu); }
        (void)hipGetLastError();
        grid = cus;
    }
    if (grid < 0) return;
    if (hipMemsetAsync((char*)d_ws + WS_CTL, 0, CTL_ZERO_BYTES, stream) != hipSuccess) return;
    Args ha{};
    for (int i = 0; i < 22; ++i) ha.in[i] = (const float*)d_in[i];
    ha.out = (float*)d_out; ha.ws = (unsigned char*)d_ws; ha.li = 0; ha.pad = 0;
#if MK_PER_PHASE
    for (int k = 0; k < N_PHASES; ++k) { ha.ph_lo = k; ha.ph_hi = k + 1; hipLaunchKernelGGL(mk_fwd, dim3(grid), dim3(NTHR), LDS_BYTES, stream, ha); }
#else
    ha.ph_lo = 0; ha.ph_hi = N_PHASES;
    hipLaunchKernelGGL(mk_fwd, dim3(grid), dim3(NTHR), LDS_BYTES, stream, ha);
#endif
    (void)hipPeekAtLastError();
}
```
